# Optimizing an MI355X kernel written in HIP

```python
import jax, jax.numpy as jnp
from jax import lax
import numpy as np

D_MODEL = 1024
BATCH = 8
SEQ = 2048
DEPTH = 4

N_MIXERS = 3
MEM_LEN = 256
EPS = 1e-6
ROPE_THETA = 10000.0
MAX_POS_OFFSET = 4096

MLA_HEADS = 8
MLA_NOPE = 128
MLA_ROPE = 64
MLA_V = 128
MLA_Q_RANK = 384
MLA_KV_RANK = 256
Q_BLOCK = 128

GDN_HEADS = 8
GDN_DK = 128
GDN_DV = 128
GDN_CONV = 4
GDN_CHUNK = 64
GDN_QKV = GDN_HEADS * (2 * GDN_DK + GDN_DV)
GDN_PROJ = GDN_QKV + GDN_HEADS * GDN_DV + 2 * GDN_HEADS

SC_WIDTH = D_MODEL
SC_CONV = 3

X_HEADS = 4
X_HEAD_DIM = D_MODEL // X_HEADS

D_FF = 4 * D_MODEL

N_A = (DEPTH + 2) // N_MIXERS
N_B = (DEPTH + 1) // N_MIXERS
N_C = DEPTH // N_MIXERS

kernel_name = "hybrid_mla_gdn_shortconv_memxattn"


def rms_norm(x, g):
    xf = x.astype(jnp.float32)
    y = xf * lax.rsqrt(jnp.mean(xf * xf, axis=-1, keepdims=True) + EPS)
    return (y * g.astype(jnp.float32)).astype(x.dtype)


def rope_tables(positions):
    inv_freq = ROPE_THETA ** (-jnp.arange(0, MLA_ROPE, 2, dtype=jnp.float32) / MLA_ROPE)
    ang = positions.astype(jnp.float32)[..., None] * inv_freq
    return jnp.cos(ang), jnp.sin(ang)


def apply_rope(x, cos, sin):
    c = cos[:, :, None, :]
    s = sin[:, :, None, :]
    x1, x2 = jnp.split(x.astype(jnp.float32), 2, axis=-1)
    return jnp.concatenate([x1 * c - x2 * s, x2 * c + x1 * s], axis=-1).astype(x.dtype)


def causal_depthwise_conv(x, w):
    k, c = w.shape
    return lax.conv_general_dilated(
        x, w[:, None, :].astype(x.dtype), window_strides=(1,), padding=[(k - 1, 0)],
        dimension_numbers=("NWC", "WIO", "NWC"), feature_group_count=c)


def mla_mixer(h, cos, sin, w_in, q_norm, kv_norm, w_uq, w_ukv, w_o):
    b, s, _ = h.shape
    z = h @ w_in
    c_q, c_kv, k_rope = jnp.split(z, [MLA_Q_RANK, MLA_Q_RANK + MLA_KV_RANK], axis=-1)
    q = (rms_norm(c_q, q_norm) @ w_uq).reshape(b, s, MLA_HEADS, MLA_NOPE + MLA_ROPE)
    q_nope = q[..., :MLA_NOPE]
    q_rope = apply_rope(q[..., MLA_NOPE:], cos, sin)
    kv = (rms_norm(c_kv, kv_norm) @ w_ukv).reshape(b, s, MLA_HEADS, MLA_NOPE + MLA_V)
    k_nope, v = kv[..., :MLA_NOPE], kv[..., MLA_NOPE:]
    k_rope = apply_rope(k_rope[:, :, None, :], cos, sin)[:, :, 0, :]
    scale = (MLA_NOPE + MLA_ROPE) ** -0.5
    outs = []
    for start in range(0, s, Q_BLOCK):
        end = start + Q_BLOCK
        sc = (jnp.einsum("bqhd,bkhd->bhqk", q_nope[:, start:end], k_nope[:, :end])
              + jnp.einsum("bqhr,bkr->bhqk", q_rope[:, start:end], k_rope[:, :end]))
        sc = sc.astype(jnp.float32) * scale
        mask = (start + jnp.arange(Q_BLOCK))[:, None] >= jnp.arange(end)[None, :]
        sc = jnp.where(mask, sc, -jnp.inf)
        p = jax.nn.softmax(sc, axis=-1).astype(v.dtype)
        outs.append(jnp.einsum("bhqk,bkhd->bqhd", p, v[:, :end]))
    o = jnp.concatenate(outs, axis=1).reshape(b, s, MLA_HEADS * MLA_V)
    return o @ w_o


def chunk_gated_delta_rule(q, k, v, g, beta):
    b, s, h, dk = q.shape
    dv = v.shape[-1]
    c = GDN_CHUNK
    n = s // c

    def to_chunks(t):
        t = t.astype(jnp.float32).reshape((b, n, c, h) + t.shape[3:])
        return jnp.moveaxis(t, (1, 3), (0, 2))

    qc, kc, vc = to_chunks(q), to_chunks(k), to_chunks(v)
    gc = lax.cumsum(to_chunks(g), axis=3)
    bc = to_chunks(beta)
    tri = jnp.tril(jnp.ones((c, c), dtype=bool))
    strict = jnp.tril(jnp.ones((c, c), dtype=bool), -1)
    decay = jnp.exp(jnp.where(tri, gc[..., :, None] - gc[..., None, :], -jnp.inf))
    k_beta = kc * bc[..., None]
    m = jnp.where(strict, jnp.einsum("nbhid,nbhjd->nbhij", k_beta, kc) * decay, 0.0)
    eye = jnp.eye(c, dtype=jnp.float32)
    t_inv = lax.linalg.triangular_solve(eye + m, jnp.broadcast_to(eye, m.shape),
                                        left_side=True, lower=True, unit_diagonal=True)
    u = t_inv @ (vc * bc[..., None])
    w = t_inv @ (k_beta * jnp.exp(gc)[..., None])
    attn_intra = jnp.einsum("nbhid,nbhjd->nbhij", qc, kc) * decay

    def step(state, xs):
        q_i, k_i, u_i, w_i, g_i, a_i = xs
        v_new = u_i - w_i @ state
        o_i = (q_i * jnp.exp(g_i)[..., None]) @ state + a_i @ v_new
        g_last = g_i[..., -1:]
        state = (state * jnp.exp(g_last)[..., None]
                 + jnp.einsum("bhcd,bhce->bhde", k_i * jnp.exp(g_last - g_i)[..., None], v_new))
        return state, o_i

    s0 = jnp.zeros((b, h, dk, dv), jnp.float32)
    _, o = lax.scan(step, s0, (qc, kc, u, w, gc, attn_intra))
    return jnp.moveaxis(o, (0, 2), (1, 3)).reshape(b, s, h, dv)


def gdn_mixer(h, w_in, conv_w, a_log, dt_bias, o_norm, w_o):
    b, s, _ = h.shape
    z = h @ w_in
    qkv, gate, beta_logit, a_logit = jnp.split(
        z, [GDN_QKV, GDN_QKV + GDN_HEADS * GDN_DV, GDN_QKV + GDN_HEADS * GDN_DV + GDN_HEADS], axis=-1)
    qkv = jax.nn.silu(causal_depthwise_conv(qkv, conv_w))
    q, k, v = jnp.split(qkv, [GDN_HEADS * GDN_DK, 2 * GDN_HEADS * GDN_DK], axis=-1)
    q = q.reshape(b, s, GDN_HEADS, GDN_DK).astype(jnp.float32)
    k = k.reshape(b, s, GDN_HEADS, GDN_DK).astype(jnp.float32)
    v = v.reshape(b, s, GDN_HEADS, GDN_DV)
    q = q * lax.rsqrt(jnp.sum(q * q, -1, keepdims=True) + EPS) * (GDN_DK ** -0.5)
    k = k * lax.rsqrt(jnp.sum(k * k, -1, keepdims=True) + EPS)
    beta = jax.nn.sigmoid(beta_logit.astype(jnp.float32))
    g = -jnp.exp(a_log.astype(jnp.float32)) * jax.nn.softplus(
        a_logit.astype(jnp.float32) + dt_bias.astype(jnp.float32))
    o = chunk_gated_delta_rule(q, k, v, g, beta)
    o = rms_norm(o, o_norm) * jax.nn.silu(gate.reshape(b, s, GDN_HEADS, GDN_DV).astype(jnp.float32))
    return o.reshape(b, s, GDN_HEADS * GDN_DV).astype(h.dtype) @ w_o


def short_conv_mixer(h, w_in, conv_w, w_o):
    z = h @ w_in
    b_gate, c_gate, u = jnp.split(z, 3, axis=-1)
    y = b_gate * causal_depthwise_conv(c_gate * u, conv_w)
    return y @ w_o


def memory_cross_attention(h, mem_n, w_q, w_kv, w_o):
    b, s, _ = h.shape
    m = mem_n.shape[1]
    q = (h @ w_q).reshape(b, s, X_HEADS, X_HEAD_DIM)
    k, v = jnp.split(mem_n @ w_kv, 2, axis=-1)
    k = k.reshape(b, m, X_HEADS, X_HEAD_DIM)
    v = v.reshape(b, m, X_HEADS, X_HEAD_DIM)
    sc = jnp.einsum("bqhd,bkhd->bhqk", q, k).astype(jnp.float32) * (X_HEAD_DIM ** -0.5)
    p = jax.nn.softmax(sc, axis=-1).astype(v.dtype)
    o = jnp.einsum("bhqk,bkhd->bqhd", p, v).reshape(b, s, X_HEADS * X_HEAD_DIM)
    return o @ w_o


def relu2_mlp(h, w1, w2):
    return jnp.square(jax.nn.relu(h @ w1)) @ w2


def setup_inputs(seed: int = 0) -> dict:
    key = jax.random.key(seed)
    ks = iter(jax.random.split(key, 40))

    def w(shape, fan_in):
        return jax.random.normal(next(ks), shape, jnp.float32) * (fan_in ** -0.5)

    def gain(shape):
        return 1.0 + 0.02 * jax.random.normal(next(ks), shape, jnp.float32)

    x = jax.random.normal(next(ks), (BATCH, SEQ, D_MODEL), jnp.float32)
    mem = jax.random.normal(next(ks), (BATCH, MEM_LEN, D_MODEL), jnp.float32)
    offsets = jax.random.randint(next(ks), (BATCH, 1), 0, MAX_POS_OFFSET, dtype=jnp.int32)
    positions = offsets + jnp.arange(SEQ, dtype=jnp.int32)[None, :]

    mla_w_in = w((N_A, D_MODEL, MLA_Q_RANK + MLA_KV_RANK + MLA_ROPE), D_MODEL)
    mla_q_norm = gain((N_A, MLA_Q_RANK))
    mla_kv_norm = gain((N_A, MLA_KV_RANK))
    mla_w_uq = w((N_A, MLA_Q_RANK, MLA_HEADS * (MLA_NOPE + MLA_ROPE)), MLA_Q_RANK)
    mla_w_ukv = w((N_A, MLA_KV_RANK, MLA_HEADS * (MLA_NOPE + MLA_V)), MLA_KV_RANK)
    mla_w_o = w((N_A, MLA_HEADS * MLA_V, D_MODEL), MLA_HEADS * MLA_V)

    gdn_w_in = w((N_B, D_MODEL, GDN_PROJ), D_MODEL)
    gdn_conv_w = w((N_B, GDN_CONV, GDN_QKV), GDN_CONV)
    gdn_a_log = jnp.log(jax.random.uniform(next(ks), (N_B, GDN_HEADS), jnp.float32, 1.0, 16.0))
    dt = jnp.exp(jax.random.uniform(next(ks), (N_B, GDN_HEADS), jnp.float32,
                                    float(np.log(1e-3)), float(np.log(1e-1))))
    gdn_dt_bias = dt + jnp.log(-jnp.expm1(-dt))
    gdn_o_norm = gain((N_B, GDN_DV))
    gdn_w_o = w((N_B, GDN_HEADS * GDN_DV, D_MODEL), GDN_HEADS * GDN_DV)

    sc_w_in = w((N_C, D_MODEL, 3 * SC_WIDTH), D_MODEL)
    sc_conv_w = w((N_C, SC_CONV, SC_WIDTH), SC_CONV)
    sc_w_o = w((N_C, SC_WIDTH, D_MODEL), SC_WIDTH)

    norm_mix = gain((DEPTH, D_MODEL))
    norm_mem = gain((DEPTH, D_MODEL))
    norm_mlp = gain((DEPTH, D_MODEL))
    xa_w_q = w((DEPTH, D_MODEL, X_HEADS * X_HEAD_DIM), D_MODEL)
    xa_w_kv = w((DEPTH, D_MODEL, 2 * X_HEADS * X_HEAD_DIM), D_MODEL)
    xa_w_o = w((DEPTH, X_HEADS * X_HEAD_DIM, D_MODEL), X_HEADS * X_HEAD_DIM)
    mlp_w1 = w((DEPTH, D_MODEL, D_FF), D_MODEL)
    mlp_w2 = w((DEPTH, D_FF, D_MODEL), D_FF)
    mem_norm = gain((D_MODEL,))
    final_norm = gain((D_MODEL,))

    return {
        "x": x, "mem": mem, "positions": positions,
        "mla_w_in": mla_w_in, "mla_q_norm": mla_q_norm, "mla_kv_norm": mla_kv_norm,
        "mla_w_uq": mla_w_uq, "mla_w_ukv": mla_w_ukv, "mla_w_o": mla_w_o,
        "gdn_w_in": gdn_w_in, "gdn_conv_w": gdn_conv_w, "gdn_a_log": gdn_a_log,
        "gdn_dt_bias": gdn_dt_bias, "gdn_o_norm": gdn_o_norm, "gdn_w_o": gdn_w_o,
        "sc_w_in": sc_w_in, "sc_conv_w": sc_conv_w, "sc_w_o": sc_w_o,
        "norm_mix": norm_mix, "norm_mem": norm_mem, "norm_mlp": norm_mlp,
        "xa_w_q": xa_w_q, "xa_w_kv": xa_w_kv, "xa_w_o": xa_w_o,
        "mlp_w1": mlp_w1, "mlp_w2": mlp_w2,
        "mem_norm": mem_norm, "final_norm": final_norm,
    }


def reference(x, mem, positions,
              mla_w_in, mla_q_norm, mla_kv_norm, mla_w_uq, mla_w_ukv, mla_w_o,
              gdn_w_in, gdn_conv_w, gdn_a_log, gdn_dt_bias, gdn_o_norm, gdn_w_o,
              sc_w_in, sc_conv_w, sc_w_o,
              norm_mix, norm_mem, norm_mlp,
              xa_w_q, xa_w_kv, xa_w_o,
              mlp_w1, mlp_w2,
              mem_norm, final_norm):
    cos, sin = rope_tables(positions)
    mem_n = rms_norm(mem, mem_norm)
    for i in range(DEPTH):
        j = i // N_MIXERS
        kind = i % N_MIXERS
        h = rms_norm(x, norm_mix[i])
        if kind == 0:
            y = mla_mixer(h, cos, sin, mla_w_in[j], mla_q_norm[j], mla_kv_norm[j],
                          mla_w_uq[j], mla_w_ukv[j], mla_w_o[j])
        elif kind == 1:
            y = gdn_mixer(h, gdn_w_in[j], gdn_conv_w[j], gdn_a_log[j], gdn_dt_bias[j],
                          gdn_o_norm[j], gdn_w_o[j])
        else:
            y = short_conv_mixer(h, sc_w_in[j], sc_conv_w[j], sc_w_o[j])
        x = x + y
        x = x + memory_cross_attention(rms_norm(x, norm_mem[i]), mem_n,
                                       xa_w_q[i], xa_w_kv[i], xa_w_o[i])
        x = x + relu2_mlp(rms_norm(x, norm_mlp[i]), mlp_w1[i], mlp_w2[i])
    return rms_norm(x, final_norm)
```

```cpp
#include <hip/hip_runtime.h>
#include <hip/hip_cooperative_groups.h>
#include <cstdio>
#include <cstdint>
namespace cg = cooperative_groups;
namespace pg8 {
#define PG8_LAS __attribute__((address_space(3)))
typedef unsigned short bf16_t;
typedef short bf16x8 __attribute__((ext_vector_type(8)));
typedef float f32x4 __attribute__((ext_vector_type(4)));
typedef unsigned u32x4 __attribute__((ext_vector_type(4)));
constexpr int BM = 256, BK = 64, HALF = 128, HTB = HALF * BK * 2  , STAGE_BYTES = 8 * HTB, NXCD = 8, WGM = 8;

__host__ __device__ __forceinline__ int lds_byte(int r, int c) { const int st = (r >> 4) * 2 + (c >> 5), rr = r & 15, cc = c & 31, ob = rr * 64 + cc * 2; return st * 1024 + (ob ^ (((ob >> 9) & 1) << 5)); }
__host__ __device__ __forceinline__ void stage_rc(int b, int& R, int& C) { const int st = b / 1024, sb = b % 1024, swz = sb ^ (((sb >> 9) & 1) << 5); R = (st >> 1) * 16 + swz / 64; C = (st & 1) * 32 + (swz % 64) / 2; }
__host__ __device__ __forceinline__ int perm32(int rho) { const int n = rho >> 4, i = rho & 15; return 8 * (i >> 2) + 4 * n + (i & 3); }

struct Unit { int pm, pn; };
struct Gemm { const bf16_t* A; const bf16_t* Bt; int M, N, K; };

struct StaticOrder {
    int nM, nN, nwg, G, c;
    __host__ __device__ void init(int M, int N, int G_, int c_) { nM = M / BM; nN = N / BM; nwg = nM * nN; G = G_; c = c_; }
    __host__ __device__ bool next(int i, Unit& u) const {
        const long L = (long)i * G + c; if (L >= nwg) return false;
        int wgid = (int)L; { const int q = nwg / NXCD, r = nwg % NXCD, xcd = wgid % NXCD, off = wgid / NXCD; wgid = (xcd < r ? xcd * (q + 1) : r * (q + 1) + (xcd - r) * q) + off; }
        const int nig = WGM * nN, gid = wgid / nig, fm = gid * WGM, gsz = (nM - fm) < WGM ? (nM - fm) : WGM;
        u.pm = fm + ((wgid % nig) % gsz); u.pn = (wgid % nig) / gsz; return true;
    }
    __device__ __forceinline__ void a_ready(const Unit&) const {}
    __device__ __forceinline__ void done(const Unit&) const {}
};

__device__ __forceinline__ unsigned cvt_pk_bf16(float lo, float hi) { unsigned r; asm volatile("v_cvt_pk_bf16_f32 %0, %1, %2" : "=v"(r) : "v"(lo), "v"(hi)); return r; }
__device__ __forceinline__ int opq_tid(int wv) { int l; asm volatile("v_mbcnt_lo_u32_b32 %0, -1, 0\n\tv_mbcnt_hi_u32_b32 %0, -1, %0" : "=v"(l)); return wv * 64 + l; }
template <class Epi, class Sched, bool ALIGN_EPI = false, bool SP2 = false>
__device__ __forceinline__ void gemm_phase(PG8_LAS unsigned char* lds, const Gemm g, const Sched& S, const Epi& E, const int wv) {
    const int tid = opq_tid(wv), wid = __builtin_amdgcn_readfirstlane(tid >> 6), lane = tid & 63, wr = wid >> 2, wc = wid & 3, fr = lane & 15, fq = lane >> 4;
    const int K = g.K, nt = K / BK;
    unsigned voffA[2], voffB[2];
#pragma unroll
    for (int i = 0; i < 2; ++i) { int R, C; stage_rc(tid * 16 + i * 8192, R, C); const int Rb = Epi::PERM ? ((R & ~31) + perm32(R & 31)) : R;
        voffA[i] = (unsigned)(R * K + C) * 2u; voffB[i] = (unsigned)(Rb * K + C) * 2u; }
    const size_t kstep = (size_t)(BK * 2);
    const size_t hstep = (size_t)HALF * K * 2;
    const size_t tstep = 2 * hstep;
    const unsigned ldsw = (unsigned)wid * 1024u;
    const int aoff = lds_byte(wr * 64 + fr, fq * 8), boff = lds_byte(wc * 32 + fr, fq * 8);
#define PG8_SA(b, h) (((b) * 2 + (h)) * HTB)
#define PG8_SB(b, h) ((4 + (b) * 2 + (h)) * HTB)
#define PG8_STAGE(bufoff, gbase, voff) do { _Pragma("unroll") for (int _i = 0; _i < 2; ++_i) \
        __builtin_amdgcn_global_load_lds((const unsigned*)((const char*)(gbase) + (voff)[_i]), (PG8_LAS unsigned*)(lds + (bufoff) + ldsw + _i * 8192), 16, 0, 0); } while (0)
#define PG8_LDA(dst, b, h) do { _Pragma("unroll") for (int m = 0; m < 4; ++m) _Pragma("unroll") for (int k = 0; k < 2; ++k) dst[m][k] = *(const PG8_LAS bf16x8*)(lds + PG8_SA(b, h) + aoff + m * 2048 + k * 1024); } while (0)
#define PG8_LDB(dst, b, h) do { _Pragma("unroll") for (int n = 0; n < 2; ++n) _Pragma("unroll") for (int k = 0; k < 2; ++k) dst[n][k] = *(const PG8_LAS bf16x8*)(lds + PG8_SB(b, h) + boff + n * 2048 + k * 1024); } while (0)
#define PG8_MMA(ai, bj, At, Bt) do { __builtin_amdgcn_s_setprio(1); _Pragma("unroll") for (int m = 0; m < 4; ++m) _Pragma("unroll") for (int n = 0; n < 2; ++n) _Pragma("unroll") for (int k = 0; k < 2; ++k) \
        acc[ai][bj][m][n] = __builtin_amdgcn_mfma_f32_16x16x32_bf16(Bt[n][k], At[m][k], acc[ai][bj][m][n], 0, 0, 0); __builtin_amdgcn_s_setprio(0); } while (0)
#define PG8_WAIT_V(n) asm volatile("s_waitcnt vmcnt(" #n ")" ::: "memory")
#define PG8_WAIT_L(n) asm volatile("s_waitcnt lgkmcnt(" #n ")" ::: "memory")
#define PG8_BAR __builtin_amdgcn_s_barrier()
#define PG8_SCHED __builtin_amdgcn_sched_barrier(0)
    Unit cur, nxt; int ui = 0;
    if (!S.next(0, cur)) return;
    f32x4 acc[2][2][4][2];
#pragma unroll
    for (int a = 0; a < 2; ++a)
#pragma unroll
        for (int b = 0; b < 2; ++b)
#pragma unroll
            for (int m = 0; m < 4; ++m)
#pragma unroll
                for (int n = 0; n < 2; ++n) acc[a][b][m][n] = (f32x4){0.f, 0.f, 0.f, 0.f};
    bf16x8 At[4][2], B0[2][2], B1[2][2];
    const char* cA = (const char*)g.A + (size_t)cur.pm * tstep; const char* cB = (const char*)g.Bt + (size_t)cur.pn * tstep;
    S.a_ready(cur);
    if constexpr (SP2) {
        PG8_STAGE(PG8_SB(0, 0), cB, voffB); PG8_STAGE(PG8_SB(0, 1), cB + hstep, voffB); PG8_STAGE(PG8_SA(0, 0), cA, voffA); PG8_STAGE(PG8_SA(0, 1), cA + hstep, voffA);
        if (wr == 1) PG8_BAR;
        PG8_WAIT_V(2); PG8_BAR;
        PG8_STAGE(PG8_SB(1, 0), cB + kstep, voffB); PG8_STAGE(PG8_SA(1, 0), cA + kstep, voffA); PG8_STAGE(PG8_SB(1, 1), cB + hstep + kstep, voffB);
        PG8_WAIT_V(6); PG8_BAR;
    } else {
        PG8_STAGE(PG8_SB(0, 0), cB, voffB); PG8_STAGE(PG8_SA(0, 0), cA, voffA); PG8_STAGE(PG8_SB(0, 1), cB + hstep, voffB); PG8_STAGE(PG8_SA(0, 1), cA + hstep, voffA);
        if (wr == 1) PG8_BAR;
        PG8_WAIT_V(4); PG8_BAR;
        PG8_STAGE(PG8_SB(1, 0), cB + kstep, voffB); PG8_STAGE(PG8_SA(1, 0), cA + kstep, voffA); PG8_STAGE(PG8_SB(1, 1), cB + hstep + kstep, voffB);
        PG8_WAIT_V(6); PG8_BAR;
    }
    for (;;) {
        const bool has_next = S.next(ui + 1, nxt);
        const char* nA = has_next ? (const char*)g.A + (size_t)nxt.pm * tstep : cA; const char* nB = has_next ? (const char*)g.Bt + (size_t)nxt.pn * tstep : cB;
        for (int t = 0; t < nt; t += 2) {
            const bool last = (t == nt - 2);
            const char* a1 = cA + (size_t)(t + 1) * kstep;
            const char* a2 = last ? nA : cA + (size_t)(t + 2) * kstep; const char* b2 = last ? nB : cB + (size_t)(t + 2) * kstep;
            const char* a3 = a2 + kstep; const char* b3 = b2 + kstep;
            if (last && has_next) S.a_ready(nxt);
            if constexpr (SP2) {
            PG8_LDB(B0, 0, 0); PG8_LDB(B1, 0, 1); PG8_SCHED; PG8_LDA(At, 0, 0); PG8_STAGE(PG8_SA(1, 1), a1 + hstep, voffA);
            PG8_WAIT_V(8); PG8_WAIT_L(0); PG8_BAR; PG8_MMA(0, 0, At, B0); PG8_MMA(0, 1, At, B1); PG8_BAR; PG8_SCHED;
            PG8_LDA(At, 0, 1); PG8_STAGE(PG8_SB(0, 0), b2, voffB); PG8_STAGE(PG8_SB(0, 1), b2 + hstep, voffB); PG8_STAGE(PG8_SA(0, 0), a2, voffA);
            PG8_WAIT_V(8); PG8_WAIT_L(0); PG8_BAR; PG8_MMA(1, 0, At, B0); PG8_MMA(1, 1, At, B1); PG8_BAR; PG8_SCHED;
            PG8_LDB(B0, 1, 0); PG8_LDB(B1, 1, 1); PG8_SCHED; PG8_LDA(At, 1, 0); PG8_STAGE(PG8_SA(0, 1), a2 + hstep, voffA);
            PG8_WAIT_V(8); PG8_WAIT_L(0); PG8_BAR; PG8_MMA(0, 0, At, B0); PG8_MMA(0, 1, At, B1); PG8_BAR; PG8_SCHED;
            PG8_LDA(At, 1, 1); PG8_STAGE(PG8_SB(1, 0), b3, voffB); PG8_STAGE(PG8_SB(1, 1), b3 + hstep, voffB); PG8_STAGE(PG8_SA(1, 0), a3, voffA);
            PG8_WAIT_V(8); PG8_WAIT_L(0); PG8_BAR; PG8_MMA(1, 0, At, B0); PG8_MMA(1, 1, At, B1); PG8_BAR; PG8_SCHED;
            } else {
            PG8_LDB(B0, 0, 0); PG8_SCHED; PG8_LDA(At, 0, 0); PG8_STAGE(PG8_SA(1, 1), a1 + hstep, voffA);
            PG8_WAIT_L(8); PG8_BAR; PG8_WAIT_L(0); PG8_MMA(0, 0, At, B0); PG8_BAR; PG8_SCHED;
            PG8_LDB(B1, 0, 1); PG8_STAGE(PG8_SB(0, 0), b2, voffB);
            PG8_BAR; PG8_WAIT_L(0); PG8_MMA(0, 1, At, B1); PG8_BAR;
            PG8_LDA(At, 0, 1); PG8_STAGE(PG8_SA(0, 0), a2, voffA);
            PG8_BAR; PG8_WAIT_L(0); PG8_MMA(1, 0, At, B0); PG8_BAR; PG8_SCHED;
            PG8_STAGE(PG8_SB(0, 1), b2 + hstep, voffB);
            PG8_WAIT_V(6); PG8_BAR; PG8_MMA(1, 1, At, B1); PG8_BAR;
            PG8_LDB(B0, 1, 0); PG8_SCHED; PG8_LDA(At, 1, 0); PG8_STAGE(PG8_SA(0, 1), a2 + hstep, voffA);
            PG8_WAIT_L(8); PG8_BAR; PG8_WAIT_L(0); PG8_MMA(0, 0, At, B0); PG8_BAR; PG8_SCHED;
            PG8_LDB(B1, 1, 1); PG8_STAGE(PG8_SB(1, 0), b3, voffB);
            PG8_BAR; PG8_WAIT_L(0); PG8_MMA(0, 1, At, B1); PG8_BAR;
            PG8_LDA(At, 1, 1); PG8_STAGE(PG8_SA(1, 0), a3, voffA);
            PG8_BAR; PG8_WAIT_L(0); PG8_MMA(1, 0, At, B0); PG8_BAR; PG8_SCHED;
            PG8_STAGE(PG8_SB(1, 1), b3 + hstep, voffB);
            PG8_WAIT_V(6); PG8_BAR; PG8_MMA(1, 1, At, B1); PG8_BAR;
            }
        }
        if constexpr (ALIGN_EPI) { if (wr == 0) PG8_BAR; }
        if constexpr (!Epi::AFTER_DRAIN) { E(acc, cur, wr, wc, fr, fq); S.done(cur); }
        if (!has_next) break;
#pragma unroll
        for (int a = 0; a < 2; ++a)
#pragma unroll
            for (int b = 0; b < 2; ++b)
#pragma unroll
                for (int m = 0; m < 4; ++m)
#pragma unroll
                    for (int n = 0; n < 2; ++n) acc[a][b][m][n] = (f32x4){0.f, 0.f, 0.f, 0.f};
        cur = nxt; cA = nA; cB = nB; ++ui;
        if constexpr (ALIGN_EPI) { if (wr == 1) PG8_BAR; }
    }
    PG8_WAIT_V(0);
    if constexpr (!ALIGN_EPI) { if (wr == 0) PG8_BAR; }
    PG8_BAR;
    if constexpr (Epi::AFTER_DRAIN) { E.fused(acc, cur, wr, wc, fr, fq, lds, wid, lane); S.done(cur); }
#undef PG8_SA
#undef PG8_SB
#undef PG8_STAGE
#undef PG8_LDA
#undef PG8_LDB
#undef PG8_MMA
#undef PG8_WAIT_V
#undef PG8_WAIT_L
#undef PG8_BAR
#undef PG8_SCHED
}
}
#define LAS __attribute__((address_space(3)))
typedef unsigned short bf16_t;
typedef short bf16x8 __attribute__((ext_vector_type(8)));
typedef short bf16x4 __attribute__((ext_vector_type(4)));
typedef float f32x4 __attribute__((ext_vector_type(4)));
typedef float f32x2 __attribute__((ext_vector_type(2)));
typedef unsigned u32x4 __attribute__((ext_vector_type(4)));
typedef unsigned u32x2 __attribute__((ext_vector_type(2)));
typedef __bf16 bf16x2_t __attribute__((ext_vector_type(2)));

constexpr int T = 16384, D = 1024, SEQ = 2048;
constexpr float EPS = 1e-6f;
constexpr size_t MiB = 1u << 20;
constexpr int LDS_BYTES = 131072 + 2048;
#ifndef N_LAUNCH_SPLIT
#define N_LAUNCH_SPLIT 0
#endif

constexpr size_t W_MIXIN = 1 * MiB, W_UQ = 10 * MiB, W_UKV = 12 * MiB, W_MIXO = 13 * MiB, W_XQ = 15 * MiB, W_XKV = 17 * MiB, W_XO = 21 * MiB, W_1 = 23 * MiB, W_2 = 31 * MiB;
constexpr size_t WS_H = 39 * MiB, WS_MEMN = 71 * MiB, WS_MK = 75 * MiB, WS_MVT = 79 * MiB, WS_COS = 83 * MiB, WS_SIN = 85 * MiB, WS_AR = 87 * MiB;
constexpr size_t A_Z = WS_AR, A_CQN = WS_AR + 44 * MiB, A_CKVN = WS_AR + 56 * MiB, A_KROPE = WS_AR + 64 * MiB, A_Q = WS_AR + 66 * MiB, A_KNOPE = WS_AR + 114 * MiB, A_VT = WS_AR + 146 * MiB;
constexpr size_t G_PRE = WS_AR, G_POST = WS_AR + 96 * MiB, G_GATE = WS_AR + 192 * MiB, G_LOGIT = WS_AR + 224 * MiB, G_BETA = WS_AR + 225 * MiB, G_G = G_BETA + MiB / 2, G_GC = WS_AR + 226 * MiB;
constexpr size_t G_W = WS_AR, G_UT = WS_AR + 32 * MiB, G_ATT = WS_AR + 64 * MiB;
constexpr size_t WS_END = WS_AR + 227 * MiB;

__device__ __forceinline__ float shx(float v, int m, int lane) { return __int_as_float(__builtin_amdgcn_ds_bpermute((lane ^ m) << 2, __float_as_int(v))); }
__device__ __forceinline__ float wave_sum(float v, int lane) {
#pragma unroll
    for (int o = 32; o > 0; o >>= 1) v += shx(v, o, lane);
    return v;
}
__device__ __forceinline__ float bf2f(unsigned short b) { return __uint_as_float(((unsigned)b) << 16); }
__device__ __forceinline__ unsigned pk2(float lo, float hi) { f32x2 v = {lo, hi}; bf16x2_t b = __builtin_convertvector(v, bf16x2_t); return __builtin_bit_cast(unsigned, b); }
__device__ __forceinline__ unsigned short f2bf(float f) { return (unsigned short)(pk2(f, 0.f) & 0xffffu); }
__device__ __forceinline__ float silu_f(float x) { return x / (1.f + __expf(-x)); }
__device__ __forceinline__ u32x2 pk4(f32x4 v) { u32x2 r; r.x = pk2(v[0], v[1]); r.y = pk2(v[2], v[3]); return r; }
#define MFMA16(a, b, c) __builtin_amdgcn_mfma_f32_16x16x32_bf16((a), (b), (c), 0, 0, 0)

template <class F> struct EpiF {
    static constexpr bool PERM = false, AFTER_DRAIN = false;
    F f;
    __device__ __forceinline__ void operator()(const pg8::f32x4 (&acc)[2][2][4][2], const pg8::Unit& u, int wr, int wc, int fr, int fq) const {
#pragma unroll
        for (int ai = 0; ai < 2; ++ai)
#pragma unroll
            for (int m = 0; m < 4; ++m) {
                const int row = u.pm * 256 + ai * 128 + wr * 64 + m * 16 + fr;
#pragma unroll
                for (int bj = 0; bj < 2; ++bj)
#pragma unroll
                    for (int n = 0; n < 2; ++n) { const int col = u.pn * 256 + bj * 128 + wc * 32 + n * 16 + fq * 4; f(row, col, acc[ai][bj][m][n], bj); __builtin_amdgcn_sched_barrier(0); }
                asm volatile("" ::: "memory");
            }
    }
};
template <class F> __device__ __forceinline__ void run_gemm(LAS unsigned char* lds, const bf16_t* A, const bf16_t* Bt, int M, int N, int K, const F& f, const int wv) {
    pg8::Gemm g{A, Bt, M, N, K}; pg8::StaticOrder S; S.init(M, N, (int)gridDim.x, (int)blockIdx.x);
    EpiF<F> E{f};
    pg8::gemm_phase<EpiF<F>, pg8::StaticOrder, true, true>(lds, g, S, E, wv);
}
struct FResid { float* x; __device__ __forceinline__ void operator()(int row, int col, f32x4 v, int bj) const { f32x4* p = (f32x4*)(x + (size_t)row * D + col); *p = *p + v; } };
struct FBf16 { bf16_t* O; int ldc; __device__ __forceinline__ void operator()(int row, int col, f32x4 v, int bj) const { *(u32x2*)(O + (size_t)row * ldc + col) = pk4(v); } };
struct FRelu2 { bf16_t* O; int ldc; __device__ __forceinline__ void operator()(int row, int col, f32x4 v, int bj) const {
    f32x4 r; for (int e = 0; e < 4; ++e) { const float t = v[e] > 0.f ? v[e] : 0.f; r[e] = t * t; } *(u32x2*)(O + (size_t)row * ldc + col) = pk4(r); } };
struct FMlaIn { float* z; __device__ __forceinline__ void operator()(int row, int col, f32x4 v, int bj) const { if (col < 704) *(f32x4*)(z + (size_t)row * 704 + col) = v; } };
struct FMemKV { bf16_t* K; bf16_t* Vt; __device__ __forceinline__ void operator()(int row, int col, f32x4 v, int bj) const {
    if (col < 1024) { *(u32x2*)(K + (size_t)row * 1024 + col) = pk4(v); }
    else { const int c = col - 1024, hh = c >> 8, d = c & 255, b = row >> 8, m = row & 255; bf16_t* p = Vt + (size_t)(((b * 4 + hh) * 4 + (m >> 6)) * 16384 + d * 64 + (m & 63));
#pragma unroll
        for (int e = 0; e < 4; ++e) p[e * 64] = f2bf(v[e]); } } };
struct FUkv { bf16_t* kn; bf16_t* Vt; __device__ __forceinline__ void operator()(int row, int col, f32x4 v, int bj) const {
    const int hh = col >> 8, wi = col & 255;
    if (bj == 0) { *(u32x2*)(kn + (size_t)row * 1024 + hh * 128 + wi) = pk4(v); }
    else { const int d = wi - 128, b = row >> 11, s = row & 2047; bf16_t* p = Vt + (size_t)(((b * 8 + hh) * 32 + (s >> 6)) * 8192 + d * 64 + (s & 63));
#pragma unroll
        for (int e = 0; e < 4; ++e) p[e * 64] = f2bf(v[e]); } } };
struct FGdnIn { bf16_t* qkv; bf16_t* gate; float* logit; __device__ __forceinline__ void operator()(int row, int col, f32x4 v, int bj) const {
    if (col < 3072) *(u32x2*)(qkv + (size_t)row * 3072 + col) = pk4(v);
    else if (col < 4096) *(u32x2*)(gate + (size_t)row * 1024 + (col - 3072)) = pk4(v);
    else if (col < 4112) *(f32x4*)(logit + (size_t)row * 16 + (col - 4096)) = v; } };

__device__ __forceinline__ void conv_w(const float* __restrict__ W, int K, int Nvalid, int Npad, bf16_t* __restrict__ WT, LAS float* scr, int gw, int NGW, int lane) {
    const int nblk = Npad / 32, nitems = (K / 64) * nblk;
    for (int it = gw; it < nitems; it += NGW) {
        const int kb = it / nblk, nb = it - kb * nblk, k0 = 64 * kb, n0 = 32 * nb;
        const int n = n0 + (lane & 31);
#pragma unroll 8
        for (int i = 0; i < 32; ++i) { const int kk = 2 * i + (lane >> 5); scr[kk * 33 + (lane & 31)] = (n < Nvalid) ? W[(size_t)(k0 + kk) * Nvalid + n] : 0.f; }
        asm volatile("s_waitcnt lgkmcnt(0)" ::: "memory");
        const int c = lane & 7;
#pragma unroll
        for (int j = 0; j < 4; ++j) { const int nn = (lane >> 3) + 8 * j; const LAS float* s = scr + (8 * c) * 33 + nn;
            u32x4 o; o.x = pk2(s[0 * 33], s[1 * 33]); o.y = pk2(s[2 * 33], s[3 * 33]); o.z = pk2(s[4 * 33], s[5 * 33]); o.w = pk2(s[6 * 33], s[7 * 33]);
            *(u32x4*)(WT + (size_t)(n0 + nn) * K + k0 + 8 * c) = o; }
        asm volatile("s_waitcnt lgkmcnt(0)" ::: "memory");
    }
}
__device__ __forceinline__ void rms_row(const float* xrow, const float* g, bf16_t* orow, float* copy, int lane) {
    const f32x4* xr = (const f32x4*)xrow + lane; const f32x4* gr = (const f32x4*)g + lane;
    f32x4 v[4]; float s = 0.f;
#pragma unroll
    for (int j = 0; j < 4; ++j) { v[j] = xr[64 * j]; s += (v[j][0] * v[j][0] + v[j][1] * v[j][1]) + (v[j][2] * v[j][2] + v[j][3] * v[j][3]); }
    const float rstd = rsqrtf(wave_sum(s, lane) * (1.f / D) + EPS);
    u32x2* o8 = (u32x2*)orow + lane;
#pragma unroll
    for (int j = 0; j < 4; ++j) { if (copy) ((f32x4*)copy + lane)[64 * j] = v[j]; const f32x4 gg = gr[64 * j]; o8[64 * j] = pk4(v[j] * rstd * gg); }
}
__device__ __forceinline__ void rms_row_f32(float* xrow, const float* g, int lane) {
    f32x4* xr = (f32x4*)xrow + lane; const f32x4* gr = (const f32x4*)g + lane;
    f32x4 v[4]; float s = 0.f;
#pragma unroll
    for (int j = 0; j < 4; ++j) { v[j] = xr[64 * j]; s += (v[j][0] * v[j][0] + v[j][1] * v[j][1]) + (v[j][2] * v[j][2] + v[j][3] * v[j][3]); }
    const float rstd = rsqrtf(wave_sum(s, lane) * (1.f / D) + EPS);
#pragma unroll
    for (int j = 0; j < 4; ++j) xr[64 * j] = v[j] * rstd * gr[64 * j];
}

template <int DK1, int DK2, int DV, int RT, bool CAUSAL, bool ROPE>
__device__ __forceinline__ void attn_unit(LAS unsigned char* lds, const bf16_t* __restrict__ Q, int ldq, const bf16_t* __restrict__ K1, int ldk1, const bf16_t* __restrict__ K2, int ldk2,
                                          const bf16_t* __restrict__ Vt, int ldvt, int nkt, int q0, bf16_t* __restrict__ O, int ldo, float sl2, const float* __restrict__ cosr, const float* __restrict__ sinr, const int wv) {
    constexpr int DQK = DK1 + DK2, NKS = DQK / 32, NDT = DV / 16, KP = DQK + 8, VP = 72, KCH = DQK / 8;
    LAS bf16_t* Ks = (LAS bf16_t*)lds;
    LAS bf16_t* Vs = (LAS bf16_t*)(lds + 64 * KP * 2);
    const int tid = pg8::opq_tid(wv), lane = tid & 63, wid = tid >> 6, fr = lane & 15, fq = lane >> 4;
    const int wrow0 = wid * 16 * RT;
    bf16x8 qf[RT][NKS];
#pragma unroll
    for (int rt = 0; rt < RT; ++rt)
#pragma unroll
        for (int ks = 0; ks < NKS; ++ks) qf[rt][ks] = *(const bf16x8*)(Q + (size_t)(wrow0 + rt * 16 + fr) * ldq + ks * 32 + fq * 8);
    if (ROPE) {
#pragma unroll
        for (int rt = 0; rt < RT; ++rt) {
            const int row = wrow0 + rt * 16 + fr; constexpr int k1 = DK1 / 32;
            bf16x8 a = qf[rt][k1], b = qf[rt][k1 + 1], oa, ob;
#pragma unroll
            for (int j = 0; j < 8; ++j) { const float c = cosr[row * 32 + fq * 8 + j], s = sinr[row * 32 + fq * 8 + j];
                const float x1 = bf2f((unsigned short)a[j]), x2 = bf2f((unsigned short)b[j]);
                oa[j] = (short)f2bf(x1 * c - x2 * s); ob[j] = (short)f2bf(x2 * c + x1 * s); }
            qf[rt][k1] = oa; qf[rt][k1 + 1] = ob;
        }
    }
    float m_run[RT], l_run[RT]; f32x4 oacc[RT][NDT];
#pragma unroll
    for (int rt = 0; rt < RT; ++rt) { m_run[rt] = -INFINITY; l_run[rt] = 0.f;
#pragma unroll
        for (int dt = 0; dt < NDT; ++dt) oacc[rt][dt] = (f32x4){0.f, 0.f, 0.f, 0.f}; }
    for (int kt = 0; kt < nkt; ++kt) {
        __syncthreads();
#pragma unroll
        for (int i = 0; i < (64 * KCH) / 512; ++i) { const int id = tid + 512 * i, key = id / KCH, c = id - key * KCH;
            const bf16_t* src = (c < DK1 / 8) ? (K1 + (size_t)(kt * 64 + key) * ldk1 + c * 8) : (K2 + (size_t)(kt * 64 + key) * ldk2 + (c - DK1 / 8) * 8);
            *(LAS u32x4*)(Ks + key * KP + c * 8) = *(const u32x4*)src; }
#pragma unroll
        for (int i = 0; i < (DV * 8) / 512; ++i) { const int id = tid + 512 * i, d = id >> 3, c = id & 7;
            *(LAS u32x4*)(Vs + d * VP + c * 8) = *(const u32x4*)(Vt + (size_t)kt * (DV * 64) + d * 64 + c * 8); }
        __syncthreads();
        if (CAUSAL && kt * 64 > q0 + wrow0 + 16 * RT - 1) continue;
        f32x4 sacc[RT][4];
#pragma unroll
        for (int rt = 0; rt < RT; ++rt)
#pragma unroll
            for (int ct = 0; ct < 4; ++ct) sacc[rt][ct] = (f32x4){0.f, 0.f, 0.f, 0.f};
#pragma unroll
        for (int ct = 0; ct < 4; ++ct)
#pragma unroll
            for (int ks = 0; ks < NKS; ++ks) { const bf16x8 kf = *(const LAS bf16x8*)(Ks + (ct * 16 + fr) * KP + ks * 32 + fq * 8);
#pragma unroll
                for (int rt = 0; rt < RT; ++rt) sacc[rt][ct] = MFMA16(kf, qf[rt][ks], sacc[rt][ct]);
                if ((ks & 1) == 1) __builtin_amdgcn_sched_barrier(0); }
        const bool need_mask = CAUSAL && (kt * 64 + 63 > q0 + wrow0);
        bf16x8 pf[RT][2];
#pragma unroll
        for (int rt = 0; rt < RT; ++rt) {
            const int qi = q0 + wrow0 + rt * 16 + fr;
            float mx = -INFINITY;
#pragma unroll
            for (int ct = 0; ct < 4; ++ct)
#pragma unroll
                for (int e = 0; e < 4; ++e) { float s = sacc[rt][ct][e] * sl2; if (need_mask && (kt * 64 + ct * 16 + fq * 4 + e > qi)) s = -INFINITY; sacc[rt][ct][e] = s; mx = fmaxf(mx, s); }
            mx = fmaxf(mx, shx(mx, 16, lane)); mx = fmaxf(mx, shx(mx, 32, lane));
            const float m_new = fmaxf(m_run[rt], mx);
            const float alpha = exp2f(m_run[rt] - m_new); m_run[rt] = m_new;
            float ls = 0.f;
#pragma unroll
            for (int ct = 0; ct < 4; ++ct)
#pragma unroll
                for (int e = 0; e < 4; ++e) { const float p = exp2f(sacc[rt][ct][e] - m_new); sacc[rt][ct][e] = p; ls += p; }
            l_run[rt] = l_run[rt] * alpha + ls;
#pragma unroll
            for (int dt = 0; dt < NDT; ++dt) oacc[rt][dt] = oacc[rt][dt] * alpha;
#pragma unroll
            for (int s2 = 0; s2 < 2; ++s2) { u32x4 w; w.x = pk2(sacc[rt][2 * s2][0], sacc[rt][2 * s2][1]); w.y = pk2(sacc[rt][2 * s2][2], sacc[rt][2 * s2][3]);
                w.z = pk2(sacc[rt][2 * s2 + 1][0], sacc[rt][2 * s2 + 1][1]); w.w = pk2(sacc[rt][2 * s2 + 1][2], sacc[rt][2 * s2 + 1][3]); pf[rt][s2] = __builtin_bit_cast(bf16x8, w); }
        }
#pragma unroll
        for (int dt = 0; dt < NDT; ++dt)
#pragma unroll
            for (int s2 = 0; s2 < 2; ++s2) {
                const bf16x4 lo = *(const LAS bf16x4*)(Vs + (dt * 16 + fr) * VP + s2 * 32 + fq * 4);
                const bf16x4 hi = *(const LAS bf16x4*)(Vs + (dt * 16 + fr) * VP + s2 * 32 + 16 + fq * 4);
                const bf16x8 vf = __builtin_shufflevector(lo, hi, 0, 1, 2, 3, 4, 5, 6, 7);
#pragma unroll
                for (int rt = 0; rt < RT; ++rt) oacc[rt][dt] = MFMA16(vf, pf[rt][s2], oacc[rt][dt]);
                if (s2 == 1) __builtin_amdgcn_sched_barrier(0);
            }
    }
#pragma unroll
    for (int rt = 0; rt < RT; ++rt) {
        float l = l_run[rt]; l += shx(l, 16, lane); l += shx(l, 32, lane);
        const float inv = 1.f / l;
        bf16_t* orow = O + (size_t)(wrow0 + rt * 16 + fr) * ldo + fq * 4;
#pragma unroll
        for (int dt = 0; dt < NDT; ++dt) *(u32x2*)(orow + dt * 16) = pk4(oacc[rt][dt] * inv);
    }
}
__device__ __forceinline__ bf16x8 ldsfrag(const LAS bf16_t* base, int pitch, int row, int k) { return *(const LAS bf16x8*)(base + row * pitch + k); }

__device__ __forceinline__ void gdn_conv_phase(const bf16_t* __restrict__ pre, bf16_t* __restrict__ post, const float* __restrict__ convw, const float* __restrict__ logit,
                                               const float* __restrict__ a_log, const float* __restrict__ dt_bias, float* __restrict__ beta, float* __restrict__ g, int gw, int NGW, int lane, int gtid, int NT) {
    for (int it = gw; it < T * 24; it += NGW) {
        const int r = it / 24, grp = it - r * 24, t = r & (SEQ - 1), col = grp * 128 + 2 * lane;
        float a0 = 0.f, a1 = 0.f;
#pragma unroll
        for (int j = 0; j < 4; ++j) { if (t - 3 + j >= 0) { const unsigned x = *(const unsigned*)(pre + (size_t)(r - 3 + j) * 3072 + col);
            const f32x2 w = *(const f32x2*)(convw + j * 3072 + col); a0 += w[0] * bf2f((unsigned short)(x & 0xffffu)); a1 += w[1] * bf2f((unsigned short)(x >> 16)); } }
        float y0 = silu_f(a0), y1 = silu_f(a1);
        if (grp < 16) { const float ss = wave_sum(y0 * y0 + y1 * y1, lane); const float sc = rsqrtf(ss + EPS) * (grp < 8 ? 0.08838834764831845f : 1.f); y0 *= sc; y1 *= sc; }
        *(unsigned*)(post + (size_t)r * 3072 + col) = pk2(y0, y1);
    }
    for (int i = gtid; i < T * 8; i += NT) { const int r = i >> 3, h = i & 7; const float bl = logit[r * 16 + h], al = logit[r * 16 + 8 + h];
        beta[i] = 1.f / (1.f + expf(-bl)); const float xx = al + dt_bias[h]; const float sp = xx > 20.f ? xx : log1pf(expf(xx)); g[i] = -expf(a_log[h]) * sp; }
}

__device__ __forceinline__ void gdn_chunk_phase(LAS unsigned char* lds, const bf16_t* __restrict__ post, const float* __restrict__ beta, const float* __restrict__ g,
                                                bf16_t* __restrict__ Wc, bf16_t* __restrict__ UT, bf16_t* __restrict__ ATT, float* __restrict__ GC, const int wv) {
    constexpr int KP = 136, TP = 72;
    LAS bf16_t* kS = (LAS bf16_t*)lds; LAS bf16_t* qS = (LAS bf16_t*)(lds + 17408); LAS bf16_t* vbT = (LAS bf16_t*)(lds + 34816); LAS bf16_t* kbgT = (LAS bf16_t*)(lds + 53248);
    LAS float* Mm = (LAS float*)(lds + 71680); LAS bf16_t* Ti = (LAS bf16_t*)(lds + 88064); LAS float* gcS = (LAS float*)(lds + 97280); LAS float* btS = (LAS float*)(lds + 97536);
    const int tid = pg8::opq_tid(wv), lane = tid & 63, wid = tid >> 6, fr = lane & 15, fq = lane >> 4;
    for (int unit = blockIdx.x; unit < 2048; unit += gridDim.x) {
        const int b = unit >> 8, h = (unit >> 5) & 7, n = unit & 31, r0 = b * SEQ + n * 64;
        __syncthreads();
        if (wid == 0) { float gv = g[(size_t)(r0 + lane) * 8 + h];
#pragma unroll
            for (int o = 1; o < 64; o <<= 1) { const float up = __int_as_float(__builtin_amdgcn_ds_bpermute(((lane - o) & 63) << 2, __float_as_int(gv))); if (lane >= o) gv += up; }
            gcS[lane] = gv; btS[lane] = beta[(size_t)(r0 + lane) * 8 + h]; GC[(size_t)unit * 64 + lane] = gv; }
        __syncthreads();
#pragma unroll
        for (int i = 0; i < 2; ++i) { const int id = tid + 512 * i, pos = id & 63, c8 = id >> 6;
            const bf16_t* rowp = post + (size_t)(r0 + pos) * 3072 + h * 128 + c8 * 8;
            const u32x4 qv = *(const u32x4*)rowp, kv = *(const u32x4*)(rowp + 1024), vv = *(const u32x4*)(rowp + 2048);
            *(LAS u32x4*)(qS + pos * KP + c8 * 8) = qv; *(LAS u32x4*)(kS + pos * KP + c8 * 8) = kv;
            const float bt = btS[pos], sc = bt * __expf(gcS[pos]);
            const bf16x8 k8 = __builtin_bit_cast(bf16x8, kv), v8 = __builtin_bit_cast(bf16x8, vv);
#pragma unroll
            for (int e = 0; e < 8; ++e) { kbgT[(c8 * 8 + e) * TP + pos] = f2bf(bf2f((unsigned short)k8[e]) * sc); vbT[(c8 * 8 + e) * TP + pos] = f2bf(bf2f((unsigned short)v8[e]) * bt); } }
        __syncthreads();
#pragma unroll
        for (int tt = 0; tt < 2; ++tt) { const int t = wid + 8 * tt, it = t >> 2, jt = t & 3; const int i = it * 16 + fr, j0 = jt * 16 + fq * 4;
            bf16_t* ap = ATT + (size_t)unit * 4096 + i * 64 + j0;
            if (jt <= it) {
                f32x4 aK = {0.f, 0.f, 0.f, 0.f}, aQ = {0.f, 0.f, 0.f, 0.f};
#pragma unroll
                for (int ks = 0; ks < 4; ++ks) { const bf16x8 kj = ldsfrag(kS, KP, jt * 16 + fr, ks * 32 + fq * 8), ki = ldsfrag(kS, KP, it * 16 + fr, ks * 32 + fq * 8), qi = ldsfrag(qS, KP, it * 16 + fr, ks * 32 + fq * 8);
                    aK = MFMA16(kj, ki, aK); aQ = MFMA16(kj, qi, aQ); }
                const float gi = gcS[i], bi = btS[i]; f32x4 mm, at;
#pragma unroll
                for (int e = 0; e < 4; ++e) { const int j = j0 + e; const float dec = (i >= j) ? __expf(gi - gcS[j]) : 0.f; mm[e] = (i > j) ? bi * aK[e] * dec : 0.f; at[e] = aQ[e] * dec; }
                *(LAS f32x4*)(Mm + i * 64 + j0) = mm; *(u32x2*)ap = pk4(at);
            } else { *(u32x2*)ap = (u32x2){0u, 0u}; }
        }
        __syncthreads();
        if (wid == 0) {
            float x[64]; int ln = lane; asm volatile("" : "+v"(ln)); int zv = 0; asm volatile("" : "+v"(zv)); const LAS float* Mv = Mm + zv;
#pragma unroll
            for (int i = 0; i < 64; ++i) {
                int dl = i - ln; dl = dl < 0 ? -dl : dl; dl = 1 - dl; dl = dl < 0 ? 0 : dl; float s0 = (float)dl, s1 = 0.f, s2 = 0.f, s3 = 0.f;
#pragma unroll
                for (int j4 = 0; j4 < (i + 3) / 4; ++j4) { const f32x4 m = *(const LAS f32x4*)(Mv + i * 64 + j4 * 4);
                    if (j4 * 4 + 0 < i) s0 -= m[0] * x[j4 * 4 + 0]; if (j4 * 4 + 1 < i) s1 -= m[1] * x[j4 * 4 + 1];
                    if (j4 * 4 + 2 < i) s2 -= m[2] * x[j4 * 4 + 2]; if (j4 * 4 + 3 < i) s3 -= m[3] * x[j4 * 4 + 3]; }
                x[i] = (s0 + s1) + (s2 + s3);
                Ti[i * TP + lane] = f2bf(x[i]);
            }
        }
        __syncthreads();
#pragma unroll
        for (int q = 0; q < 4; ++q) { const int t = wid * 4 + q, pt = t >> 3, dt = t & 7;
            f32x4 aU = {0.f, 0.f, 0.f, 0.f}, aW = {0.f, 0.f, 0.f, 0.f};
#pragma unroll
            for (int ks = 0; ks < 2; ++ks) { const bf16x8 tf = ldsfrag(Ti, TP, pt * 16 + fr, ks * 32 + fq * 8);
                aU = MFMA16(tf, ldsfrag(vbT, TP, dt * 16 + fr, ks * 32 + fq * 8), aU);
                aW = MFMA16(ldsfrag(kbgT, TP, dt * 16 + fr, ks * 32 + fq * 8), tf, aW); }
            *(u32x2*)(UT + (size_t)unit * 8192 + (dt * 16 + fr) * 64 + pt * 16 + fq * 4) = pk4(aU);
            *(u32x2*)(Wc + (size_t)unit * 8192 + (pt * 16 + fr) * 128 + dt * 16 + fq * 4) = pk4(aW);
        }
    }
}

__device__ __forceinline__ void gdn_seq_phase(LAS unsigned char* lds, const bf16_t* __restrict__ post, const bf16_t* __restrict__ Wc, const bf16_t* __restrict__ UT, const bf16_t* __restrict__ ATT,
                                              const float* __restrict__ GC, const bf16_t* __restrict__ gate, const float* __restrict__ o_norm, bf16_t* __restrict__ out, const int wv) {
    constexpr int KP = 136, TP = 72;
    LAS bf16_t* wS = (LAS bf16_t*)lds; LAS bf16_t* qgS = (LAS bf16_t*)(lds + 17408); LAS bf16_t* kdT = (LAS bf16_t*)(lds + 34816); LAS bf16_t* atS = (LAS bf16_t*)(lds + 53248);
    LAS bf16_t* StT = (LAS bf16_t*)(lds + 62464); LAS bf16_t* vnT = (LAS bf16_t*)(lds + 97280); LAS float* part = (LAS float*)(lds + 115712);
    const int tid = pg8::opq_tid(wv), lane = tid & 63, wid = tid >> 6, fr = lane & 15, fq = lane >> 4;
    const int dvr = 16 * wid + fr;
    for (int item = blockIdx.x; item < 64; item += gridDim.x) {
        const int b = item >> 3, h = item & 7;
        f32x4 sacc[8];
#pragma unroll
        for (int mt = 0; mt < 8; ++mt) { sacc[mt] = (f32x4){0.f, 0.f, 0.f, 0.f}; *(LAS u32x2*)(StT + dvr * KP + mt * 16 + fq * 4) = (u32x2){0u, 0u}; }
        const float gn = o_norm[dvr];
        for (int n = 0; n < 32; ++n) {
            const int unit = item * 32 + n, r0 = b * SEQ + n * 64;
            const float glast = GC[(size_t)unit * 64 + 63];
            __syncthreads();
#pragma unroll
            for (int i = 0; i < 2; ++i) { const int id = tid + 512 * i;
                { const int pos = id >> 4, c8 = id & 15;
                  *(LAS u32x4*)(wS + pos * KP + c8 * 8) = *(const u32x4*)(Wc + (size_t)unit * 8192 + pos * 128 + c8 * 8);
                  const bf16x8 q8 = *(const bf16x8*)(post + (size_t)(r0 + pos) * 3072 + h * 128 + c8 * 8); const float eg = __expf(GC[(size_t)unit * 64 + pos]);
                  u32x4 w; w.x = pk2(bf2f((unsigned short)q8[0]) * eg, bf2f((unsigned short)q8[1]) * eg); w.y = pk2(bf2f((unsigned short)q8[2]) * eg, bf2f((unsigned short)q8[3]) * eg);
                  w.z = pk2(bf2f((unsigned short)q8[4]) * eg, bf2f((unsigned short)q8[5]) * eg); w.w = pk2(bf2f((unsigned short)q8[6]) * eg, bf2f((unsigned short)q8[7]) * eg);
                  *(LAS u32x4*)(qgS + pos * KP + c8 * 8) = w; }
                { const int pos = id & 63, c8 = id >> 6;
                  const bf16x8 k8 = *(const bf16x8*)(post + (size_t)(r0 + pos) * 3072 + 1024 + h * 128 + c8 * 8); const float sc = __expf(glast - GC[(size_t)unit * 64 + pos]);
#pragma unroll
                  for (int e = 0; e < 8; ++e) kdT[(c8 * 8 + e) * TP + pos] = f2bf(bf2f((unsigned short)k8[e]) * sc); } }
            { const int i = tid >> 3, c8 = tid & 7; *(LAS u32x4*)(atS + i * TP + c8 * 8) = *(const u32x4*)(ATT + (size_t)unit * 4096 + i * 64 + c8 * 8); }
            __syncthreads();
            f32x4 o[4];
#pragma unroll
            for (int rt = 0; rt < 4; ++rt) { f32x4 acc = {0.f, 0.f, 0.f, 0.f};
#pragma unroll
                for (int ks = 0; ks < 4; ++ks) acc = MFMA16(ldsfrag(wS, KP, rt * 16 + fr, ks * 32 + fq * 8), ldsfrag(StT, KP, dvr, ks * 32 + fq * 8), acc);
                const bf16x4 u4 = *(const bf16x4*)(UT + (size_t)unit * 8192 + dvr * 64 + rt * 16 + fq * 4);
                f32x4 vn; for (int e = 0; e < 4; ++e) vn[e] = bf2f((unsigned short)u4[e]) - acc[e];
                *(LAS u32x2*)(vnT + dvr * TP + rt * 16 + fq * 4) = pk4(vn); }
#pragma unroll
            for (int rt = 0; rt < 4; ++rt) { f32x4 acc = {0.f, 0.f, 0.f, 0.f};
#pragma unroll
                for (int ks = 0; ks < 4; ++ks) acc = MFMA16(ldsfrag(qgS, KP, rt * 16 + fr, ks * 32 + fq * 8), ldsfrag(StT, KP, dvr, ks * 32 + fq * 8), acc);
#pragma unroll
                for (int ks = 0; ks < 2; ++ks) acc = MFMA16(ldsfrag(atS, TP, rt * 16 + fr, ks * 32 + fq * 8), ldsfrag(vnT, TP, dvr, ks * 32 + fq * 8), acc);
                o[rt] = acc; }
            const float egl = __expf(glast);
#pragma unroll
            for (int mt = 0; mt < 8; ++mt) { f32x4 acc = sacc[mt] * egl;
#pragma unroll
                for (int ks = 0; ks < 2; ++ks) acc = MFMA16(ldsfrag(kdT, TP, mt * 16 + fr, ks * 32 + fq * 8), ldsfrag(vnT, TP, dvr, ks * 32 + fq * 8), acc);
                sacc[mt] = acc; *(LAS u32x2*)(StT + dvr * KP + mt * 16 + fq * 4) = pk4(acc); }
#pragma unroll
            for (int rt = 0; rt < 4; ++rt) { f32x4 ss = o[rt] * o[rt];
#pragma unroll
                for (int sh = 1; sh < 16; sh <<= 1) { ss[0] += shx(ss[0], sh, lane); ss[1] += shx(ss[1], sh, lane); ss[2] += shx(ss[2], sh, lane); ss[3] += shx(ss[3], sh, lane); }
                if (fr == 0) *(LAS f32x4*)(part + wid * 64 + rt * 16 + fq * 4) = ss; }
            __syncthreads();
#pragma unroll
            for (int rt = 0; rt < 4; ++rt) { f32x4 tot = {0.f, 0.f, 0.f, 0.f};
#pragma unroll
                for (int w = 0; w < 8; ++w) tot += *(const LAS f32x4*)(part + w * 64 + rt * 16 + fq * 4);
#pragma unroll
                for (int e = 0; e < 4; ++e) { const int pos = rt * 16 + fq * 4 + e; const size_t oi = (size_t)(r0 + pos) * 1024 + h * 128 + dvr;
                    const float rstd = rsqrtf(tot[e] * (1.f / 128.f) + EPS); const float gt = bf2f(gate[oi]);
                    out[oi] = f2bf(o[rt][e] * rstd * gn * silu_f(gt)); } }
        }
    }
}

__device__ __forceinline__ void mla_mid_phase(const float* __restrict__ z, const float* __restrict__ qn, const float* __restrict__ kvn, const float* __restrict__ cosb, const float* __restrict__ sinb,
                                              bf16_t* __restrict__ cqn, bf16_t* __restrict__ ckvn, bf16_t* __restrict__ krope, int gw, int NGW, int lane) {
    for (int r = gw; r < T; r += NGW) {
        const float* zr = z + (size_t)r * 704;
        f32x2 a[3]; float s = 0.f;
#pragma unroll
        for (int i = 0; i < 3; ++i) { a[i] = *(const f32x2*)(zr + 2 * lane + 128 * i); s += a[i][0] * a[i][0] + a[i][1] * a[i][1]; }
        float rstd = rsqrtf(wave_sum(s, lane) * (1.f / 384.f) + EPS);
#pragma unroll
        for (int i = 0; i < 3; ++i) { const f32x2 gg = *(const f32x2*)(qn + 2 * lane + 128 * i); *(unsigned*)(cqn + (size_t)r * 384 + 2 * lane + 128 * i) = pk2(a[i][0] * rstd * gg[0], a[i][1] * rstd * gg[1]); }
        f32x2 c[2]; s = 0.f;
#pragma unroll
        for (int i = 0; i < 2; ++i) { c[i] = *(const f32x2*)(zr + 384 + 2 * lane + 128 * i); s += c[i][0] * c[i][0] + c[i][1] * c[i][1]; }
        rstd = rsqrtf(wave_sum(s, lane) * (1.f / 256.f) + EPS);
#pragma unroll
        for (int i = 0; i < 2; ++i) { const f32x2 gg = *(const f32x2*)(kvn + 2 * lane + 128 * i); *(unsigned*)(ckvn + (size_t)r * 256 + 2 * lane + 128 * i) = pk2(c[i][0] * rstd * gg[0], c[i][1] * rstd * gg[1]); }
        const float v = zr[640 + lane], pv = shx(v, 32, lane); const int i = lane & 31; const float cs = cosb[(size_t)r * 32 + i], sn = sinb[(size_t)r * 32 + i];
        const float outv = (lane < 32) ? (v * cs - pv * sn) : (v * cs + pv * sn);
        krope[(size_t)r * 64 + lane] = f2bf(outv);
    }
}
__device__ __forceinline__ void sc_mid_phase(const bf16_t* __restrict__ z, const float* __restrict__ cw, bf16_t* __restrict__ y, int gtid, int NT) {
    for (int it = gtid; it < T * 128; it += NT) {
        const int r = it >> 7, c8 = it & 127, t = r & (SEQ - 1), col = c8 * 8;
        float acc[8];
#pragma unroll
        for (int e = 0; e < 8; ++e) acc[e] = 0.f;
#pragma unroll
        for (int j = 0; j < 3; ++j) { if (t - 2 + j >= 0) { const bf16_t* zr = z + (size_t)(r - 2 + j) * 3072 + col;
            const bf16x8 cg8 = *(const bf16x8*)(zr + 1024), u8 = *(const bf16x8*)(zr + 2048); const f32x4 w0 = *(const f32x4*)(cw + j * 1024 + col), w1 = *(const f32x4*)(cw + j * 1024 + col + 4);
#pragma unroll
            for (int e = 0; e < 8; ++e) acc[e] += (e < 4 ? w0[e] : w1[e - 4]) * (bf2f((unsigned short)cg8[e]) * bf2f((unsigned short)u8[e])); } }
        const bf16x8 b8 = *(const bf16x8*)(z + (size_t)r * 3072 + col);
        u32x4 o; o.x = pk2(acc[0] * bf2f((unsigned short)b8[0]), acc[1] * bf2f((unsigned short)b8[1])); o.y = pk2(acc[2] * bf2f((unsigned short)b8[2]), acc[3] * bf2f((unsigned short)b8[3]));
        o.z = pk2(acc[4] * bf2f((unsigned short)b8[4]), acc[5] * bf2f((unsigned short)b8[5])); o.w = pk2(acc[6] * bf2f((unsigned short)b8[6]), acc[7] * bf2f((unsigned short)b8[7]));
        *(u32x4*)(y + (size_t)r * 1024 + col) = o;
    }
}
struct Params { const float* in[28]; float* out; unsigned char* ws; int L, pad; };
enum { PH_PREP = 0, PH_IN_MLA, PH_IN_GDN, PH_IN_SC, PH_MLA_MID, PH_MLA_UP, PH_MLA_ATTN, PH_GDN_CONV, PH_GDN_CHUNK, PH_GDN_SEQ, PH_SC_MID, PH_OPROJ,
       PH_XNORM, PH_XQ, PH_XATTN, PH_XO, PH_MNORM, PH_MUP, PH_MDOWN, PH_FINAL, PH_COUNT };

template <int PH> __device__ __forceinline__ void run_phase(const Params& p, const int L, LAS unsigned char* lds, const int wv) {
    const int tid = pg8::opq_tid(wv), lane = tid & 63, wid = tid >> 6;
    const int G = gridDim.x, gw = blockIdx.x * 8 + wid, NGW = G * 8, gtid = blockIdx.x * 512 + tid, NT = G * 512;
    unsigned char* ws = p.ws;
    float* X = p.out;
    bf16_t* H = (bf16_t*)(ws + WS_H); bf16_t* MEMN = (bf16_t*)(ws + WS_MEMN); bf16_t* MK = (bf16_t*)(ws + WS_MK); bf16_t* MVT = (bf16_t*)(ws + WS_MVT);
    float* COS = (float*)(ws + WS_COS); float* SIN = (float*)(ws + WS_SIN);
    bf16_t* Wmixin = (bf16_t*)(ws + W_MIXIN); bf16_t* Wuq = (bf16_t*)(ws + W_UQ); bf16_t* Wukv = (bf16_t*)(ws + W_UKV); bf16_t* Wmixo = (bf16_t*)(ws + W_MIXO);
    bf16_t* Wxq = (bf16_t*)(ws + W_XQ); bf16_t* Wxkv = (bf16_t*)(ws + W_XKV); bf16_t* Wxo = (bf16_t*)(ws + W_XO); bf16_t* W1 = (bf16_t*)(ws + W_1); bf16_t* W2 = (bf16_t*)(ws + W_2);
    const int kind = L % 3, j = L / 3;
    if constexpr (PH == PH_PREP) {
        const float* xin = p.in[0]; const float* mem = p.in[1]; const int* positions = (const int*)p.in[2];
        LAS float* scr = (LAS float*)(lds + wid * 16384);
        if (kind == 0) {
            conv_w(p.in[3] + (size_t)j * 1024 * 704, 1024, 704, 768, Wmixin, scr, gw, NGW, lane);
            conv_w(p.in[6] + (size_t)j * 384 * 1536, 384, 1536, 1536, Wuq, scr, gw, NGW, lane);
            conv_w(p.in[7] + (size_t)j * 256 * 2048, 256, 2048, 2048, Wukv, scr, gw, NGW, lane);
            conv_w(p.in[8] + (size_t)j * 1024 * 1024, 1024, 1024, 1024, Wmixo, scr, gw, NGW, lane);
        } else if (kind == 1) {
            conv_w(p.in[9], 1024, 4112, 4352, Wmixin, scr, gw, NGW, lane);
            conv_w(p.in[14], 1024, 1024, 1024, Wmixo, scr, gw, NGW, lane);
        } else {
            conv_w(p.in[15], 1024, 3072, 3072, Wmixin, scr, gw, NGW, lane);
            conv_w(p.in[17], 1024, 1024, 1024, Wmixo, scr, gw, NGW, lane);
        }
        conv_w(p.in[21] + (size_t)L * 1024 * 1024, 1024, 1024, 1024, Wxq, scr, gw, NGW, lane);
        conv_w(p.in[22] + (size_t)L * 1024 * 2048, 1024, 2048, 2048, Wxkv, scr, gw, NGW, lane);
        conv_w(p.in[23] + (size_t)L * 1024 * 1024, 1024, 1024, 1024, Wxo, scr, gw, NGW, lane);
        conv_w(p.in[24] + (size_t)L * 1024 * 4096, 1024, 4096, 4096, W1, scr, gw, NGW, lane);
        conv_w(p.in[25] + (size_t)L * 4096 * 1024, 4096, 1024, 1024, W2, scr, gw, NGW, lane);
        for (int r = gw; r < T; r += NGW) rms_row((L == 0 ? xin : X) + (size_t)r * D, p.in[18] + L * D, H + (size_t)r * D, L == 0 ? X + (size_t)r * D : nullptr, lane);
        if (L == 0) {
            for (int r = gw; r < 2048; r += NGW) rms_row(mem + (size_t)r * D, p.in[26], MEMN + (size_t)r * D, nullptr, lane);
            for (int i = gtid; i < T * 32; i += NT) { const int r = i >> 5, k = i & 31; const float inv = exp2f(-(float)k * (13.287712379549449f / 32.f));
                const float ang = (float)positions[r] * inv; double rev = (double)ang * 0.15915494309189535; rev -= rint(rev); const float rr = (float)(rev * 6.283185307179586);
                COS[i] = cosf(rr); SIN[i] = sinf(rr); }
        }
    } else if constexpr (PH == PH_IN_MLA) {
        run_gemm(lds, H, Wmixin, T, 768, 1024, FMlaIn{(float*)(ws + A_Z)}, wv);
        run_gemm(lds, MEMN, Wxkv, 2048, 2048, 1024, FMemKV{MK, MVT}, wv);
    } else if constexpr (PH == PH_IN_GDN) {
        run_gemm(lds, H, Wmixin, T, 4352, 1024, FGdnIn{(bf16_t*)(ws + G_PRE), (bf16_t*)(ws + G_GATE), (float*)(ws + G_LOGIT)}, wv);
        run_gemm(lds, MEMN, Wxkv, 2048, 2048, 1024, FMemKV{MK, MVT}, wv);
    } else if constexpr (PH == PH_IN_SC) {
        run_gemm(lds, H, Wmixin, T, 3072, 1024, FBf16{(bf16_t*)(ws + WS_AR), 3072}, wv);
        run_gemm(lds, MEMN, Wxkv, 2048, 2048, 1024, FMemKV{MK, MVT}, wv);
    } else if constexpr (PH == PH_MLA_MID) {
        mla_mid_phase((const float*)(ws + A_Z), p.in[4] + j * 384, p.in[5] + j * 256, COS, SIN, (bf16_t*)(ws + A_CQN), (bf16_t*)(ws + A_CKVN), (bf16_t*)(ws + A_KROPE), gw, NGW, lane);
    } else if constexpr (PH == PH_MLA_UP) {
#ifndef UPSEL
#define UPSEL 3
#endif
        if (UPSEL & 1) run_gemm(lds, (const bf16_t*)(ws + A_CQN), Wuq, T, 1536, 384, FBf16{(bf16_t*)(ws + A_Q), 1536}, wv);
        if (UPSEL & 2) run_gemm(lds, (const bf16_t*)(ws + A_CKVN), Wukv, T, 2048, 256, FUkv{(bf16_t*)(ws + A_KNOPE), (bf16_t*)(ws + A_VT)}, wv);
    } else if constexpr (PH == PH_MLA_ATTN) {
        const bf16_t* Qb = (const bf16_t*)(ws + A_Q); const bf16_t* Kn = (const bf16_t*)(ws + A_KNOPE); const bf16_t* Kr = (const bf16_t*)(ws + A_KROPE); const bf16_t* Vt = (const bf16_t*)(ws + A_VT);
        for (int item = blockIdx.x; item < 256; item += G) {
            const int bh = item >> 2, s = item & 3, b = bh >> 3, h = bh & 7;
            for (int pass = 0; pass < 2; ++pass) { const int qb = pass ? 7 - s : s; const size_t row0 = (size_t)b * SEQ + qb * 256;
                attn_unit<128, 64, 128, 2, true, true>(lds, Qb + row0 * 1536 + h * 192, 1536, Kn + (size_t)b * SEQ * 1024 + h * 128, 1024, Kr + (size_t)b * SEQ * 64, 64,
                    Vt + (size_t)(b * 8 + h) * 128 * 2048, 64, (qb + 1) * 4, qb * 256, H + row0 * 1024 + h * 128, 1024, 0.07216878364870322f * 1.4426950408889634f, COS + row0 * 32, SIN + row0 * 32, wv); }
        }
    } else if constexpr (PH == PH_GDN_CONV) {
        gdn_conv_phase((const bf16_t*)(ws + G_PRE), (bf16_t*)(ws + G_POST), p.in[10], (const float*)(ws + G_LOGIT), p.in[11], p.in[12], (float*)(ws + G_BETA), (float*)(ws + G_G), gw, NGW, lane, gtid, NT);
    } else if constexpr (PH == PH_GDN_CHUNK) {
        gdn_chunk_phase(lds, (const bf16_t*)(ws + G_POST), (const float*)(ws + G_BETA), (const float*)(ws + G_G), (bf16_t*)(ws + G_W), (bf16_t*)(ws + G_UT), (bf16_t*)(ws + G_ATT), (float*)(ws + G_GC), wv);
    } else if constexpr (PH == PH_GDN_SEQ) {
        gdn_seq_phase(lds, (const bf16_t*)(ws + G_POST), (const bf16_t*)(ws + G_W), (const bf16_t*)(ws + G_UT), (const bf16_t*)(ws + G_ATT), (const float*)(ws + G_GC), (const bf16_t*)(ws + G_GATE), p.in[13], H, wv);
    } else if constexpr (PH == PH_SC_MID) {
        sc_mid_phase((const bf16_t*)(ws + WS_AR), p.in[16], H, gtid, NT);
    } else if constexpr (PH == PH_OPROJ) {
        run_gemm(lds, H, Wmixo, T, 1024, 1024, FResid{X}, wv);
    } else if constexpr (PH == PH_XNORM) {
        for (int r = gw; r < T; r += NGW) rms_row(X + (size_t)r * D, p.in[19] + L * D, H + (size_t)r * D, nullptr, lane);
    } else if constexpr (PH == PH_XQ) {
        run_gemm(lds, H, Wxq, T, 1024, 1024, FBf16{(bf16_t*)(ws + WS_AR), 1024}, wv);
    } else if constexpr (PH == PH_XATTN) {
        const bf16_t* Qb = (const bf16_t*)(ws + WS_AR);
        for (int item = blockIdx.x; item < 512; item += G) { const int b = item >> 6, h = (item >> 4) & 3, qb = item & 15; const size_t row0 = (size_t)b * SEQ + qb * 128;
            attn_unit<256, 0, 256, 1, false, false>(lds, Qb + row0 * 1024 + h * 256, 1024, MK + (size_t)b * 256 * 1024 + h * 256, 1024, MK, 0,
                MVT + (size_t)(b * 4 + h) * 256 * 256, 64, 4, 0, H + row0 * 1024 + h * 256, 1024, 0.0625f * 1.4426950408889634f, COS, SIN, wv); }
    } else if constexpr (PH == PH_XO) {
        run_gemm(lds, H, Wxo, T, 1024, 1024, FResid{X}, wv);
    } else if constexpr (PH == PH_MNORM) {
        for (int r = gw; r < T; r += NGW) rms_row(X + (size_t)r * D, p.in[20] + L * D, H + (size_t)r * D, nullptr, lane);
    } else if constexpr (PH == PH_MUP) {
        run_gemm(lds, H, W1, T, 4096, 1024, FRelu2{(bf16_t*)(ws + WS_AR), 4096}, wv);
    } else if constexpr (PH == PH_MDOWN) {
        run_gemm(lds, (const bf16_t*)(ws + WS_AR), W2, T, 1024, 4096, FResid{X}, wv);
    } else if constexpr (PH == PH_FINAL) {
        for (int r = gw; r < T; r += NGW) rms_row_f32(X + (size_t)r * D, p.in[27], lane);
    }
}

#ifndef N_LAUNCH_SPLIT
#define N_LAUNCH_SPLIT 1
#endif
#if N_LAUNCH_SPLIT
template <int PH> __global__ void __launch_bounds__(512) k_phase(Params p) {
    extern __shared__ __attribute__((aligned(16))) unsigned char lds_raw[];
    run_phase<PH>(p, p.L, (LAS unsigned char*)lds_raw, __builtin_amdgcn_readfirstlane((int)threadIdx.x >> 6));
}
template <int PH> static void launch_phase(Params p, int L, int grid, hipStream_t stream) {
    static bool attr = false;
    if (!attr) { (void)hipFuncSetAttribute((const void*)k_phase<PH>, hipFuncAttributeMaxDynamicSharedMemorySize, LDS_BYTES); attr = true; }
    p.L = L;
    hipLaunchKernelGGL(k_phase<PH>, dim3(grid), dim3(512), LDS_BYTES, stream, p);
}
#else
#ifndef PH_MASK
#define PH_MASK 0xFFFFFF
#endif
#define RUN(PH) do { if constexpr ((PH_MASK >> PH) & 1) run_phase<PH>(p, L, lds, wv); grid.sync(); } while (0)
template <int L> __device__ __forceinline__ void run_layer(const Params& p, LAS unsigned char* lds, cg::grid_group& grid, const int wv) {
    constexpr int kind = L % 3;
    RUN(PH_PREP);
    if constexpr (kind == 0) { RUN(PH_IN_MLA); RUN(PH_MLA_MID); RUN(PH_MLA_UP); RUN(PH_MLA_ATTN); }
    else if constexpr (kind == 1) { RUN(PH_IN_GDN); RUN(PH_GDN_CONV); RUN(PH_GDN_CHUNK); RUN(PH_GDN_SEQ); }
    else { RUN(PH_IN_SC); RUN(PH_SC_MID); }
    RUN(PH_OPROJ); RUN(PH_XNORM); RUN(PH_XQ); RUN(PH_XATTN); RUN(PH_XO); RUN(PH_MNORM); RUN(PH_MUP); RUN(PH_MDOWN);
}
#undef RUN
__global__ void __launch_bounds__(512) mega(Params p) {
    extern __shared__ __attribute__((aligned(16))) unsigned char lds_raw[];
    LAS unsigned char* lds = (LAS unsigned char*)lds_raw;
    cg::grid_group grid = cg::this_grid();
    const int wv = __builtin_amdgcn_readfirstlane((int)threadIdx.x >> 6);
    run_layer<0>(p, lds, grid, wv); run_layer<1>(p, lds, grid, wv); run_layer<2>(p, lds, grid, wv); run_layer<3>(p, lds, grid, wv);
    run_phase<PH_FINAL>(p, 3, lds, wv);
}
#endif

extern "C" void kernel_launch(void* const* d_in, const int* in_sizes, int n_in, void* d_out, int out_size, void* d_ws, size_t ws_size, hipStream_t stream) {
    static int grid_blocks = 0;
    if (!grid_blocks) {
        if (n_in != 28 || ws_size < WS_END) { fprintf(stderr, "kernel_launch: unexpected n_in %d / ws_size %zu (need %zu)\n", n_in, ws_size, (size_t)WS_END); grid_blocks = -1; return; }
        int dev = 0, cus = 0;
        (void)hipGetDevice(&dev);
        (void)hipDeviceGetAttribute(&cus, hipDeviceAttributeMultiprocessorCount, dev);
        if (cus < 1) cus = 256;
#if N_LAUNCH_SPLIT
        grid_blocks = cus;
#else
        int per_cu = 0;
        (void)hipFuncSetAttribute((const void*)mega, hipFuncAttributeMaxDynamicSharedMemorySize, LDS_BYTES);
        (void)hipOccupancyMaxActiveBlocksPerMultiprocessor(&per_cu, (const void*)mega, 512, LDS_BYTES);
        if (per_cu < 1) per_cu = 1;
        grid_blocks = cus * per_cu;
#endif
        (void)hipGetLastError();
    }
    if (grid_blocks < 0) return;
    Params p{};
    for (int i = 0; i < 28; ++i) p.in[i] = (const float*)d_in[i];
    p.out = (float*)d_out; p.ws = (unsigned char*)d_ws;
#if N_LAUNCH_SPLIT
    const int g = grid_blocks;
    for (int L = 0; L < 4; ++L) {
        const int kind = L % 3;
        launch_phase<PH_PREP>(p, L, g, stream);
        if (kind == 0) { launch_phase<PH_IN_MLA>(p, L, g, stream); launch_phase<PH_MLA_MID>(p, L, g, stream); launch_phase<PH_MLA_UP>(p, L, g, stream); launch_phase<PH_MLA_ATTN>(p, L, g, stream); }
        else if (kind == 1) { launch_phase<PH_IN_GDN>(p, L, g, stream); launch_phase<PH_GDN_CONV>(p, L, g, stream); launch_phase<PH_GDN_CHUNK>(p, L, g, stream); launch_phase<PH_GDN_SEQ>(p, L, g, stream); }
        else { launch_phase<PH_IN_SC>(p, L, g, stream); launch_phase<PH_SC_MID>(p, L, g, stream); }
        launch_phase<PH_OPROJ>(p, L, g, stream); launch_phase<PH_XNORM>(p, L, g, stream); launch_phase<PH_XQ>(p, L, g, stream); launch_phase<PH_XATTN>(p, L, g, stream);
        launch_phase<PH_XO>(p, L, g, stream); launch_phase<PH_MNORM>(p, L, g, stream); launch_phase<PH_MUP>(p, L, g, stream); launch_phase<PH_MDOWN>(p, L, g, stream);
    }
    launch_phase<PH_FINAL>(p, 3, g, stream);
#else
    void* args[] = {&p};
    hipError_t e = hipLaunchCooperativeKernel((const void*)mega, dim3(grid_blocks), dim3(512), args, LDS_BYTES, stream);
    if (e != hipSuccess) fprintf(stderr, "cooperative launch failed: %s (grid %d)\n", hipGetErrorString(e), grid_blocks);
#endif
}
```

```cpp
#include <hip/hip_runtime.h>
#include <hip/hip_cooperative_groups.h>
#include <cstdio>
#include <cstdint>
namespace cg = cooperative_groups;
namespace pg8 {
#define PG8_LAS __attribute__((address_space(3)))
typedef unsigned short bf16_t;
typedef short bf16x8 __attribute__((ext_vector_type(8)));
typedef float f32x4 __attribute__((ext_vector_type(4)));
typedef unsigned u32x4 __attribute__((ext_vector_type(4)));
constexpr int BM = 256, BK = 64, HALF = 128, HTB = HALF * BK * 2  , STAGE_BYTES = 8 * HTB, NXCD = 8, WGM = 8;

__host__ __device__ __forceinline__ int lds_byte(int r, int c) { const int st = (r >> 4) * 2 + (c >> 5), rr = r & 15, cc = c & 31, ob = rr * 64 + cc * 2; return st * 1024 + (ob ^ (((ob >> 9) & 1) << 5)); }
__host__ __device__ __forceinline__ void stage_rc(int b, int& R, int& C) { const int st = b / 1024, sb = b % 1024, swz = sb ^ (((sb >> 9) & 1) << 5); R = (st >> 1) * 16 + swz / 64; C = (st & 1) * 32 + (swz % 64) / 2; }
__host__ __device__ __forceinline__ int perm32(int rho) { const int n = rho >> 4, i = rho & 15; return 8 * (i >> 2) + 4 * n + (i & 3); }

struct Unit { int pm, pn; };
struct Gemm { const bf16_t* A; const bf16_t* Bt; int M, N, K; };

struct StaticOrder {
    int nM, nN, nwg, G, c;
    __host__ __device__ void init(int M, int N, int G_, int c_) { nM = M / BM; nN = N / BM; nwg = nM * nN; G = G_; c = c_; }
    __host__ __device__ bool next(int i, Unit& u) const {
        const long L = (long)i * G + c; if (L >= nwg) return false;
        int wgid = (int)L; { const int q = nwg / NXCD, r = nwg % NXCD, xcd = wgid % NXCD, off = wgid / NXCD; wgid = (xcd < r ? xcd * (q + 1) : r * (q + 1) + (xcd - r) * q) + off; }
        const int nig = WGM * nN, gid = wgid / nig, fm = gid * WGM, gsz = (nM - fm) < WGM ? (nM - fm) : WGM;
        u.pm = fm + ((wgid % nig) % gsz); u.pn = (wgid % nig) / gsz; return true;
    }
    __device__ __forceinline__ void a_ready(const Unit&) const {}
    __device__ __forceinline__ void done(const Unit&) const {}
};

__device__ __forceinline__ unsigned cvt_pk_bf16(float lo, float hi) { unsigned r; asm volatile("v_cvt_pk_bf16_f32 %0, %1, %2" : "=v"(r) : "v"(lo), "v"(hi)); return r; }
__device__ __forceinline__ int opq_tid(int wv) { int l; asm volatile("v_mbcnt_lo_u32_b32 %0, -1, 0\n\tv_mbcnt_hi_u32_b32 %0, -1, %0" : "=v"(l)); return wv * 64 + l; }
template <class Epi, class Sched, bool ALIGN_EPI = false, bool SP2 = false>
__device__ __forceinline__ void gemm_phase(PG8_LAS unsigned char* lds, const Gemm g, const Sched& S, const Epi& E, const int wv) {
    const int tid = opq_tid(wv), wid = __builtin_amdgcn_readfirstlane(tid >> 6), lane = tid & 63, wr = wid >> 2, wc = wid & 3, fr = lane & 15, fq = lane >> 4;
    const int K = g.K, nt = K / BK;
    unsigned voffA[2], voffB[2];
#pragma unroll
    for (int i = 0; i < 2; ++i) { int R, C; stage_rc(tid * 16 + i * 8192, R, C); const int Rb = Epi::PERM ? ((R & ~31) + perm32(R & 31)) : R;
        voffA[i] = (unsigned)(R * K + C) * 2u; voffB[i] = (unsigned)(Rb * K + C) * 2u; }
    const size_t kstep = (size_t)(BK * 2);
    const size_t hstep = (size_t)HALF * K * 2;
    const size_t tstep = 2 * hstep;
    const unsigned ldsw = (unsigned)wid * 1024u;
    const int aoff = lds_byte(wr * 64 + fr, fq * 8), boff = lds_byte(wc * 32 + fr, fq * 8);
#define PG8_SA(b, h) (((b) * 2 + (h)) * HTB)
#define PG8_SB(b, h) ((4 + (b) * 2 + (h)) * HTB)
#define PG8_STAGE(bufoff, gbase, voff) do { _Pragma("unroll") for (int _i = 0; _i < 2; ++_i) \
        __builtin_amdgcn_global_load_lds((const unsigned*)((const char*)(gbase) + (voff)[_i]), (PG8_LAS unsigned*)(lds + (bufoff) + ldsw + _i * 8192), 16, 0, 0); } while (0)
#define PG8_LDA(dst, b, h) do { _Pragma("unroll") for (int m = 0; m < 4; ++m) _Pragma("unroll") for (int k = 0; k < 2; ++k) dst[m][k] = *(const PG8_LAS bf16x8*)(lds + PG8_SA(b, h) + aoff + m * 2048 + k * 1024); } while (0)
#define PG8_LDB(dst, b, h) do { _Pragma("unroll") for (int n = 0; n < 2; ++n) _Pragma("unroll") for (int k = 0; k < 2; ++k) dst[n][k] = *(const PG8_LAS bf16x8*)(lds + PG8_SB(b, h) + boff + n * 2048 + k * 1024); } while (0)
#define PG8_MMA(ai, bj, At, Bt) do { __builtin_amdgcn_s_setprio(1); _Pragma("unroll") for (int m = 0; m < 4; ++m) _Pragma("unroll") for (int n = 0; n < 2; ++n) _Pragma("unroll") for (int k = 0; k < 2; ++k) \
        acc[ai][bj][m][n] = __builtin_amdgcn_mfma_f32_16x16x32_bf16(Bt[n][k], At[m][k], acc[ai][bj][m][n], 0, 0, 0); __builtin_amdgcn_s_setprio(0); } while (0)
#define PG8_WAIT_V(n) asm volatile("s_waitcnt vmcnt(" #n ")" ::: "memory")
#define PG8_WAIT_L(n) asm volatile("s_waitcnt lgkmcnt(" #n ")" ::: "memory")
#define PG8_BAR __builtin_amdgcn_s_barrier()
#define PG8_SCHED __builtin_amdgcn_sched_barrier(0)
    Unit cur, nxt; int ui = 0;
    if (!S.next(0, cur)) return;
    f32x4 acc[2][2][4][2];
#pragma unroll
    for (int a = 0; a < 2; ++a)
#pragma unroll
        for (int b = 0; b < 2; ++b)
#pragma unroll
            for (int m = 0; m < 4; ++m)
#pragma unroll
                for (int n = 0; n < 2; ++n) acc[a][b][m][n] = (f32x4){0.f, 0.f, 0.f, 0.f};
    bf16x8 At[4][2], B0[2][2], B1[2][2];
    const char* cA = (const char*)g.A + (size_t)cur.pm * tstep; const char* cB = (const char*)g.Bt + (size_t)cur.pn * tstep;
    S.a_ready(cur);
    if constexpr (SP2) {
        PG8_STAGE(PG8_SB(0, 0), cB, voffB); PG8_STAGE(PG8_SB(0, 1), cB + hstep, voffB); PG8_STAGE(PG8_SA(0, 0), cA, voffA); PG8_STAGE(PG8_SA(0, 1), cA + hstep, voffA);
        if (wr == 1) PG8_BAR;
        PG8_WAIT_V(2); PG8_BAR;
        PG8_STAGE(PG8_SB(1, 0), cB + kstep, voffB); PG8_STAGE(PG8_SA(1, 0), cA + kstep, voffA); PG8_STAGE(PG8_SB(1, 1), cB + hstep + kstep, voffB);
        PG8_WAIT_V(6); PG8_BAR;
    } else {
        PG8_STAGE(PG8_SB(0, 0), cB, voffB); PG8_STAGE(PG8_SA(0, 0), cA, voffA); PG8_STAGE(PG8_SB(0, 1), cB + hstep, voffB); PG8_STAGE(PG8_SA(0, 1), cA + hstep, voffA);
        if (wr == 1) PG8_BAR;
        PG8_WAIT_V(4); PG8_BAR;
        PG8_STAGE(PG8_SB(1, 0), cB + kstep, voffB); PG8_STAGE(PG8_SA(1, 0), cA + kstep, voffA); PG8_STAGE(PG8_SB(1, 1), cB + hstep + kstep, voffB);
        PG8_WAIT_V(6); PG8_BAR;
    }
    for (;;) {
        const bool has_next = S.next(ui + 1, nxt);
        const char* nA = has_next ? (const char*)g.A + (size_t)nxt.pm * tstep : cA; const char* nB = has_next ? (const char*)g.Bt + (size_t)nxt.pn * tstep : cB;
        for (int t = 0; t < nt; t += 2) {
            const bool last = (t == nt - 2);
            const char* a1 = cA + (size_t)(t + 1) * kstep;
            const char* a2 = last ? nA : cA + (size_t)(t + 2) * kstep; const char* b2 = last ? nB : cB + (size_t)(t + 2) * kstep;
            const char* a3 = a2 + kstep; const char* b3 = b2 + kstep;
            if (last && has_next) S.a_ready(nxt);
            if constexpr (SP2) {
            PG8_LDB(B0, 0, 0); PG8_LDB(B1, 0, 1); PG8_SCHED; PG8_LDA(At, 0, 0); PG8_STAGE(PG8_SA(1, 1), a1 + hstep, voffA);
            PG8_WAIT_V(8); PG8_WAIT_L(0); PG8_BAR; PG8_MMA(0, 0, At, B0); PG8_MMA(0, 1, At, B1); PG8_BAR; PG8_SCHED;
            PG8_LDA(At, 0, 1); PG8_STAGE(PG8_SB(0, 0), b2, voffB); PG8_STAGE(PG8_SB(0, 1), b2 + hstep, voffB); PG8_STAGE(PG8_SA(0, 0), a2, voffA);
            PG8_WAIT_V(8); PG8_WAIT_L(0); PG8_BAR; PG8_MMA(1, 0, At, B0); PG8_MMA(1, 1, At, B1); PG8_BAR; PG8_SCHED;
            PG8_LDB(B0, 1, 0); PG8_LDB(B1, 1, 1); PG8_SCHED; PG8_LDA(At, 1, 0); PG8_STAGE(PG8_SA(0, 1), a2 + hstep, voffA);
            PG8_WAIT_V(8); PG8_WAIT_L(0); PG8_BAR; PG8_MMA(0, 0, At, B0); PG8_MMA(0, 1, At, B1); PG8_BAR; PG8_SCHED;
            PG8_LDA(At, 1, 1); PG8_STAGE(PG8_SB(1, 0), b3, voffB); PG8_STAGE(PG8_SB(1, 1), b3 + hstep, voffB); PG8_STAGE(PG8_SA(1, 0), a3, voffA);
            PG8_WAIT_V(8); PG8_WAIT_L(0); PG8_BAR; PG8_MMA(1, 0, At, B0); PG8_MMA(1, 1, At, B1); PG8_BAR; PG8_SCHED;
            } else {
            PG8_LDB(B0, 0, 0); PG8_SCHED; PG8_LDA(At, 0, 0); PG8_STAGE(PG8_SA(1, 1), a1 + hstep, voffA);
            PG8_WAIT_L(8); PG8_BAR; PG8_WAIT_L(0); PG8_MMA(0, 0, At, B0); PG8_BAR; PG8_SCHED;
            PG8_LDB(B1, 0, 1); PG8_STAGE(PG8_SB(0, 0), b2, voffB);
            PG8_BAR; PG8_WAIT_L(0); PG8_MMA(0, 1, At, B1); PG8_BAR;
            PG8_LDA(At, 0, 1); PG8_STAGE(PG8_SA(0, 0), a2, voffA);
            PG8_BAR; PG8_WAIT_L(0); PG8_MMA(1, 0, At, B0); PG8_BAR; PG8_SCHED;
            PG8_STAGE(PG8_SB(0, 1), b2 + hstep, voffB);
            PG8_WAIT_V(6); PG8_BAR; PG8_MMA(1, 1, At, B1); PG8_BAR;
            PG8_LDB(B0, 1, 0); PG8_SCHED; PG8_LDA(At, 1, 0); PG8_STAGE(PG8_SA(0, 1), a2 + hstep, voffA);
            PG8_WAIT_L(8); PG8_BAR; PG8_WAIT_L(0); PG8_MMA(0, 0, At, B0); PG8_BAR; PG8_SCHED;
            PG8_LDB(B1, 1, 1); PG8_STAGE(PG8_SB(1, 0), b3, voffB);
            PG8_BAR; PG8_WAIT_L(0); PG8_MMA(0, 1, At, B1); PG8_BAR;
            PG8_LDA(At, 1, 1); PG8_STAGE(PG8_SA(1, 0), a3, voffA);
            PG8_BAR; PG8_WAIT_L(0); PG8_MMA(1, 0, At, B0); PG8_BAR; PG8_SCHED;
            PG8_STAGE(PG8_SB(1, 1), b3 + hstep, voffB);
            PG8_WAIT_V(6); PG8_BAR; PG8_MMA(1, 1, At, B1); PG8_BAR;
            }
        }
        if constexpr (ALIGN_EPI) { if (wr == 0) PG8_BAR; }
        if constexpr (!Epi::AFTER_DRAIN) { E(acc, cur, wr, wc, fr, fq); S.done(cur); }
        if (!has_next) break;
#pragma unroll
        for (int a = 0; a < 2; ++a)
#pragma unroll
            for (int b = 0; b < 2; ++b)
#pragma unroll
                for (int m = 0; m < 4; ++m)
#pragma unroll
                    for (int n = 0; n < 2; ++n) acc[a][b][m][n] = (f32x4){0.f, 0.f, 0.f, 0.f};
        cur = nxt; cA = nA; cB = nB; ++ui;
        if constexpr (ALIGN_EPI) { if (wr == 1) PG8_BAR; }
    }
    PG8_WAIT_V(0);
    if constexpr (!ALIGN_EPI) { if (wr == 0) PG8_BAR; }
    PG8_BAR;
    if constexpr (Epi::AFTER_DRAIN) { E.fused(acc, cur, wr, wc, fr, fq, lds, wid, lane); S.done(cur); }
#undef PG8_SA
#undef PG8_SB
#undef PG8_STAGE
#undef PG8_LDA
#undef PG8_LDB
#undef PG8_MMA
#undef PG8_WAIT_V
#undef PG8_WAIT_L
#undef PG8_BAR
#undef PG8_SCHED
}
}
#define LAS __attribute__((address_space(3)))
typedef unsigned short bf16_t;
typedef short bf16x8 __attribute__((ext_vector_type(8)));
typedef short bf16x4 __attribute__((ext_vector_type(4)));
typedef float f32x4 __attribute__((ext_vector_type(4)));
typedef float f32x2 __attribute__((ext_vector_type(2)));
typedef unsigned u32x4 __attribute__((ext_vector_type(4)));
typedef unsigned u32x2 __attribute__((ext_vector_type(2)));
typedef __bf16 bf16x2_t __attribute__((ext_vector_type(2)));

constexpr int T = 16384, D = 1024, SEQ = 2048;
constexpr float EPS = 1e-6f;
constexpr size_t MiB = 1u << 20;
constexpr int LDS_BYTES = 131072 + 2048;
#ifndef N_LAUNCH_SPLIT
#define N_LAUNCH_SPLIT 0
#endif

constexpr size_t W_MIXIN = 1 * MiB, W_UQ = 10 * MiB, W_UKV = 12 * MiB, W_MIXO = 13 * MiB, W_XQ = 15 * MiB, W_XKV = 17 * MiB, W_XO = 21 * MiB, W_1 = 23 * MiB, W_2 = 31 * MiB;
constexpr size_t WS_H = 39 * MiB, WS_MEMN = 71 * MiB, WS_MK = 75 * MiB, WS_MVT = 79 * MiB, WS_COS = 83 * MiB, WS_SIN = 85 * MiB, WS_AR = 87 * MiB;
constexpr size_t A_Z = WS_AR, A_CQN = WS_AR + 44 * MiB, A_CKVN = WS_AR + 56 * MiB, A_KROPE = WS_AR + 64 * MiB, A_Q = WS_AR + 66 * MiB, A_KNOPE = WS_AR + 114 * MiB, A_VT = WS_AR + 146 * MiB;
constexpr size_t G_PRE = WS_AR, G_POST = WS_AR + 96 * MiB, G_GATE = WS_AR + 192 * MiB, G_LOGIT = WS_AR + 224 * MiB, G_BETA = WS_AR + 225 * MiB, G_G = G_BETA + MiB / 2, G_GC = WS_AR + 226 * MiB;
constexpr size_t G_W = WS_AR, G_UT = WS_AR + 32 * MiB, G_ATT = WS_AR + 64 * MiB;
constexpr size_t WS_END = WS_AR + 227 * MiB;

__device__ __forceinline__ float shx(float v, int m, int lane) { return __int_as_float(__builtin_amdgcn_ds_bpermute((lane ^ m) << 2, __float_as_int(v))); }
__device__ __forceinline__ float wave_sum(float v, int lane) {
#pragma unroll
    for (int o = 32; o > 0; o >>= 1) v += shx(v, o, lane);
    return v;
}
__device__ __forceinline__ float bf2f(unsigned short b) { return __uint_as_float(((unsigned)b) << 16); }
__device__ __forceinline__ unsigned pk2(float lo, float hi) { f32x2 v = {lo, hi}; bf16x2_t b = __builtin_convertvector(v, bf16x2_t); return __builtin_bit_cast(unsigned, b); }
__device__ __forceinline__ unsigned short f2bf(float f) { return (unsigned short)(pk2(f, 0.f) & 0xffffu); }
__device__ __forceinline__ float silu_f(float x) { return x / (1.f + __expf(-x)); }
__device__ __forceinline__ u32x2 pk4(f32x4 v) { u32x2 r; r.x = pk2(v[0], v[1]); r.y = pk2(v[2], v[3]); return r; }
#define MFMA16(a, b, c) __builtin_amdgcn_mfma_f32_16x16x32_bf16((a), (b), (c), 0, 0, 0)

template <class F> struct EpiF {
    static constexpr bool PERM = false, AFTER_DRAIN = false;
    F f;
    __device__ __forceinline__ void operator()(const pg8::f32x4 (&acc)[2][2][4][2], const pg8::Unit& u, int wr, int wc, int fr, int fq) const {
#pragma unroll
        for (int ai = 0; ai < 2; ++ai)
#pragma unroll
            for (int m = 0; m < 4; ++m) {
                const int row = u.pm * 256 + ai * 128 + wr * 64 + m * 16 + fr;
#pragma unroll
                for (int bj = 0; bj < 2; ++bj)
#pragma unroll
                    for (int n = 0; n < 2; ++n) { const int col = u.pn * 256 + bj * 128 + wc * 32 + n * 16 + fq * 4; f(row, col, acc[ai][bj][m][n], bj); __builtin_amdgcn_sched_barrier(0); }
                asm volatile("" ::: "memory");
            }
    }
};
template <class F> __device__ __forceinline__ void run_gemm(LAS unsigned char* lds, const bf16_t* A, const bf16_t* Bt, int M, int N, int K, const F& f, const int wv) {
    pg8::Gemm g{A, Bt, M, N, K}; pg8::StaticOrder S; S.init(M, N, (int)gridDim.x, (int)blockIdx.x);
    EpiF<F> E{f};
    pg8::gemm_phase<EpiF<F>, pg8::StaticOrder, true, true>(lds, g, S, E, wv);
}
struct FResid { float* x; __device__ __forceinline__ void operator()(int row, int col, f32x4 v, int bj) const { f32x4* p = (f32x4*)(x + (size_t)row * D + col); *p = *p + v; } };
struct FBf16 { bf16_t* O; int ldc; __device__ __forceinline__ void operator()(int row, int col, f32x4 v, int bj) const { *(u32x2*)(O + (size_t)row * ldc + col) = pk4(v); } };
struct FRelu2 { bf16_t* O; int ldc; __device__ __forceinline__ void operator()(int row, int col, f32x4 v, int bj) const {
    f32x4 r; for (int e = 0; e < 4; ++e) { const float t = v[e] > 0.f ? v[e] : 0.f; r[e] = t * t; } *(u32x2*)(O + (size_t)row * ldc + col) = pk4(r); } };
struct FMlaIn { float* z; __device__ __forceinline__ void operator()(int row, int col, f32x4 v, int bj) const { if (col < 704) *(f32x4*)(z + (size_t)row * 704 + col) = v; } };
struct FMemKV { bf16_t* K; bf16_t* Vt; __device__ __forceinline__ void operator()(int row, int col, f32x4 v, int bj) const {
    if (col < 1024) { *(u32x2*)(K + (size_t)row * 1024 + col) = pk4(v); }
    else { const int c = col - 1024, hh = c >> 8, d = c & 255, b = row >> 8, m = row & 255; bf16_t* p = Vt + (size_t)(((b * 4 + hh) * 4 + (m >> 6)) * 16384 + d * 64 + (m & 63));
#pragma unroll
        for (int e = 0; e < 4; ++e) p[e * 64] = f2bf(v[e]); } } };
struct FUkv { bf16_t* kn; bf16_t* Vt; __device__ __forceinline__ void operator()(int row, int col, f32x4 v, int bj) const {
    const int hh = col >> 8, wi = col & 255;
    if (bj == 0) { *(u32x2*)(kn + (size_t)row * 1024 + hh * 128 + wi) = pk4(v); }
    else { const int d = wi - 128, b = row >> 11, s = row & 2047; bf16_t* p = Vt + (size_t)(((b * 8 + hh) * 32 + (s >> 6)) * 8192 + d * 64 + (s & 63));
#pragma unroll
        for (int e = 0; e < 4; ++e) p[e * 64] = f2bf(v[e]); } } };
struct FGdnIn { bf16_t* qkv; bf16_t* gate; float* logit; __device__ __forceinline__ void operator()(int row, int col, f32x4 v, int bj) const {
    if (col < 3072) *(u32x2*)(qkv + (size_t)row * 3072 + col) = pk4(v);
    else if (col < 4096) *(u32x2*)(gate + (size_t)row * 1024 + (col - 3072)) = pk4(v);
    else if (col < 4112) *(f32x4*)(logit + (size_t)row * 16 + (col - 4096)) = v; } };

__device__ __forceinline__ void conv_w(const float* __restrict__ W, int K, int Nvalid, int Npad, bf16_t* __restrict__ WT, LAS float* scr, int gw, int NGW, int lane) {
    const int nblk = Npad / 32, nitems = (K / 64) * nblk;
    for (int it = gw; it < nitems; it += NGW) {
        const int kb = it / nblk, nb = it - kb * nblk, k0 = 64 * kb, n0 = 32 * nb;
        const int n = n0 + (lane & 31);
#pragma unroll 8
        for (int i = 0; i < 32; ++i) { const int kk = 2 * i + (lane >> 5); scr[kk * 33 + (lane & 31)] = (n < Nvalid) ? W[(size_t)(k0 + kk) * Nvalid + n] : 0.f; }
        asm volatile("s_waitcnt lgkmcnt(0)" ::: "memory");
        const int c = lane & 7;
#pragma unroll
        for (int j = 0; j < 4; ++j) { const int nn = (lane >> 3) + 8 * j; const LAS float* s = scr + (8 * c) * 33 + nn;
            u32x4 o; o.x = pk2(s[0 * 33], s[1 * 33]); o.y = pk2(s[2 * 33], s[3 * 33]); o.z = pk2(s[4 * 33], s[5 * 33]); o.w = pk2(s[6 * 33], s[7 * 33]);
            *(u32x4*)(WT + (size_t)(n0 + nn) * K + k0 + 8 * c) = o; }
        asm volatile("s_waitcnt lgkmcnt(0)" ::: "memory");
    }
}
__device__ __forceinline__ void rms_row(const float* xrow, const float* g, bf16_t* orow, float* copy, int lane) {
    const f32x4* xr = (const f32x4*)xrow + lane; const f32x4* gr = (const f32x4*)g + lane;
    f32x4 v[4]; float s = 0.f;
#pragma unroll
    for (int j = 0; j < 4; ++j) { v[j] = xr[64 * j]; s += (v[j][0] * v[j][0] + v[j][1] * v[j][1]) + (v[j][2] * v[j][2] + v[j][3] * v[j][3]); }
    const float rstd = rsqrtf(wave_sum(s, lane) * (1.f / D) + EPS);
    u32x2* o8 = (u32x2*)orow + lane;
#pragma unroll
    for (int j = 0; j < 4; ++j) { if (copy) ((f32x4*)copy + lane)[64 * j] = v[j]; const f32x4 gg = gr[64 * j]; o8[64 * j] = pk4(v[j] * rstd * gg); }
}
__device__ __forceinline__ void rms_row_f32(float* xrow, const float* g, int lane) {
    f32x4* xr = (f32x4*)xrow + lane; const f32x4* gr = (const f32x4*)g + lane;
    f32x4 v[4]; float s = 0.f;
#pragma unroll
    for (int j = 0; j < 4; ++j) { v[j] = xr[64 * j]; s += (v[j][0] * v[j][0] + v[j][1] * v[j][1]) + (v[j][2] * v[j][2] + v[j][3] * v[j][3]); }
    const float rstd = rsqrtf(wave_sum(s, lane) * (1.f / D) + EPS);
#pragma unroll
    for (int j = 0; j < 4; ++j) xr[64 * j] = v[j] * rstd * gr[64 * j];
}

template <int DK1, int DK2, int DV, int RT, bool CAUSAL, bool ROPE>
__device__ __forceinline__ void attn_unit(LAS unsigned char* lds, const bf16_t* __restrict__ Q, int ldq, const bf16_t* __restrict__ K1, int ldk1, const bf16_t* __restrict__ K2, int ldk2,
                                          const bf16_t* __restrict__ Vt, int ldvt, int nkt, int q0, bf16_t* __restrict__ O, int ldo, float sl2, const float* __restrict__ cosr, const float* __restrict__ sinr, const int wv) {
    constexpr int DQK = DK1 + DK2, NKS = DQK / 32, NDT = DV / 16, KP = DQK + 8, VP = 72, KCH = DQK / 8;
    LAS bf16_t* Ks = (LAS bf16_t*)lds;
    LAS bf16_t* Vs = (LAS bf16_t*)(lds + 64 * KP * 2);
    const int tid = pg8::opq_tid(wv), lane = tid & 63, wid = tid >> 6, fr = lane & 15, fq = lane >> 4;
    const int wrow0 = wid * 16 * RT;
    bf16x8 qf[RT][NKS];
#pragma unroll
    for (int rt = 0; rt < RT; ++rt)
#pragma unroll
        for (int ks = 0; ks < NKS; ++ks) qf[rt][ks] = *(const bf16x8*)(Q + (size_t)(wrow0 + rt * 16 + fr) * ldq + ks * 32 + fq * 8);
    if (ROPE) {
#pragma unroll
        for (int rt = 0; rt < RT; ++rt) {
            const int row = wrow0 + rt * 16 + fr; constexpr int k1 = DK1 / 32;
            bf16x8 a = qf[rt][k1], b = qf[rt][k1 + 1], oa, ob;
#pragma unroll
            for (int j = 0; j < 8; ++j) { const float c = cosr[row * 32 + fq * 8 + j], s = sinr[row * 32 + fq * 8 + j];
                const float x1 = bf2f((unsigned short)a[j]), x2 = bf2f((unsigned short)b[j]);
                oa[j] = (short)f2bf(x1 * c - x2 * s); ob[j] = (short)f2bf(x2 * c + x1 * s); }
            qf[rt][k1] = oa; qf[rt][k1 + 1] = ob;
        }
    }
    float m_run[RT], l_run[RT]; f32x4 oacc[RT][NDT];
#pragma unroll
    for (int rt = 0; rt < RT; ++rt) { m_run[rt] = -INFINITY; l_run[rt] = 0.f;
#pragma unroll
        for (int dt = 0; dt < NDT; ++dt) oacc[rt][dt] = (f32x4){0.f, 0.f, 0.f, 0.f}; }
    for (int kt = 0; kt < nkt; ++kt) {
        __syncthreads();
#pragma unroll
        for (int i = 0; i < (64 * KCH) / 512; ++i) { const int id = tid + 512 * i, key = id / KCH, c = id - key * KCH;
            const bf16_t* src = (c < DK1 / 8) ? (K1 + (size_t)(kt * 64 + key) * ldk1 + c * 8) : (K2 + (size_t)(kt * 64 + key) * ldk2 + (c - DK1 / 8) * 8);
            *(LAS u32x4*)(Ks + key * KP + c * 8) = *(const u32x4*)src; }
#pragma unroll
        for (int i = 0; i < (DV * 8) / 512; ++i) { const int id = tid + 512 * i, d = id >> 3, c = id & 7;
            *(LAS u32x4*)(Vs + d * VP + c * 8) = *(const u32x4*)(Vt + (size_t)kt * (DV * 64) + d * 64 + c * 8); }
        __syncthreads();
        if (CAUSAL && kt * 64 > q0 + wrow0 + 16 * RT - 1) continue;
        f32x4 sacc[RT][4];
#pragma unroll
        for (int rt = 0; rt < RT; ++rt)
#pragma unroll
            for (int ct = 0; ct < 4; ++ct) sacc[rt][ct] = (f32x4){0.f, 0.f, 0.f, 0.f};
#pragma unroll
        for (int ct = 0; ct < 4; ++ct)
#pragma unroll
            for (int ks = 0; ks < NKS; ++ks) { const bf16x8 kf = *(const LAS bf16x8*)(Ks + (ct * 16 + fr) * KP + ks * 32 + fq * 8);
#pragma unroll
                for (int rt = 0; rt < RT; ++rt) sacc[rt][ct] = MFMA16(kf, qf[rt][ks], sacc[rt][ct]);
                if ((ks & 1) == 1) __builtin_amdgcn_sched_barrier(0); }
        const bool need_mask = CAUSAL && (kt * 64 + 63 > q0 + wrow0);
        bf16x8 pf[RT][2];
#pragma unroll
        for (int rt = 0; rt < RT; ++rt) {
            const int qi = q0 + wrow0 + rt * 16 + fr;
            float mx = -INFINITY;
#pragma unroll
            for (int ct = 0; ct < 4; ++ct)
#pragma unroll
                for (int e = 0; e < 4; ++e) { float s = sacc[rt][ct][e] * sl2; if (need_mask && (kt * 64 + ct * 16 + fq * 4 + e > qi)) s = -INFINITY; sacc[rt][ct][e] = s; mx = fmaxf(mx, s); }
            mx = fmaxf(mx, shx(mx, 16, lane)); mx = fmaxf(mx, shx(mx, 32, lane));
            const float m_new = fmaxf(m_run[rt], mx);
            const float alpha = exp2f(m_run[rt] - m_new); m_run[rt] = m_new;
            float ls = 0.f;
#pragma unroll
            for (int ct = 0; ct < 4; ++ct)
#pragma unroll
                for (int e = 0; e < 4; ++e) { const float p = exp2f(sacc[rt][ct][e] - m_new); sacc[rt][ct][e] = p; ls += p; }
            l_run[rt] = l_run[rt] * alpha + ls;
#pragma unroll
            for (int dt = 0; dt < NDT; ++dt) oacc[rt][dt] = oacc[rt][dt] * alpha;
#pragma unroll
            for (int s2 = 0; s2 < 2; ++s2) { u32x4 w; w.x = pk2(sacc[rt][2 * s2][0], sacc[rt][2 * s2][1]); w.y = pk2(sacc[rt][2 * s2][2], sacc[rt][2 * s2][3]);
                w.z = pk2(sacc[rt][2 * s2 + 1][0], sacc[rt][2 * s2 + 1][1]); w.w = pk2(sacc[rt][2 * s2 + 1][2], sacc[rt][2 * s2 + 1][3]); pf[rt][s2] = __builtin_bit_cast(bf16x8, w); }
        }
#pragma unroll
        for (int dt = 0; dt < NDT; ++dt)
#pragma unroll
            for (int s2 = 0; s2 < 2; ++s2) {
                const bf16x4 lo = *(const LAS bf16x4*)(Vs + (dt * 16 + fr) * VP + s2 * 32 + fq * 4);
                const bf16x4 hi = *(const LAS bf16x4*)(Vs + (dt * 16 + fr) * VP + s2 * 32 + 16 + fq * 4);
                const bf16x8 vf = __builtin_shufflevector(lo, hi, 0, 1, 2, 3, 4, 5, 6, 7);
#pragma unroll
                for (int rt = 0; rt < RT; ++rt) oacc[rt][dt] = MFMA16(vf, pf[rt][s2], oacc[rt][dt]);
                if (s2 == 1) __builtin_amdgcn_sched_barrier(0);
            }
    }
#pragma unroll
    for (int rt = 0; rt < RT; ++rt) {
        float l = l_run[rt]; l += shx(l, 16, lane); l += shx(l, 32, lane);
        const float inv = 1.f / l;
        bf16_t* orow = O + (size_t)(wrow0 + rt * 16 + fr) * ldo + fq * 4;
#pragma unroll
        for (int dt = 0; dt < NDT; ++dt) *(u32x2*)(orow + dt * 16) = pk4(oacc[rt][dt] * inv);
    }
}
#define GAS __attribute__((address_space(1)))
typedef GAS unsigned gu32;
typedef GAS unsigned long long gu64;
#define RLX_AGENT __ATOMIC_RELAXED, __HIP_MEMORY_SCOPE_AGENT
#define LDS_WAIT() asm volatile("s_waitcnt lgkmcnt(0)" ::: "memory")
#define VM_WAIT() asm volatile("s_waitcnt vmcnt(0)" ::: "memory")

#define XB_TMO      128
#define XB_XCNT(j)  (256  + 64 * (j))
#define XB_XSUB(j)  (1280 + 64 * (j))
#define XB_XGEN(j)  (2304 + 64 * (j))
#define XB_TOP      3328
#define XB_TOPGEN   3392
#define XCD_BAR_WORDS 3456
#define XB_SPIN_CAP (1u << 18)

__device__ __forceinline__ unsigned xb_ld(unsigned* p)              { return __hip_atomic_load(p, __ATOMIC_RELAXED, __HIP_MEMORY_SCOPE_AGENT); }
__device__ __forceinline__ unsigned xb_add(unsigned* p, unsigned v) { return __hip_atomic_fetch_add(p, v, __ATOMIC_RELAXED, __HIP_MEMORY_SCOPE_AGENT); }
__device__ __forceinline__ unsigned xb_xcc_id() { return (unsigned)__builtin_amdgcn_s_getreg((3 << 11) | 20) & 0xFu; }
#define XB_SPIN(cond, bar) do { unsigned _sp = 0; while (cond) { __builtin_amdgcn_s_sleep(1); \
    if ((++_sp & 255u) == 0u) { if (xb_ld(&(bar)[XB_TMO])) break; if (_sp > XB_SPIN_CAP) { atomicAdd(&(bar)[XB_TMO], 1u); break; } } } } while (0)

struct XcdBarrier {
    unsigned* bar; unsigned x;
    volatile LAS unsigned* st;
};

__device__ __forceinline__ XcdBarrier xcd_barrier_post(unsigned* bar, volatile LAS unsigned* st) {
    XcdBarrier b; b.bar = bar; b.x = xb_xcc_id(); b.st = st;
    if (threadIdx.x == 0) (void)xb_add(&bar[XB_XCNT(b.x)], 1u);
    return b;
}
__device__ __forceinline__ void xcd_barrier_complete(unsigned* bar, unsigned x, unsigned& nloc, unsigned& nx) {
    const unsigned G = gridDim.x * gridDim.y * gridDim.z;
    unsigned sum, cnt, mine, sp = 0u;
    for (;;) {
        sum = 0u; cnt = 0u; mine = 0u;
#pragma unroll
        for (unsigned j = 0; j < 16; ++j) { const unsigned c = xb_ld(&bar[XB_XCNT(j)]); sum += c; cnt += (c > 0u) ? 1u : 0u; mine = (j == x) ? c : mine; }
        if (sum == G) break;
        __builtin_amdgcn_s_sleep(1);
        if ((++sp & 255u) == 0u) { if (xb_ld(&bar[XB_TMO])) break; if (sp > XB_SPIN_CAP) { atomicAdd(&bar[XB_TMO], 1u); break; } }
    }
    nloc = mine > 0u ? mine : 1u; nx = cnt > 0u ? cnt : 1u;
}

__device__ __forceinline__ void xcd_barrier(const XcdBarrier& b) {
    asm volatile("s_waitcnt vmcnt(0)" ::: "memory");
    __syncthreads();
    if (threadIdx.x == 0) {
        unsigned* bar = b.bar;
        __builtin_amdgcn_s_waitcnt(0);
        unsigned nloc = b.st[0], nx = b.st[1];
        if (nloc == 0u) { xcd_barrier_complete(bar, b.x, nloc, nx); b.st[0] = nloc; b.st[1] = nx; }
        const unsigned old = xb_add(&bar[XB_XSUB(b.x)], 1u);
        const unsigned gen = old / nloc;
        if (old + 1u == (gen + 1u) * nloc) {
            __builtin_amdgcn_fence(__ATOMIC_RELEASE, "agent");
            asm volatile("s_waitcnt vmcnt(0)" ::: "memory");
            const unsigned og = xb_add(&bar[XB_TOP], 1u);
            const unsigned tg = og / nx;
            if (og + 1u == (tg + 1u) * nx) xb_add(&bar[XB_TOPGEN], 1u);
            else XB_SPIN(xb_ld(&bar[XB_TOPGEN]) == tg, bar);
            __builtin_amdgcn_fence(__ATOMIC_ACQUIRE, "agent");
            xb_add(&bar[XB_XGEN(b.x)], 1u);
            asm volatile("s_waitcnt vmcnt(0)" ::: "memory");
        } else {
            XB_SPIN(xb_ld(&bar[XB_XGEN(b.x)]) == gen, bar);
            __builtin_amdgcn_fence(__ATOMIC_ACQUIRE, "agent");
            asm volatile("s_waitcnt vmcnt(0)" ::: "memory");
        }
    }
    __syncthreads();
}

__device__ __forceinline__ bf16x8 ldsfrag(const LAS bf16_t* base, int pitch, int row, int k) { return *(const LAS bf16x8*)(base + row * pitch + k); }

__device__ __forceinline__ void gdn_conv_phase(const bf16_t* __restrict__ pre, bf16_t* __restrict__ post, const float* __restrict__ convw, const float* __restrict__ logit,
                                               const float* __restrict__ a_log, const float* __restrict__ dt_bias, float* __restrict__ beta, float* __restrict__ g, int gw, int NGW, int lane, int gtid, int NT) {
    for (int it = gw; it < T * 24; it += NGW) {
        const int r = it / 24, grp = it - r * 24, t = r & (SEQ - 1), col = grp * 128 + 2 * lane;
        float a0 = 0.f, a1 = 0.f;
#pragma unroll
        for (int j = 0; j < 4; ++j) { if (t - 3 + j >= 0) { const unsigned x = *(const unsigned*)(pre + (size_t)(r - 3 + j) * 3072 + col);
            const f32x2 w = *(const f32x2*)(convw + j * 3072 + col); a0 += w[0] * bf2f((unsigned short)(x & 0xffffu)); a1 += w[1] * bf2f((unsigned short)(x >> 16)); } }
        float y0 = silu_f(a0), y1 = silu_f(a1);
        if (grp < 16) { const float ss = wave_sum(y0 * y0 + y1 * y1, lane); const float sc = rsqrtf(ss + EPS) * (grp < 8 ? 0.08838834764831845f : 1.f); y0 *= sc; y1 *= sc; }
        *(unsigned*)(post + (size_t)r * 3072 + col) = pk2(y0, y1);
    }
    for (int i = gtid; i < T * 8; i += NT) { const int r = i >> 3, h = i & 7; const float bl = logit[r * 16 + h], al = logit[r * 16 + 8 + h];
        beta[i] = 1.f / (1.f + expf(-bl)); const float xx = al + dt_bias[h]; const float sp = xx > 20.f ? xx : log1pf(expf(xx)); g[i] = -expf(a_log[h]) * sp; }
}

__device__ __forceinline__ void gdn_chunk_phase(LAS unsigned char* lds, const bf16_t* __restrict__ post, const float* __restrict__ beta, const float* __restrict__ g,
                                                bf16_t* __restrict__ Wc, bf16_t* __restrict__ UT, bf16_t* __restrict__ ATT, float* __restrict__ GC, const int wv) {
    constexpr int KP = 136, TP = 72;
    LAS bf16_t* kS = (LAS bf16_t*)lds; LAS bf16_t* qS = (LAS bf16_t*)(lds + 17408); LAS bf16_t* vbT = (LAS bf16_t*)(lds + 34816); LAS bf16_t* kbgT = (LAS bf16_t*)(lds + 53248);
    LAS float* Mm = (LAS float*)(lds + 71680); LAS bf16_t* Ti = (LAS bf16_t*)(lds + 88064); LAS float* gcS = (LAS float*)(lds + 97280); LAS float* btS = (LAS float*)(lds + 97536);
    const int tid = pg8::opq_tid(wv), lane = tid & 63, wid = tid >> 6, fr = lane & 15, fq = lane >> 4;
    for (int unit = blockIdx.x; unit < 2048; unit += gridDim.x) {
        const int b = unit >> 8, h = (unit >> 5) & 7, n = unit & 31, r0 = b * SEQ + n * 64;
        __syncthreads();
        if (wid == 0) { float gv = g[(size_t)(r0 + lane) * 8 + h];
#pragma unroll
            for (int o = 1; o < 64; o <<= 1) { const float up = __int_as_float(__builtin_amdgcn_ds_bpermute(((lane - o) & 63) << 2, __float_as_int(gv))); if (lane >= o) gv += up; }
            gcS[lane] = gv; btS[lane] = beta[(size_t)(r0 + lane) * 8 + h]; GC[(size_t)unit * 64 + lane] = gv; }
        __syncthreads();
#pragma unroll
        for (int i = 0; i < 2; ++i) { const int id = tid + 512 * i, pos = id & 63, c8 = id >> 6;
            const bf16_t* rowp = post + (size_t)(r0 + pos) * 3072 + h * 128 + c8 * 8;
            const u32x4 qv = *(const u32x4*)rowp, kv = *(const u32x4*)(rowp + 1024), vv = *(const u32x4*)(rowp + 2048);
            *(LAS u32x4*)(qS + pos * KP + c8 * 8) = qv; *(LAS u32x4*)(kS + pos * KP + c8 * 8) = kv;
            const float bt = btS[pos], sc = bt * __expf(gcS[pos]);
            const bf16x8 k8 = __builtin_bit_cast(bf16x8, kv), v8 = __builtin_bit_cast(bf16x8, vv);
#pragma unroll
            for (int e = 0; e < 8; ++e) { kbgT[(c8 * 8 + e) * TP + pos] = f2bf(bf2f((unsigned short)k8[e]) * sc); vbT[(c8 * 8 + e) * TP + pos] = f2bf(bf2f((unsigned short)v8[e]) * bt); } }
        __syncthreads();
#pragma unroll
        for (int tt = 0; tt < 2; ++tt) { const int t = wid + 8 * tt, it = t >> 2, jt = t & 3; const int i = it * 16 + fr, j0 = jt * 16 + fq * 4;
            bf16_t* ap = ATT + (size_t)unit * 4096 + i * 64 + j0;
            if (jt <= it) {
                f32x4 aK = {0.f, 0.f, 0.f, 0.f}, aQ = {0.f, 0.f, 0.f, 0.f};
#pragma unroll
                for (int ks = 0; ks < 4; ++ks) { const bf16x8 kj = ldsfrag(kS, KP, jt * 16 + fr, ks * 32 + fq * 8), ki = ldsfrag(kS, KP, it * 16 + fr, ks * 32 + fq * 8), qi = ldsfrag(qS, KP, it * 16 + fr, ks * 32 + fq * 8);
                    aK = MFMA16(kj, ki, aK); aQ = MFMA16(kj, qi, aQ); }
                const float gi = gcS[i], bi = btS[i]; f32x4 mm, at;
#pragma unroll
                for (int e = 0; e < 4; ++e) { const int j = j0 + e; const float dec = (i >= j) ? __expf(gi - gcS[j]) : 0.f; mm[e] = (i > j) ? bi * aK[e] * dec : 0.f; at[e] = aQ[e] * dec; }
                *(LAS f32x4*)(Mm + i * 64 + j0) = mm; *(u32x2*)ap = pk4(at);
            } else { *(u32x2*)ap = (u32x2){0u, 0u}; }
        }
        __syncthreads();
        if (wid == 0) {
            float x[64]; int ln = lane; asm volatile("" : "+v"(ln)); int zv = 0; asm volatile("" : "+v"(zv)); const LAS float* Mv = Mm + zv;
#pragma unroll
            for (int i = 0; i < 64; ++i) {
                int dl = i - ln; dl = dl < 0 ? -dl : dl; dl = 1 - dl; dl = dl < 0 ? 0 : dl; float s0 = (float)dl, s1 = 0.f, s2 = 0.f, s3 = 0.f;
#pragma unroll
                for (int j4 = 0; j4 < (i + 3) / 4; ++j4) { const f32x4 m = *(const LAS f32x4*)(Mv + i * 64 + j4 * 4);
                    if (j4 * 4 + 0 < i) s0 -= m[0] * x[j4 * 4 + 0]; if (j4 * 4 + 1 < i) s1 -= m[1] * x[j4 * 4 + 1];
                    if (j4 * 4 + 2 < i) s2 -= m[2] * x[j4 * 4 + 2]; if (j4 * 4 + 3 < i) s3 -= m[3] * x[j4 * 4 + 3]; }
                x[i] = (s0 + s1) + (s2 + s3);
                Ti[i * TP + lane] = f2bf(x[i]);
            }
        }
        __syncthreads();
#pragma unroll
        for (int q = 0; q < 4; ++q) { const int t = wid * 4 + q, pt = t >> 3, dt = t & 7;
            f32x4 aU = {0.f, 0.f, 0.f, 0.f}, aW = {0.f, 0.f, 0.f, 0.f};
#pragma unroll
            for (int ks = 0; ks < 2; ++ks) { const bf16x8 tf = ldsfrag(Ti, TP, pt * 16 + fr, ks * 32 + fq * 8);
                aU = MFMA16(tf, ldsfrag(vbT, TP, dt * 16 + fr, ks * 32 + fq * 8), aU);
                aW = MFMA16(ldsfrag(kbgT, TP, dt * 16 + fr, ks * 32 + fq * 8), tf, aW); }
            *(u32x2*)(UT + (size_t)unit * 8192 + (dt * 16 + fr) * 64 + pt * 16 + fq * 4) = pk4(aU);
            *(u32x2*)(Wc + (size_t)unit * 8192 + (pt * 16 + fr) * 128 + dt * 16 + fq * 4) = pk4(aW);
        }
    }
}

__device__ __forceinline__ void gdn_seq_phase(LAS unsigned char* lds, const bf16_t* __restrict__ post, const bf16_t* __restrict__ Wc, const bf16_t* __restrict__ UT, const bf16_t* __restrict__ ATT,
                                              const float* __restrict__ GC, const bf16_t* __restrict__ gate, const float* __restrict__ o_norm, bf16_t* __restrict__ out, const int wv) {
    constexpr int KP = 136, TP = 72;
    LAS bf16_t* wS = (LAS bf16_t*)lds; LAS bf16_t* qgS = (LAS bf16_t*)(lds + 17408); LAS bf16_t* kdT = (LAS bf16_t*)(lds + 34816); LAS bf16_t* atS = (LAS bf16_t*)(lds + 53248);
    LAS bf16_t* StT = (LAS bf16_t*)(lds + 62464); LAS bf16_t* vnT = (LAS bf16_t*)(lds + 97280); LAS float* part = (LAS float*)(lds + 115712);
    const int tid = pg8::opq_tid(wv), lane = tid & 63, wid = tid >> 6, fr = lane & 15, fq = lane >> 4;
    const int dvr = 16 * wid + fr;
    for (int item = blockIdx.x; item < 64; item += gridDim.x) {
        const int b = item >> 3, h = item & 7;
        f32x4 sacc[8];
#pragma unroll
        for (int mt = 0; mt < 8; ++mt) { sacc[mt] = (f32x4){0.f, 0.f, 0.f, 0.f}; *(LAS u32x2*)(StT + dvr * KP + mt * 16 + fq * 4) = (u32x2){0u, 0u}; }
        const float gn = o_norm[dvr];
        for (int n = 0; n < 32; ++n) {
            const int unit = item * 32 + n, r0 = b * SEQ + n * 64;
            const float glast = GC[(size_t)unit * 64 + 63];
            __syncthreads();
#pragma unroll
            for (int i = 0; i < 2; ++i) { const int id = tid + 512 * i;
                { const int pos = id >> 4, c8 = id & 15;
                  *(LAS u32x4*)(wS + pos * KP + c8 * 8) = *(const u32x4*)(Wc + (size_t)unit * 8192 + pos * 128 + c8 * 8);
                  const bf16x8 q8 = *(const bf16x8*)(post + (size_t)(r0 + pos) * 3072 + h * 128 + c8 * 8); const float eg = __expf(GC[(size_t)unit * 64 + pos]);
                  u32x4 w; w.x = pk2(bf2f((unsigned short)q8[0]) * eg, bf2f((unsigned short)q8[1]) * eg); w.y = pk2(bf2f((unsigned short)q8[2]) * eg, bf2f((unsigned short)q8[3]) * eg);
                  w.z = pk2(bf2f((unsigned short)q8[4]) * eg, bf2f((unsigned short)q8[5]) * eg); w.w = pk2(bf2f((unsigned short)q8[6]) * eg, bf2f((unsigned short)q8[7]) * eg);
                  *(LAS u32x4*)(qgS + pos * KP + c8 * 8) = w; }
                { const int pos = id & 63, c8 = id >> 6;
                  const bf16x8 k8 = *(const bf16x8*)(post + (size_t)(r0 + pos) * 3072 + 1024 + h * 128 + c8 * 8); const float sc = __expf(glast - GC[(size_t)unit * 64 + pos]);
#pragma unroll
                  for (int e = 0; e < 8; ++e) kdT[(c8 * 8 + e) * TP + pos] = f2bf(bf2f((unsigned short)k8[e]) * sc); } }
            { const int i = tid >> 3, c8 = tid & 7; *(LAS u32x4*)(atS + i * TP + c8 * 8) = *(const u32x4*)(ATT + (size_t)unit * 4096 + i * 64 + c8 * 8); }
            __syncthreads();
            f32x4 o[4];
#pragma unroll
            for (int rt = 0; rt < 4; ++rt) { f32x4 acc = {0.f, 0.f, 0.f, 0.f};
#pragma unroll
                for (int ks = 0; ks < 4; ++ks) acc = MFMA16(ldsfrag(wS, KP, rt * 16 + fr, ks * 32 + fq * 8), ldsfrag(StT, KP, dvr, ks * 32 + fq * 8), acc);
                const bf16x4 u4 = *(const bf16x4*)(UT + (size_t)unit * 8192 + dvr * 64 + rt * 16 + fq * 4);
                f32x4 vn; for (int e = 0; e < 4; ++e) vn[e] = bf2f((unsigned short)u4[e]) - acc[e];
                *(LAS u32x2*)(vnT + dvr * TP + rt * 16 + fq * 4) = pk4(vn); }
#pragma unroll
            for (int rt = 0; rt < 4; ++rt) { f32x4 acc = {0.f, 0.f, 0.f, 0.f};
#pragma unroll
                for (int ks = 0; ks < 4; ++ks) acc = MFMA16(ldsfrag(qgS, KP, rt * 16 + fr, ks * 32 + fq * 8), ldsfrag(StT, KP, dvr, ks * 32 + fq * 8), acc);
#pragma unroll
                for (int ks = 0; ks < 2; ++ks) acc = MFMA16(ldsfrag(atS, TP, rt * 16 + fr, ks * 32 + fq * 8), ldsfrag(vnT, TP, dvr, ks * 32 + fq * 8), acc);
                o[rt] = acc; }
            const float egl = __expf(glast);
#pragma unroll
            for (int mt = 0; mt < 8; ++mt) { f32x4 acc = sacc[mt] * egl;
#pragma unroll
                for (int ks = 0; ks < 2; ++ks) acc = MFMA16(ldsfrag(kdT, TP, mt * 16 + fr, ks * 32 + fq * 8), ldsfrag(vnT, TP, dvr, ks * 32 + fq * 8), acc);
                sacc[mt] = acc; *(LAS u32x2*)(StT + dvr * KP + mt * 16 + fq * 4) = pk4(acc); }
#pragma unroll
            for (int rt = 0; rt < 4; ++rt) { f32x4 ss = o[rt] * o[rt];
#pragma unroll
                for (int sh = 1; sh < 16; sh <<= 1) { ss[0] += shx(ss[0], sh, lane); ss[1] += shx(ss[1], sh, lane); ss[2] += shx(ss[2], sh, lane); ss[3] += shx(ss[3], sh, lane); }
                if (fr == 0) *(LAS f32x4*)(part + wid * 64 + rt * 16 + fq * 4) = ss; }
            __syncthreads();
#pragma unroll
            for (int rt = 0; rt < 4; ++rt) { f32x4 tot = {0.f, 0.f, 0.f, 0.f};
#pragma unroll
                for (int w = 0; w < 8; ++w) tot += *(const LAS f32x4*)(part + w * 64 + rt * 16 + fq * 4);
#pragma unroll
                for (int e = 0; e < 4; ++e) { const int pos = rt * 16 + fq * 4 + e; const size_t oi = (size_t)(r0 + pos) * 1024 + h * 128 + dvr;
                    const float rstd = rsqrtf(tot[e] * (1.f / 128.f) + EPS); const float gt = bf2f(gate[oi]);
                    out[oi] = f2bf(o[rt][e] * rstd * gn * silu_f(gt)); } }
        }
    }
}

__device__ __forceinline__ void mla_mid_phase(const float* __restrict__ z, const float* __restrict__ qn, const float* __restrict__ kvn, const float* __restrict__ cosb, const float* __restrict__ sinb,
                                              bf16_t* __restrict__ cqn, bf16_t* __restrict__ ckvn, bf16_t* __restrict__ krope, int gw, int NGW, int lane) {
    for (int r = gw; r < T; r += NGW) {
        const float* zr = z + (size_t)r * 704;
        f32x2 a[3]; float s = 0.f;
#pragma unroll
        for (int i = 0; i < 3; ++i) { a[i] = *(const f32x2*)(zr + 2 * lane + 128 * i); s += a[i][0] * a[i][0] + a[i][1] * a[i][1]; }
        float rstd = rsqrtf(wave_sum(s, lane) * (1.f / 384.f) + EPS);
#pragma unroll
        for (int i = 0; i < 3; ++i) { const f32x2 gg = *(const f32x2*)(qn + 2 * lane + 128 * i); *(unsigned*)(cqn + (size_t)r * 384 + 2 * lane + 128 * i) = pk2(a[i][0] * rstd * gg[0], a[i][1] * rstd * gg[1]); }
        f32x2 c[2]; s = 0.f;
#pragma unroll
        for (int i = 0; i < 2; ++i) { c[i] = *(const f32x2*)(zr + 384 + 2 * lane + 128 * i); s += c[i][0] * c[i][0] + c[i][1] * c[i][1]; }
        rstd = rsqrtf(wave_sum(s, lane) * (1.f / 256.f) + EPS);
#pragma unroll
        for (int i = 0; i < 2; ++i) { const f32x2 gg = *(const f32x2*)(kvn + 2 * lane + 128 * i); *(unsigned*)(ckvn + (size_t)r * 256 + 2 * lane + 128 * i) = pk2(c[i][0] * rstd * gg[0], c[i][1] * rstd * gg[1]); }
        const float v = zr[640 + lane], pv = shx(v, 32, lane); const int i = lane & 31; const float cs = cosb[(size_t)r * 32 + i], sn = sinb[(size_t)r * 32 + i];
        const float outv = (lane < 32) ? (v * cs - pv * sn) : (v * cs + pv * sn);
        krope[(size_t)r * 64 + lane] = f2bf(outv);
    }
}
__device__ __forceinline__ void sc_mid_phase(const bf16_t* __restrict__ z, const float* __restrict__ cw, bf16_t* __restrict__ y, int gtid, int NT) {
    for (int it = gtid; it < T * 128; it += NT) {
        const int r = it >> 7, c8 = it & 127, t = r & (SEQ - 1), col = c8 * 8;
        float acc[8];
#pragma unroll
        for (int e = 0; e < 8; ++e) acc[e] = 0.f;
#pragma unroll
        for (int j = 0; j < 3; ++j) { if (t - 2 + j >= 0) { const bf16_t* zr = z + (size_t)(r - 2 + j) * 3072 + col;
            const bf16x8 cg8 = *(const bf16x8*)(zr + 1024), u8 = *(const bf16x8*)(zr + 2048); const f32x4 w0 = *(const f32x4*)(cw + j * 1024 + col), w1 = *(const f32x4*)(cw + j * 1024 + col + 4);
#pragma unroll
            for (int e = 0; e < 8; ++e) acc[e] += (e < 4 ? w0[e] : w1[e - 4]) * (bf2f((unsigned short)cg8[e]) * bf2f((unsigned short)u8[e])); } }
        const bf16x8 b8 = *(const bf16x8*)(z + (size_t)r * 3072 + col);
        u32x4 o; o.x = pk2(acc[0] * bf2f((unsigned short)b8[0]), acc[1] * bf2f((unsigned short)b8[1])); o.y = pk2(acc[2] * bf2f((unsigned short)b8[2]), acc[3] * bf2f((unsigned short)b8[3]));
        o.z = pk2(acc[4] * bf2f((unsigned short)b8[4]), acc[5] * bf2f((unsigned short)b8[5])); o.w = pk2(acc[6] * bf2f((unsigned short)b8[6]), acc[7] * bf2f((unsigned short)b8[7]));
        *(u32x4*)(y + (size_t)r * 1024 + col) = o;
    }
}
struct Params { const float* in[28]; float* out; unsigned char* ws; int L, pad; };
enum { PH_PREP = 0, PH_IN_MLA, PH_IN_GDN, PH_IN_SC, PH_MLA_MID, PH_MLA_UP, PH_MLA_ATTN, PH_GDN_CONV, PH_GDN_CHUNK, PH_GDN_SEQ, PH_SC_MID, PH_OPROJ,
       PH_XNORM, PH_XQ, PH_XATTN, PH_XO, PH_MNORM, PH_MUP, PH_MDOWN, PH_FINAL, PH_COUNT };

template <int PH> __device__ __forceinline__ void run_phase(const Params& p, const int L, LAS unsigned char* lds, const int wv) {
    const int tid = pg8::opq_tid(wv), lane = tid & 63, wid = tid >> 6;
    const int G = gridDim.x, gw = blockIdx.x * 8 + wid, NGW = G * 8, gtid = blockIdx.x * 512 + tid, NT = G * 512;
    unsigned char* ws = p.ws;
    float* X = p.out;
    bf16_t* H = (bf16_t*)(ws + WS_H); bf16_t* MEMN = (bf16_t*)(ws + WS_MEMN); bf16_t* MK = (bf16_t*)(ws + WS_MK); bf16_t* MVT = (bf16_t*)(ws + WS_MVT);
    float* COS = (float*)(ws + WS_COS); float* SIN = (float*)(ws + WS_SIN);
    bf16_t* Wmixin = (bf16_t*)(ws + W_MIXIN); bf16_t* Wuq = (bf16_t*)(ws + W_UQ); bf16_t* Wukv = (bf16_t*)(ws + W_UKV); bf16_t* Wmixo = (bf16_t*)(ws + W_MIXO);
    bf16_t* Wxq = (bf16_t*)(ws + W_XQ); bf16_t* Wxkv = (bf16_t*)(ws + W_XKV); bf16_t* Wxo = (bf16_t*)(ws + W_XO); bf16_t* W1 = (bf16_t*)(ws + W_1); bf16_t* W2 = (bf16_t*)(ws + W_2);
    const int kind = L % 3, j = L / 3;
    if constexpr (PH == PH_PREP) {
        const float* xin = p.in[0]; const float* mem = p.in[1]; const int* positions = (const int*)p.in[2];
        LAS float* scr = (LAS float*)(lds + wid * 16384);
        if (kind == 0) {
            conv_w(p.in[3] + (size_t)j * 1024 * 704, 1024, 704, 768, Wmixin, scr, gw, NGW, lane);
            conv_w(p.in[6] + (size_t)j * 384 * 1536, 384, 1536, 1536, Wuq, scr, gw, NGW, lane);
            conv_w(p.in[7] + (size_t)j * 256 * 2048, 256, 2048, 2048, Wukv, scr, gw, NGW, lane);
            conv_w(p.in[8] + (size_t)j * 1024 * 1024, 1024, 1024, 1024, Wmixo, scr, gw, NGW, lane);
        } else if (kind == 1) {
            conv_w(p.in[9], 1024, 4112, 4352, Wmixin, scr, gw, NGW, lane);
            conv_w(p.in[14], 1024, 1024, 1024, Wmixo, scr, gw, NGW, lane);
        } else {
            conv_w(p.in[15], 1024, 3072, 3072, Wmixin, scr, gw, NGW, lane);
            conv_w(p.in[17], 1024, 1024, 1024, Wmixo, scr, gw, NGW, lane);
        }
        conv_w(p.in[21] + (size_t)L * 1024 * 1024, 1024, 1024, 1024, Wxq, scr, gw, NGW, lane);
        conv_w(p.in[22] + (size_t)L * 1024 * 2048, 1024, 2048, 2048, Wxkv, scr, gw, NGW, lane);
        conv_w(p.in[23] + (size_t)L * 1024 * 1024, 1024, 1024, 1024, Wxo, scr, gw, NGW, lane);
        conv_w(p.in[24] + (size_t)L * 1024 * 4096, 1024, 4096, 4096, W1, scr, gw, NGW, lane);
        conv_w(p.in[25] + (size_t)L * 4096 * 1024, 4096, 1024, 1024, W2, scr, gw, NGW, lane);
        for (int r = gw; r < T; r += NGW) rms_row((L == 0 ? xin : X) + (size_t)r * D, p.in[18] + L * D, H + (size_t)r * D, L == 0 ? X + (size_t)r * D : nullptr, lane);
        if (L == 0) {
            for (int r = gw; r < 2048; r += NGW) rms_row(mem + (size_t)r * D, p.in[26], MEMN + (size_t)r * D, nullptr, lane);
            for (int i = gtid; i < T * 32; i += NT) { const int r = i >> 5, k = i & 31; const float inv = exp2f(-(float)k * (13.287712379549449f / 32.f));
                const float ang = (float)positions[r] * inv; double rev = (double)ang * 0.15915494309189535; rev -= rint(rev); const float rr = (float)(rev * 6.283185307179586);
                COS[i] = cosf(rr); SIN[i] = sinf(rr); }
        }
    } else if constexpr (PH == PH_IN_MLA) {
        run_gemm(lds, H, Wmixin, T, 768, 1024, FMlaIn{(float*)(ws + A_Z)}, wv);
        run_gemm(lds, MEMN, Wxkv, 2048, 2048, 1024, FMemKV{MK, MVT}, wv);
    } else if constexpr (PH == PH_IN_GDN) {
        run_gemm(lds, H, Wmixin, T, 4352, 1024, FGdnIn{(bf16_t*)(ws + G_PRE), (bf16_t*)(ws + G_GATE), (float*)(ws + G_LOGIT)}, wv);
        run_gemm(lds, MEMN, Wxkv, 2048, 2048, 1024, FMemKV{MK, MVT}, wv);
    } else if constexpr (PH == PH_IN_SC) {
        run_gemm(lds, H, Wmixin, T, 3072, 1024, FBf16{(bf16_t*)(ws + WS_AR), 3072}, wv);
        run_gemm(lds, MEMN, Wxkv, 2048, 2048, 1024, FMemKV{MK, MVT}, wv);
    } else if constexpr (PH == PH_MLA_MID) {
        mla_mid_phase((const float*)(ws + A_Z), p.in[4] + j * 384, p.in[5] + j * 256, COS, SIN, (bf16_t*)(ws + A_CQN), (bf16_t*)(ws + A_CKVN), (bf16_t*)(ws + A_KROPE), gw, NGW, lane);
    } else if constexpr (PH == PH_MLA_UP) {
#ifndef UPSEL
#define UPSEL 3
#endif
        if (UPSEL & 1) run_gemm(lds, (const bf16_t*)(ws + A_CQN), Wuq, T, 1536, 384, FBf16{(bf16_t*)(ws + A_Q), 1536}, wv);
        if (UPSEL & 2) run_gemm(lds, (const bf16_t*)(ws + A_CKVN), Wukv, T, 2048, 256, FUkv{(bf16_t*)(ws + A_KNOPE), (bf16_t*)(ws + A_VT)}, wv);
    } else if constexpr (PH == PH_MLA_ATTN) {
        const bf16_t* Qb = (const bf16_t*)(ws + A_Q); const bf16_t* Kn = (const bf16_t*)(ws + A_KNOPE); const bf16_t* Kr = (const bf16_t*)(ws + A_KROPE); const bf16_t* Vt = (const bf16_t*)(ws + A_VT);
        for (int item = blockIdx.x; item < 256; item += G) {
            const int bh = item >> 2, s = item & 3, b = bh >> 3, h = bh & 7;
            for (int pass = 0; pass < 2; ++pass) { const int qb = pass ? 7 - s : s; const size_t row0 = (size_t)b * SEQ + qb * 256;
                attn_unit<128, 64, 128, 2, true, true>(lds, Qb + row0 * 1536 + h * 192, 1536, Kn + (size_t)b * SEQ * 1024 + h * 128, 1024, Kr + (size_t)b * SEQ * 64, 64,
                    Vt + (size_t)(b * 8 + h) * 128 * 2048, 64, (qb + 1) * 4, qb * 256, H + row0 * 1024 + h * 128, 1024, 0.07216878364870322f * 1.4426950408889634f, COS + row0 * 32, SIN + row0 * 32, wv); }
        }
    } else if constexpr (PH == PH_GDN_CONV) {
        gdn_conv_phase((const bf16_t*)(ws + G_PRE), (bf16_t*)(ws + G_POST), p.in[10], (const float*)(ws + G_LOGIT), p.in[11], p.in[12], (float*)(ws + G_BETA), (float*)(ws + G_G), gw, NGW, lane, gtid, NT);
    } else if constexpr (PH == PH_GDN_CHUNK) {
        gdn_chunk_phase(lds, (const bf16_t*)(ws + G_POST), (const float*)(ws + G_BETA), (const float*)(ws + G_G), (bf16_t*)(ws + G_W), (bf16_t*)(ws + G_UT), (bf16_t*)(ws + G_ATT), (float*)(ws + G_GC), wv);
    } else if constexpr (PH == PH_GDN_SEQ) {
        gdn_seq_phase(lds, (const bf16_t*)(ws + G_POST), (const bf16_t*)(ws + G_W), (const bf16_t*)(ws + G_UT), (const bf16_t*)(ws + G_ATT), (const float*)(ws + G_GC), (const bf16_t*)(ws + G_GATE), p.in[13], H, wv);
    } else if constexpr (PH == PH_SC_MID) {
        sc_mid_phase((const bf16_t*)(ws + WS_AR), p.in[16], H, gtid, NT);
    } else if constexpr (PH == PH_OPROJ) {
        run_gemm(lds, H, Wmixo, T, 1024, 1024, FResid{X}, wv);
    } else if constexpr (PH == PH_XNORM) {
        for (int r = gw; r < T; r += NGW) rms_row(X + (size_t)r * D, p.in[19] + L * D, H + (size_t)r * D, nullptr, lane);
    } else if constexpr (PH == PH_XQ) {
        run_gemm(lds, H, Wxq, T, 1024, 1024, FBf16{(bf16_t*)(ws + WS_AR), 1024}, wv);
    } else if constexpr (PH == PH_XATTN) {
        const bf16_t* Qb = (const bf16_t*)(ws + WS_AR);
        for (int item = blockIdx.x; item < 512; item += G) { const int b = item >> 6, h = (item >> 4) & 3, qb = item & 15; const size_t row0 = (size_t)b * SEQ + qb * 128;
            attn_unit<256, 0, 256, 1, false, false>(lds, Qb + row0 * 1024 + h * 256, 1024, MK + (size_t)b * 256 * 1024 + h * 256, 1024, MK, 0,
                MVT + (size_t)(b * 4 + h) * 256 * 256, 64, 4, 0, H + row0 * 1024 + h * 256, 1024, 0.0625f * 1.4426950408889634f, COS, SIN, wv); }
    } else if constexpr (PH == PH_XO) {
        run_gemm(lds, H, Wxo, T, 1024, 1024, FResid{X}, wv);
    } else if constexpr (PH == PH_MNORM) {
        for (int r = gw; r < T; r += NGW) rms_row(X + (size_t)r * D, p.in[20] + L * D, H + (size_t)r * D, nullptr, lane);
    } else if constexpr (PH == PH_MUP) {
        run_gemm(lds, H, W1, T, 4096, 1024, FRelu2{(bf16_t*)(ws + WS_AR), 4096}, wv);
    } else if constexpr (PH == PH_MDOWN) {
        run_gemm(lds, (const bf16_t*)(ws + WS_AR), W2, T, 1024, 4096, FResid{X}, wv);
    } else if constexpr (PH == PH_FINAL) {
        for (int r = gw; r < T; r += NGW) rms_row_f32(X + (size_t)r * D, p.in[27], lane);
    }
}

#ifndef N_LAUNCH_SPLIT
#define N_LAUNCH_SPLIT 1
#endif
#if N_LAUNCH_SPLIT
template <int PH> __global__ void __launch_bounds__(512) k_phase(Params p) {
    extern __shared__ __attribute__((aligned(16))) unsigned char lds_raw[];
    run_phase<PH>(p, p.L, (LAS unsigned char*)lds_raw, __builtin_amdgcn_readfirstlane((int)threadIdx.x >> 6));
}
template <int PH> static void launch_phase(Params p, int L, int grid, hipStream_t stream) {
    static bool attr = false;
    if (!attr) { (void)hipFuncSetAttribute((const void*)k_phase<PH>, hipFuncAttributeMaxDynamicSharedMemorySize, LDS_BYTES); attr = true; }
    p.L = L;
    hipLaunchKernelGGL(k_phase<PH>, dim3(grid), dim3(512), LDS_BYTES, stream, p);
}
#else
#ifndef PH_MASK
#define PH_MASK 0xFFFFFF
#endif
#define RUN(PH) do { if constexpr ((PH_MASK >> PH) & 1) run_phase<PH>(p, L, lds, wv); if (L == 0 && PH == PH_PREP) grid.sync(); else xcd_barrier(bar); } while (0)
template <int L> __device__ __forceinline__ void run_layer(const Params& p, LAS unsigned char* lds, cg::grid_group& grid, const XcdBarrier& bar, const int wv) {
    constexpr int kind = L % 3;
    RUN(PH_PREP);
    if constexpr (kind == 0) { RUN(PH_IN_MLA); RUN(PH_MLA_MID); RUN(PH_MLA_UP); RUN(PH_MLA_ATTN); }
    else if constexpr (kind == 1) { RUN(PH_IN_GDN); RUN(PH_GDN_CONV); RUN(PH_GDN_CHUNK); RUN(PH_GDN_SEQ); }
    else { RUN(PH_IN_SC); RUN(PH_SC_MID); }
    RUN(PH_OPROJ); RUN(PH_XNORM); RUN(PH_XQ); RUN(PH_XATTN); RUN(PH_XO); RUN(PH_MNORM); RUN(PH_MUP); RUN(PH_MDOWN);
}
#undef RUN
__global__ void __launch_bounds__(512) mega(Params p) {
    extern __shared__ __attribute__((aligned(16))) unsigned char lds_raw[];
    LAS unsigned char* lds = (LAS unsigned char*)lds_raw;
    cg::grid_group grid = cg::this_grid();
    const int wv = __builtin_amdgcn_readfirstlane((int)threadIdx.x >> 6);
    if (threadIdx.x < 2) ((volatile LAS unsigned*)(lds + 131072 + 1024))[threadIdx.x] = 0u;
    __syncthreads();
    const XcdBarrier bar = xcd_barrier_post((unsigned*)p.ws, (volatile LAS unsigned*)(lds + 131072 + 1024));
    run_layer<0>(p, lds, grid, bar, wv); run_layer<1>(p, lds, grid, bar, wv); run_layer<2>(p, lds, grid, bar, wv); run_layer<3>(p, lds, grid, bar, wv);
    run_phase<PH_FINAL>(p, 3, lds, wv);
}
#endif

extern "C" void kernel_launch(void* const* d_in, const int* in_sizes, int n_in, void* d_out, int out_size, void* d_ws, size_t ws_size, hipStream_t stream) {
    static int grid_blocks = 0;
    if (!grid_blocks) {
        if (n_in != 28 || ws_size < WS_END) { fprintf(stderr, "kernel_launch: unexpected n_in %d / ws_size %zu (need %zu)\n", n_in, ws_size, (size_t)WS_END); grid_blocks = -1; return; }
        int dev = 0, cus = 0;
        (void)hipGetDevice(&dev);
        (void)hipDeviceGetAttribute(&cus, hipDeviceAttributeMultiprocessorCount, dev);
        if (cus < 1) cus = 256;
#if N_LAUNCH_SPLIT
        grid_blocks = cus;
#else
        int per_cu = 0;
        (void)hipFuncSetAttribute((const void*)mega, hipFuncAttributeMaxDynamicSharedMemorySize, LDS_BYTES);
        (void)hipOccupancyMaxActiveBlocksPerMultiprocessor(&per_cu, (const void*)mega, 512, LDS_BYTES);
        if (per_cu < 1) per_cu = 1;
        grid_blocks = cus * per_cu;
#endif
        (void)hipGetLastError();
    }
    if (grid_blocks < 0) return;
    Params p{};
    for (int i = 0; i < 28; ++i) p.in[i] = (const float*)d_in[i];
    p.out = (float*)d_out; p.ws = (unsigned char*)d_ws;
#if N_LAUNCH_SPLIT
    const int g = grid_blocks;
    for (int L = 0; L < 4; ++L) {
        const int kind = L % 3;
        launch_phase<PH_PREP>(p, L, g, stream);
        if (kind == 0) { launch_phase<PH_IN_MLA>(p, L, g, stream); launch_phase<PH_MLA_MID>(p, L, g, stream); launch_phase<PH_MLA_UP>(p, L, g, stream); launch_phase<PH_MLA_ATTN>(p, L, g, stream); }
        else if (kind == 1) { launch_phase<PH_IN_GDN>(p, L, g, stream); launch_phase<PH_GDN_CONV>(p, L, g, stream); launch_phase<PH_GDN_CHUNK>(p, L, g, stream); launch_phase<PH_GDN_SEQ>(p, L, g, stream); }
        else { launch_phase<PH_IN_SC>(p, L, g, stream); launch_phase<PH_SC_MID>(p, L, g, stream); }
        launch_phase<PH_OPROJ>(p, L, g, stream); launch_phase<PH_XNORM>(p, L, g, stream); launch_phase<PH_XQ>(p, L, g, stream); launch_phase<PH_XATTN>(p, L, g, stream);
        launch_phase<PH_XO>(p, L, g, stream); launch_phase<PH_MNORM>(p, L, g, stream); launch_phase<PH_MUP>(p, L, g, stream); launch_phase<PH_MDOWN>(p, L, g, stream);
    }
    launch_phase<PH_FINAL>(p, 3, g, stream);
#else
    (void)hipMemsetAsync(d_ws, 0, 16384, stream);
    void* args[] = {&p};
    hipError_t e = hipLaunchCooperativeKernel((const void*)mega, dim3(grid_blocks), dim3(512), args, LDS_BYTES, stream);
    if (e != hipSuccess) fprintf(stderr, "cooperative launch failed: %s (grid %d)\n", hipGetErrorString(e), grid_blocks);
#endif
}
```

```cpp
#include <hip/hip_runtime.h>
#include <hip/hip_cooperative_groups.h>
#include <cstdio>
#include <cstdint>
namespace cg = cooperative_groups;
namespace pg8 {
#define PG8_LAS __attribute__((address_space(3)))
typedef unsigned short bf16_t;
typedef short bf16x8 __attribute__((ext_vector_type(8)));
typedef float f32x4 __attribute__((ext_vector_type(4)));
typedef unsigned u32x4 __attribute__((ext_vector_type(4)));
constexpr int BM = 256, BK = 64, HALF = 128, HTB = HALF * BK * 2  , STAGE_BYTES = 8 * HTB, NXCD = 8, WGM = 8;

__host__ __device__ __forceinline__ int lds_byte(int r, int c) { const int st = (r >> 4) * 2 + (c >> 5), rr = r & 15, cc = c & 31, ob = rr * 64 + cc * 2; return st * 1024 + (ob ^ (((ob >> 9) & 1) << 5)); }
__host__ __device__ __forceinline__ void stage_rc(int b, int& R, int& C) { const int st = b / 1024, sb = b % 1024, swz = sb ^ (((sb >> 9) & 1) << 5); R = (st >> 1) * 16 + swz / 64; C = (st & 1) * 32 + (swz % 64) / 2; }
__host__ __device__ __forceinline__ int perm32(int rho) { const int n = rho >> 4, i = rho & 15; return 8 * (i >> 2) + 4 * n + (i & 3); }

struct Unit { int pm, pn; };
struct Gemm { const bf16_t* A; const bf16_t* Bt; int M, N, K; };

struct StaticOrder {
    int nM, nN, nwg, G, c;
    __host__ __device__ void init(int M, int N, int G_, int c_) { nM = M / BM; nN = N / BM; nwg = nM * nN; G = G_; c = c_; }
    __host__ __device__ bool next(int i, Unit& u) const {
        const long L = (long)i * G + c; if (L >= nwg) return false;
        int wgid = (int)L; { const int q = nwg / NXCD, r = nwg % NXCD, xcd = wgid % NXCD, off = wgid / NXCD; wgid = (xcd < r ? xcd * (q + 1) : r * (q + 1) + (xcd - r) * q) + off; }
        const int nig = WGM * nN, gid = wgid / nig, fm = gid * WGM, gsz = (nM - fm) < WGM ? (nM - fm) : WGM;
        u.pm = fm + ((wgid % nig) % gsz); u.pn = (wgid % nig) / gsz; return true;
    }
    __device__ __forceinline__ void a_ready(const Unit&) const {}
    __device__ __forceinline__ void done(const Unit&) const {}
};

__device__ __forceinline__ unsigned cvt_pk_bf16(float lo, float hi) { unsigned r; asm volatile("v_cvt_pk_bf16_f32 %0, %1, %2" : "=v"(r) : "v"(lo), "v"(hi)); return r; }
__device__ __forceinline__ int opq_tid(int wv) { int l; asm volatile("v_mbcnt_lo_u32_b32 %0, -1, 0\n\tv_mbcnt_hi_u32_b32 %0, -1, %0" : "=v"(l)); return wv * 64 + l; }
template <class Epi, class Sched, bool ALIGN_EPI = false, bool SP2 = false>
__device__ __forceinline__ void gemm_phase(PG8_LAS unsigned char* lds, const Gemm g, const Sched& S, const Epi& E, const int wv) {
    const int tid = opq_tid(wv), wid = __builtin_amdgcn_readfirstlane(tid >> 6), lane = tid & 63, wr = wid >> 2, wc = wid & 3, fr = lane & 15, fq = lane >> 4;
    const int K = g.K, nt = K / BK;
    unsigned voffA[2], voffB[2];
#pragma unroll
    for (int i = 0; i < 2; ++i) { int R, C; stage_rc(tid * 16 + i * 8192, R, C); const int Rb = Epi::PERM ? ((R & ~31) + perm32(R & 31)) : R;
        voffA[i] = (unsigned)(R * K + C) * 2u; voffB[i] = (unsigned)(Rb * K + C) * 2u; }
    const size_t kstep = (size_t)(BK * 2);
    const size_t hstep = (size_t)HALF * K * 2;
    const size_t tstep = 2 * hstep;
    const unsigned ldsw = (unsigned)wid * 1024u;
    const int aoff = lds_byte(wr * 64 + fr, fq * 8), boff = lds_byte(wc * 32 + fr, fq * 8);
#define PG8_SA(b, h) (((b) * 2 + (h)) * HTB)
#define PG8_SB(b, h) ((4 + (b) * 2 + (h)) * HTB)
#define PG8_STAGE(bufoff, gbase, voff) do { _Pragma("unroll") for (int _i = 0; _i < 2; ++_i) \
        __builtin_amdgcn_global_load_lds((const unsigned*)((const char*)(gbase) + (voff)[_i]), (PG8_LAS unsigned*)(lds + (bufoff) + ldsw + _i * 8192), 16, 0, 0); } while (0)
#define PG8_LDA(dst, b, h) do { _Pragma("unroll") for (int m = 0; m < 4; ++m) _Pragma("unroll") for (int k = 0; k < 2; ++k) dst[m][k] = *(const PG8_LAS bf16x8*)(lds + PG8_SA(b, h) + aoff + m * 2048 + k * 1024); } while (0)
#define PG8_LDB(dst, b, h) do { _Pragma("unroll") for (int n = 0; n < 2; ++n) _Pragma("unroll") for (int k = 0; k < 2; ++k) dst[n][k] = *(const PG8_LAS bf16x8*)(lds + PG8_SB(b, h) + boff + n * 2048 + k * 1024); } while (0)
#define PG8_MMA(ai, bj, At, Bt) do { __builtin_amdgcn_s_setprio(1); _Pragma("unroll") for (int m = 0; m < 4; ++m) _Pragma("unroll") for (int n = 0; n < 2; ++n) _Pragma("unroll") for (int k = 0; k < 2; ++k) \
        acc[ai][bj][m][n] = __builtin_amdgcn_mfma_f32_16x16x32_bf16(Bt[n][k], At[m][k], acc[ai][bj][m][n], 0, 0, 0); __builtin_amdgcn_s_setprio(0); } while (0)
#define PG8_WAIT_V(n) asm volatile("s_waitcnt vmcnt(" #n ")" ::: "memory")
#define PG8_WAIT_L(n) asm volatile("s_waitcnt lgkmcnt(" #n ")" ::: "memory")
#define PG8_BAR __builtin_amdgcn_s_barrier()
#define PG8_SCHED __builtin_amdgcn_sched_barrier(0)
    Unit cur, nxt; int ui = 0;
    if (!S.next(0, cur)) return;
    f32x4 acc[2][2][4][2];
#pragma unroll
    for (int a = 0; a < 2; ++a)
#pragma unroll
        for (int b = 0; b < 2; ++b)
#pragma unroll
            for (int m = 0; m < 4; ++m)
#pragma unroll
                for (int n = 0; n < 2; ++n) acc[a][b][m][n] = (f32x4){0.f, 0.f, 0.f, 0.f};
    bf16x8 At[4][2], B0[2][2], B1[2][2];
    const char* cA = (const char*)g.A + (size_t)cur.pm * tstep; const char* cB = (const char*)g.Bt + (size_t)cur.pn * tstep;
    S.a_ready(cur);
    if constexpr (SP2) {
        PG8_STAGE(PG8_SB(0, 0), cB, voffB); PG8_STAGE(PG8_SB(0, 1), cB + hstep, voffB); PG8_STAGE(PG8_SA(0, 0), cA, voffA); PG8_STAGE(PG8_SA(0, 1), cA + hstep, voffA);
        if (wr == 1) PG8_BAR;
        PG8_WAIT_V(2); PG8_BAR;
        PG8_STAGE(PG8_SB(1, 0), cB + kstep, voffB); PG8_STAGE(PG8_SA(1, 0), cA + kstep, voffA); PG8_STAGE(PG8_SB(1, 1), cB + hstep + kstep, voffB);
        PG8_WAIT_V(6); PG8_BAR;
    } else {
        PG8_STAGE(PG8_SB(0, 0), cB, voffB); PG8_STAGE(PG8_SA(0, 0), cA, voffA); PG8_STAGE(PG8_SB(0, 1), cB + hstep, voffB); PG8_STAGE(PG8_SA(0, 1), cA + hstep, voffA);
        if (wr == 1) PG8_BAR;
        PG8_WAIT_V(4); PG8_BAR;
        PG8_STAGE(PG8_SB(1, 0), cB + kstep, voffB); PG8_STAGE(PG8_SA(1, 0), cA + kstep, voffA); PG8_STAGE(PG8_SB(1, 1), cB + hstep + kstep, voffB);
        PG8_WAIT_V(6); PG8_BAR;
    }
    for (;;) {
        const bool has_next = S.next(ui + 1, nxt);
        const char* nA = has_next ? (const char*)g.A + (size_t)nxt.pm * tstep : cA; const char* nB = has_next ? (const char*)g.Bt + (size_t)nxt.pn * tstep : cB;
        for (int t = 0; t < nt; t += 2) {
            const bool last = (t == nt - 2);
            const char* a1 = cA + (size_t)(t + 1) * kstep;
            const char* a2 = last ? nA : cA + (size_t)(t + 2) * kstep; const char* b2 = last ? nB : cB + (size_t)(t + 2) * kstep;
            const char* a3 = a2 + kstep; const char* b3 = b2 + kstep;
            if (last && has_next) S.a_ready(nxt);
            if constexpr (SP2) {
            PG8_LDB(B0, 0, 0); PG8_LDB(B1, 0, 1); PG8_SCHED; PG8_LDA(At, 0, 0); PG8_STAGE(PG8_SA(1, 1), a1 + hstep, voffA);
            PG8_WAIT_V(8); PG8_WAIT_L(0); PG8_BAR; PG8_MMA(0, 0, At, B0); PG8_MMA(0, 1, At, B1); PG8_BAR; PG8_SCHED;
            PG8_LDA(At, 0, 1); PG8_STAGE(PG8_SB(0, 0), b2, voffB); PG8_STAGE(PG8_SB(0, 1), b2 + hstep, voffB); PG8_STAGE(PG8_SA(0, 0), a2, voffA);
            PG8_WAIT_V(8); PG8_WAIT_L(0); PG8_BAR; PG8_MMA(1, 0, At, B0); PG8_MMA(1, 1, At, B1); PG8_BAR; PG8_SCHED;
            PG8_LDB(B0, 1, 0); PG8_LDB(B1, 1, 1); PG8_SCHED; PG8_LDA(At, 1, 0); PG8_STAGE(PG8_SA(0, 1), a2 + hstep, voffA);
            PG8_WAIT_V(8); PG8_WAIT_L(0); PG8_BAR; PG8_MMA(0, 0, At, B0); PG8_MMA(0, 1, At, B1); PG8_BAR; PG8_SCHED;
            PG8_LDA(At, 1, 1); PG8_STAGE(PG8_SB(1, 0), b3, voffB); PG8_STAGE(PG8_SB(1, 1), b3 + hstep, voffB); PG8_STAGE(PG8_SA(1, 0), a3, voffA);
            PG8_WAIT_V(8); PG8_WAIT_L(0); PG8_BAR; PG8_MMA(1, 0, At, B0); PG8_MMA(1, 1, At, B1); PG8_BAR; PG8_SCHED;
            } else {
            PG8_LDB(B0, 0, 0); PG8_SCHED; PG8_LDA(At, 0, 0); PG8_STAGE(PG8_SA(1, 1), a1 + hstep, voffA);
            PG8_WAIT_L(8); PG8_BAR; PG8_WAIT_L(0); PG8_MMA(0, 0, At, B0); PG8_BAR; PG8_SCHED;
            PG8_LDB(B1, 0, 1); PG8_STAGE(PG8_SB(0, 0), b2, voffB);
            PG8_BAR; PG8_WAIT_L(0); PG8_MMA(0, 1, At, B1); PG8_BAR;
            PG8_LDA(At, 0, 1); PG8_STAGE(PG8_SA(0, 0), a2, voffA);
            PG8_BAR; PG8_WAIT_L(0); PG8_MMA(1, 0, At, B0); PG8_BAR; PG8_SCHED;
            PG8_STAGE(PG8_SB(0, 1), b2 + hstep, voffB);
            PG8_WAIT_V(6); PG8_BAR; PG8_MMA(1, 1, At, B1); PG8_BAR;
            PG8_LDB(B0, 1, 0); PG8_SCHED; PG8_LDA(At, 1, 0); PG8_STAGE(PG8_SA(0, 1), a2 + hstep, voffA);
            PG8_WAIT_L(8); PG8_BAR; PG8_WAIT_L(0); PG8_MMA(0, 0, At, B0); PG8_BAR; PG8_SCHED;
            PG8_LDB(B1, 1, 1); PG8_STAGE(PG8_SB(1, 0), b3, voffB);
            PG8_BAR; PG8_WAIT_L(0); PG8_MMA(0, 1, At, B1); PG8_BAR;
            PG8_LDA(At, 1, 1); PG8_STAGE(PG8_SA(1, 0), a3, voffA);
            PG8_BAR; PG8_WAIT_L(0); PG8_MMA(1, 0, At, B0); PG8_BAR; PG8_SCHED;
            PG8_STAGE(PG8_SB(1, 1), b3 + hstep, voffB);
            PG8_WAIT_V(6); PG8_BAR; PG8_MMA(1, 1, At, B1); PG8_BAR;
            }
        }
        if constexpr (ALIGN_EPI) { if (wr == 0) PG8_BAR; }
        if constexpr (!Epi::AFTER_DRAIN) { E(acc, cur, wr, wc, fr, fq); S.done(cur); }
        if (!has_next) break;
#pragma unroll
        for (int a = 0; a < 2; ++a)
#pragma unroll
            for (int b = 0; b < 2; ++b)
#pragma unroll
                for (int m = 0; m < 4; ++m)
#pragma unroll
                    for (int n = 0; n < 2; ++n) acc[a][b][m][n] = (f32x4){0.f, 0.f, 0.f, 0.f};
        cur = nxt; cA = nA; cB = nB; ++ui;
        if constexpr (ALIGN_EPI) { if (wr == 1) PG8_BAR; }
    }
    PG8_WAIT_V(0);
    if constexpr (!ALIGN_EPI) { if (wr == 0) PG8_BAR; }
    PG8_BAR;
    if constexpr (Epi::AFTER_DRAIN) { E.fused(acc, cur, wr, wc, fr, fq, lds, wid, lane); S.done(cur); }
#undef PG8_SA
#undef PG8_SB
#undef PG8_STAGE
#undef PG8_LDA
#undef PG8_LDB
#undef PG8_MMA
#undef PG8_WAIT_V
#undef PG8_WAIT_L
#undef PG8_BAR
#undef PG8_SCHED
}
}
#define LAS __attribute__((address_space(3)))
typedef unsigned short bf16_t;
typedef short bf16x8 __attribute__((ext_vector_type(8)));
typedef short bf16x4 __attribute__((ext_vector_type(4)));
typedef float f32x4 __attribute__((ext_vector_type(4)));
typedef float f32x2 __attribute__((ext_vector_type(2)));
typedef unsigned u32x4 __attribute__((ext_vector_type(4)));
typedef unsigned u32x2 __attribute__((ext_vector_type(2)));
typedef __bf16 bf16x2_t __attribute__((ext_vector_type(2)));

constexpr int T = 16384, D = 1024, SEQ = 2048;
constexpr float EPS = 1e-6f;
constexpr size_t MiB = 1u << 20;
constexpr int LDS_BYTES = 131072 + 2048;
#ifndef N_LAUNCH_SPLIT
#define N_LAUNCH_SPLIT 0
#endif

constexpr size_t W_MIXIN = 1 * MiB, W_UQ = 10 * MiB, W_UKV = 12 * MiB, W_MIXO = 13 * MiB, W_XQ = 15 * MiB, W_XKV = 17 * MiB, W_XO = 21 * MiB, W_1 = 23 * MiB, W_2 = 31 * MiB;
constexpr size_t WS_H = 39 * MiB, WS_MEMN = 71 * MiB, WS_MK = 75 * MiB, WS_MVT = 79 * MiB, WS_COS = 83 * MiB, WS_SIN = 85 * MiB, WS_AR = 87 * MiB;
constexpr size_t A_Z = WS_AR, A_CQN = WS_AR + 44 * MiB, A_CKVN = WS_AR + 56 * MiB, A_KROPE = WS_AR + 64 * MiB, A_Q = WS_AR + 66 * MiB, A_KNOPE = WS_AR + 114 * MiB, A_VT = WS_AR + 146 * MiB;
constexpr size_t G_PRE = WS_AR, G_POST = WS_AR + 96 * MiB, G_GATE = WS_AR + 192 * MiB, G_LOGIT = WS_AR + 224 * MiB, G_BETA = WS_AR + 225 * MiB, G_G = G_BETA + MiB / 2, G_GC = WS_AR + 226 * MiB;
constexpr size_t G_W = WS_AR, G_UT = WS_AR + 32 * MiB, G_ATT = WS_AR + 64 * MiB;
constexpr size_t WS_END = WS_AR + 227 * MiB;

__device__ __forceinline__ float shx(float v, int m, int lane) { return __int_as_float(__builtin_amdgcn_ds_bpermute((lane ^ m) << 2, __float_as_int(v))); }
__device__ __forceinline__ float wave_sum(float v, int lane) {
#pragma unroll
    for (int o = 32; o > 0; o >>= 1) v += shx(v, o, lane);
    return v;
}
__device__ __forceinline__ float bf2f(unsigned short b) { return __uint_as_float(((unsigned)b) << 16); }
__device__ __forceinline__ unsigned pk2(float lo, float hi) { f32x2 v = {lo, hi}; bf16x2_t b = __builtin_convertvector(v, bf16x2_t); return __builtin_bit_cast(unsigned, b); }
__device__ __forceinline__ unsigned short f2bf(float f) { return (unsigned short)(pk2(f, 0.f) & 0xffffu); }
__device__ __forceinline__ float silu_f(float x) { return x / (1.f + __expf(-x)); }
__device__ __forceinline__ u32x2 pk4(f32x4 v) { u32x2 r; r.x = pk2(v[0], v[1]); r.y = pk2(v[2], v[3]); return r; }
#define MFMA16(a, b, c) __builtin_amdgcn_mfma_f32_16x16x32_bf16((a), (b), (c), 0, 0, 0)

template <class F> struct EpiF {
    static constexpr bool PERM = false, AFTER_DRAIN = false;
    F f;
    __device__ __forceinline__ void operator()(const pg8::f32x4 (&acc)[2][2][4][2], const pg8::Unit& u, int wr, int wc, int fr, int fq) const {
#pragma unroll
        for (int ai = 0; ai < 2; ++ai)
#pragma unroll
            for (int m = 0; m < 4; ++m) {
                const int row = u.pm * 256 + ai * 128 + wr * 64 + m * 16 + fr;
                const float rs = f.rs(row); float part = 0.f;
#pragma unroll
                for (int bj = 0; bj < 2; ++bj)
#pragma unroll
                    for (int n = 0; n < 2; ++n) { const int col = u.pn * 256 + bj * 128 + wc * 32 + n * 16 + fq * 4; part += f(row, col, acc[ai][bj][m][n] * rs, bj); __builtin_amdgcn_sched_barrier(0); }
                f.row_done(row, part, fr, fq, u.pn * 4 + wc);
                asm volatile("" ::: "memory");
            }
    }
};
template <class F> __device__ __forceinline__ void run_gemm(LAS unsigned char* lds, const bf16_t* A, const bf16_t* Bt, int M, int N, int K, const F& f, const int wv, const int cshift = 0) {
    pg8::Gemm g{A, Bt, M, N, K}; pg8::StaticOrder S; int cc_ = (int)blockIdx.x + cshift; if (cc_ >= (int)gridDim.x) cc_ -= (int)gridDim.x; S.init(M, N, (int)gridDim.x, cc_);
    EpiF<F> E{f};
    pg8::gemm_phase<EpiF<F>, pg8::StaticOrder, true, true>(lds, g, S, E, wv);
}
#define F_NOSCALE __device__ __forceinline__ float rs(int) const { return 1.f; }
#define F_SCALE   __device__ __forceinline__ float rs(int row) const { const f32x4* q_ = (const f32x4*)(ssq + (size_t)row * 16); const f32x4 a_ = q_[0], b_ = q_[1], c_ = q_[2], d_ = q_[3]; \
    const f32x4 t_ = (a_ + b_) + (c_ + d_); return rsqrtf(((t_[0] + t_[1]) + (t_[2] + t_[3])) * (1.f / D) + EPS); }
#define F_NODONE  __device__ __forceinline__ void row_done(int, float, int, int, int) const {}
struct FResid { float* x; bf16_t* xb; float* ssq; F_NOSCALE
    __device__ __forceinline__ float operator()(int row, int col, f32x4 v, int bj) const { f32x4* p = (f32x4*)(x + (size_t)row * D + col); const f32x4 o = *p + v; *p = o;
        *(u32x2*)(xb + (size_t)row * D + col) = pk4(o); return (o[0] * o[0] + o[1] * o[1]) + (o[2] * o[2] + o[3] * o[3]); }
    __device__ __forceinline__ void row_done(int row, float part, int fr, int fq, int slot) const { const int lane = fq * 16 + fr; part += shx(part, 16, lane); part += shx(part, 32, lane); if (fq == 0) ssq[(size_t)row * 16 + slot] = part; } };
struct FBf16 { bf16_t* O; int ldc; F_NOSCALE F_NODONE __device__ __forceinline__ float operator()(int row, int col, f32x4 v, int bj) const { *(u32x2*)(O + (size_t)row * ldc + col) = pk4(v); return 0.f; } };
struct FBf16S { bf16_t* O; int ldc; const float* ssq; F_SCALE F_NODONE __device__ __forceinline__ float operator()(int row, int col, f32x4 v, int bj) const { *(u32x2*)(O + (size_t)row * ldc + col) = pk4(v); return 0.f; } };
struct FRelu2 { bf16_t* O; int ldc; const float* ssq; F_SCALE F_NODONE __device__ __forceinline__ float operator()(int row, int col, f32x4 v, int bj) const {
    f32x4 r; for (int e = 0; e < 4; ++e) { const float t = v[e] > 0.f ? v[e] : 0.f; r[e] = t * t; } *(u32x2*)(O + (size_t)row * ldc + col) = pk4(r); return 0.f; } };
struct FMlaIn { float* z; const float* ssq; F_SCALE F_NODONE __device__ __forceinline__ float operator()(int row, int col, f32x4 v, int bj) const { if (col < 704) *(f32x4*)(z + (size_t)row * 704 + col) = v; return 0.f; } };
struct FMemKV { bf16_t* K; bf16_t* Vt; F_NOSCALE F_NODONE __device__ __forceinline__ float operator()(int row, int col, f32x4 v, int bj) const {
    if (col < 1024) { *(u32x2*)(K + (size_t)row * 1024 + col) = pk4(v); }
    else { const int c = col - 1024, hh = c >> 8, d = c & 255, b = row >> 8, m = row & 255; bf16_t* p = Vt + (size_t)(((b * 4 + hh) * 4 + (m >> 6)) * 16384 + d * 64 + (m & 63));
#pragma unroll
        for (int e = 0; e < 4; ++e) p[e * 64] = f2bf(v[e]); } return 0.f; } };
struct FUkv { bf16_t* kn; bf16_t* Vt; F_NOSCALE F_NODONE __device__ __forceinline__ float operator()(int row, int col, f32x4 v, int bj) const {
    const int hh = col >> 8, wi = col & 255;
    if (bj == 0) { *(u32x2*)(kn + (size_t)row * 1024 + hh * 128 + wi) = pk4(v); }
    else { const int d = wi - 128, b = row >> 11, s = row & 2047; bf16_t* p = Vt + (size_t)(((b * 8 + hh) * 32 + (s >> 6)) * 8192 + d * 64 + (s & 63));
#pragma unroll
        for (int e = 0; e < 4; ++e) p[e * 64] = f2bf(v[e]); } return 0.f; } };
struct FGdnIn { bf16_t* qkv; bf16_t* gate; float* logit; const float* ssq; F_SCALE F_NODONE __device__ __forceinline__ float operator()(int row, int col, f32x4 v, int bj) const {
    if (col < 3072) *(u32x2*)(qkv + (size_t)row * 3072 + col) = pk4(v);
    else if (col < 4096) *(u32x2*)(gate + (size_t)row * 1024 + (col - 3072)) = pk4(v);
    else if (col < 4112) *(f32x4*)(logit + (size_t)row * 16 + (col - 4096)) = v; return 0.f; } };

__device__ __forceinline__ void conv_w(const float* __restrict__ W, int K, int Nvalid, int Npad, bf16_t* __restrict__ WT, LAS float* scr, int gw, int NGW, int lane, const float* __restrict__ gk = nullptr) {
    const int nblk = Npad / 32, nitems = (K / 64) * nblk;
    for (int it = gw; it < nitems; it += NGW) {
        const int kb = it / nblk, nb = it - kb * nblk, k0 = 64 * kb, n0 = 32 * nb;
        const int n = n0 + (lane & 31);
#pragma unroll 8
        for (int i = 0; i < 32; ++i) { const int kk = 2 * i + (lane >> 5); float wv_ = (n < Nvalid) ? W[(size_t)(k0 + kk) * Nvalid + n] : 0.f; if (gk) wv_ *= gk[k0 + kk]; scr[kk * 33 + (lane & 31)] = wv_; }
        asm volatile("s_waitcnt lgkmcnt(0)" ::: "memory");
        const int c = lane & 7;
#pragma unroll
        for (int j = 0; j < 4; ++j) { const int nn = (lane >> 3) + 8 * j; const LAS float* s = scr + (8 * c) * 33 + nn;
            u32x4 o; o.x = pk2(s[0 * 33], s[1 * 33]); o.y = pk2(s[2 * 33], s[3 * 33]); o.z = pk2(s[4 * 33], s[5 * 33]); o.w = pk2(s[6 * 33], s[7 * 33]);
            *(u32x4*)(WT + (size_t)(n0 + nn) * K + k0 + 8 * c) = o; }
        asm volatile("s_waitcnt lgkmcnt(0)" ::: "memory");
    }
}
__device__ __forceinline__ void init_row(const float* xrow, float* copy, bf16_t* orow, float* ssq_row, int lane) {
    const f32x4* xr = (const f32x4*)xrow + lane;
    f32x4 v[4]; float s = 0.f;
#pragma unroll
    for (int j = 0; j < 4; ++j) { v[j] = xr[64 * j]; s += (v[j][0] * v[j][0] + v[j][1] * v[j][1]) + (v[j][2] * v[j][2] + v[j][3] * v[j][3]); }
    s = wave_sum(s, lane);
    u32x2* o8 = (u32x2*)orow + lane;
#pragma unroll
    for (int j = 0; j < 4; ++j) { ((f32x4*)copy + lane)[64 * j] = v[j]; o8[64 * j] = pk4(v[j]); }
    if (lane < 16) ssq_row[lane] = (lane == 0) ? s : 0.f;
}
__device__ __forceinline__ void rms_row(const float* xrow, const float* g, bf16_t* orow, float* copy, int lane) {
    const f32x4* xr = (const f32x4*)xrow + lane; const f32x4* gr = (const f32x4*)g + lane;
    f32x4 v[4]; float s = 0.f;
#pragma unroll
    for (int j = 0; j < 4; ++j) { v[j] = xr[64 * j]; s += (v[j][0] * v[j][0] + v[j][1] * v[j][1]) + (v[j][2] * v[j][2] + v[j][3] * v[j][3]); }
    const float rstd = rsqrtf(wave_sum(s, lane) * (1.f / D) + EPS);
    u32x2* o8 = (u32x2*)orow + lane;
#pragma unroll
    for (int j = 0; j < 4; ++j) { if (copy) ((f32x4*)copy + lane)[64 * j] = v[j]; const f32x4 gg = gr[64 * j]; o8[64 * j] = pk4(v[j] * rstd * gg); }
}
__device__ __forceinline__ void rms_row_f32(float* xrow, const float* g, int lane) {
    f32x4* xr = (f32x4*)xrow + lane; const f32x4* gr = (const f32x4*)g + lane;
    f32x4 v[4]; float s = 0.f;
#pragma unroll
    for (int j = 0; j < 4; ++j) { v[j] = xr[64 * j]; s += (v[j][0] * v[j][0] + v[j][1] * v[j][1]) + (v[j][2] * v[j][2] + v[j][3] * v[j][3]); }
    const float rstd = rsqrtf(wave_sum(s, lane) * (1.f / D) + EPS);
#pragma unroll
    for (int j = 0; j < 4; ++j) xr[64 * j] = v[j] * rstd * gr[64 * j];
}

template <int DK1, int DK2, int DV, int RT, bool CAUSAL, bool ROPE>
__device__ __forceinline__ void attn_unit(LAS unsigned char* lds, const bf16_t* __restrict__ Q, int ldq, const bf16_t* __restrict__ K1, int ldk1, const bf16_t* __restrict__ K2, int ldk2,
                                          const bf16_t* __restrict__ Vt, int ldvt, int nkt, int q0, bf16_t* __restrict__ O, int ldo, float sl2, const float* __restrict__ cosr, const float* __restrict__ sinr, const int wv) {
    constexpr int DQK = DK1 + DK2, NKS = DQK / 32, NDT = DV / 16, KP = DQK + 8, VP = 72, KCH = DQK / 8;
    LAS bf16_t* Ks = (LAS bf16_t*)lds;
    LAS bf16_t* Vs = (LAS bf16_t*)(lds + 64 * KP * 2);
    const int tid = pg8::opq_tid(wv), lane = tid & 63, wid = tid >> 6, fr = lane & 15, fq = lane >> 4;
    const int wrow0 = wid * 16 * RT;
    bf16x8 qf[RT][NKS];
#pragma unroll
    for (int rt = 0; rt < RT; ++rt)
#pragma unroll
        for (int ks = 0; ks < NKS; ++ks) qf[rt][ks] = *(const bf16x8*)(Q + (size_t)(wrow0 + rt * 16 + fr) * ldq + ks * 32 + fq * 8);
    if (ROPE) {
#pragma unroll
        for (int rt = 0; rt < RT; ++rt) {
            const int row = wrow0 + rt * 16 + fr; constexpr int k1 = DK1 / 32;
            bf16x8 a = qf[rt][k1], b = qf[rt][k1 + 1], oa, ob;
#pragma unroll
            for (int j = 0; j < 8; ++j) { const float c = cosr[row * 32 + fq * 8 + j], s = sinr[row * 32 + fq * 8 + j];
                const float x1 = bf2f((unsigned short)a[j]), x2 = bf2f((unsigned short)b[j]);
                oa[j] = (short)f2bf(x1 * c - x2 * s); ob[j] = (short)f2bf(x2 * c + x1 * s); }
            qf[rt][k1] = oa; qf[rt][k1 + 1] = ob;
        }
    }
    float m_run[RT], l_run[RT]; f32x4 oacc[RT][NDT];
#pragma unroll
    for (int rt = 0; rt < RT; ++rt) { m_run[rt] = -INFINITY; l_run[rt] = 0.f;
#pragma unroll
        for (int dt = 0; dt < NDT; ++dt) oacc[rt][dt] = (f32x4){0.f, 0.f, 0.f, 0.f}; }
    for (int kt = 0; kt < nkt; ++kt) {
        __syncthreads();
#pragma unroll
        for (int i = 0; i < (64 * KCH) / 512; ++i) { const int id = tid + 512 * i, key = id / KCH, c = id - key * KCH;
            const bf16_t* src = (c < DK1 / 8) ? (K1 + (size_t)(kt * 64 + key) * ldk1 + c * 8) : (K2 + (size_t)(kt * 64 + key) * ldk2 + (c - DK1 / 8) * 8);
            *(LAS u32x4*)(Ks + key * KP + c * 8) = *(const u32x4*)src; }
#pragma unroll
        for (int i = 0; i < (DV * 8) / 512; ++i) { const int id = tid + 512 * i, d = id >> 3, c = id & 7;
            *(LAS u32x4*)(Vs + d * VP + c * 8) = *(const u32x4*)(Vt + (size_t)kt * (DV * 64) + d * 64 + c * 8); }
        __syncthreads();
        if (CAUSAL && kt * 64 > q0 + wrow0 + 16 * RT - 1) continue;
        f32x4 sacc[RT][4];
#pragma unroll
        for (int rt = 0; rt < RT; ++rt)
#pragma unroll
            for (int ct = 0; ct < 4; ++ct) sacc[rt][ct] = (f32x4){0.f, 0.f, 0.f, 0.f};
#pragma unroll
        for (int ct = 0; ct < 4; ++ct)
#pragma unroll
            for (int ks = 0; ks < NKS; ++ks) { const bf16x8 kf = *(const LAS bf16x8*)(Ks + (ct * 16 + fr) * KP + ks * 32 + fq * 8);
#pragma unroll
                for (int rt = 0; rt < RT; ++rt) sacc[rt][ct] = MFMA16(kf, qf[rt][ks], sacc[rt][ct]);
                if ((ks & 1) == 1) __builtin_amdgcn_sched_barrier(0); }
        const bool need_mask = CAUSAL && (kt * 64 + 63 > q0 + wrow0);
        bf16x8 pf[RT][2];
#pragma unroll
        for (int rt = 0; rt < RT; ++rt) {
            const int qi = q0 + wrow0 + rt * 16 + fr;
            float mx = -INFINITY;
#pragma unroll
            for (int ct = 0; ct < 4; ++ct)
#pragma unroll
                for (int e = 0; e < 4; ++e) { float s = sacc[rt][ct][e] * sl2; if (need_mask && (kt * 64 + ct * 16 + fq * 4 + e > qi)) s = -INFINITY; sacc[rt][ct][e] = s; mx = fmaxf(mx, s); }
            mx = fmaxf(mx, shx(mx, 16, lane)); mx = fmaxf(mx, shx(mx, 32, lane));
            const float m_new = fmaxf(m_run[rt], mx);
            const float alpha = exp2f(m_run[rt] - m_new); m_run[rt] = m_new;
            float ls = 0.f;
#pragma unroll
            for (int ct = 0; ct < 4; ++ct)
#pragma unroll
                for (int e = 0; e < 4; ++e) { const float p = exp2f(sacc[rt][ct][e] - m_new); sacc[rt][ct][e] = p; ls += p; }
            l_run[rt] = l_run[rt] * alpha + ls;
#pragma unroll
            for (int dt = 0; dt < NDT; ++dt) oacc[rt][dt] = oacc[rt][dt] * alpha;
#pragma unroll
            for (int s2 = 0; s2 < 2; ++s2) { u32x4 w; w.x = pk2(sacc[rt][2 * s2][0], sacc[rt][2 * s2][1]); w.y = pk2(sacc[rt][2 * s2][2], sacc[rt][2 * s2][3]);
                w.z = pk2(sacc[rt][2 * s2 + 1][0], sacc[rt][2 * s2 + 1][1]); w.w = pk2(sacc[rt][2 * s2 + 1][2], sacc[rt][2 * s2 + 1][3]); pf[rt][s2] = __builtin_bit_cast(bf16x8, w); }
        }
#pragma unroll
        for (int dt = 0; dt < NDT; ++dt)
#pragma unroll
            for (int s2 = 0; s2 < 2; ++s2) {
                const bf16x4 lo = *(const LAS bf16x4*)(Vs + (dt * 16 + fr) * VP + s2 * 32 + fq * 4);
                const bf16x4 hi = *(const LAS bf16x4*)(Vs + (dt * 16 + fr) * VP + s2 * 32 + 16 + fq * 4);
                const bf16x8 vf = __builtin_shufflevector(lo, hi, 0, 1, 2, 3, 4, 5, 6, 7);
#pragma unroll
                for (int rt = 0; rt < RT; ++rt) oacc[rt][dt] = MFMA16(vf, pf[rt][s2], oacc[rt][dt]);
                if (s2 == 1) __builtin_amdgcn_sched_barrier(0);
            }
    }
#pragma unroll
    for (int rt = 0; rt < RT; ++rt) {
        float l = l_run[rt]; l += shx(l, 16, lane); l += shx(l, 32, lane);
        const float inv = 1.f / l;
        bf16_t* orow = O + (size_t)(wrow0 + rt * 16 + fr) * ldo + fq * 4;
#pragma unroll
        for (int dt = 0; dt < NDT; ++dt) *(u32x2*)(orow + dt * 16) = pk4(oacc[rt][dt] * inv);
    }
}
#define GAS __attribute__((address_space(1)))
typedef GAS unsigned gu32;
typedef GAS unsigned long long gu64;
#define RLX_AGENT __ATOMIC_RELAXED, __HIP_MEMORY_SCOPE_AGENT
#define LDS_WAIT() asm volatile("s_waitcnt lgkmcnt(0)" ::: "memory")
#define VM_WAIT() asm volatile("s_waitcnt vmcnt(0)" ::: "memory")

#define XB_TMO      128
#define XB_XCNT(j)  (256  + 64 * (j))
#define XB_XSUB(j)  (1280 + 64 * (j))
#define XB_XGEN(j)  (2304 + 64 * (j))
#define XB_TOP      3328
#define XB_TOPGEN   3392
#define XCD_BAR_WORDS 3456
#define XB_SPIN_CAP (1u << 18)

__device__ __forceinline__ unsigned xb_ld(unsigned* p)              { return __hip_atomic_load(p, __ATOMIC_RELAXED, __HIP_MEMORY_SCOPE_AGENT); }
__device__ __forceinline__ unsigned xb_add(unsigned* p, unsigned v) { return __hip_atomic_fetch_add(p, v, __ATOMIC_RELAXED, __HIP_MEMORY_SCOPE_AGENT); }
__device__ __forceinline__ unsigned xb_xcc_id() { return (unsigned)__builtin_amdgcn_s_getreg((3 << 11) | 20) & 0xFu; }
#define XB_SPIN(cond, bar) do { unsigned _sp = 0; while (cond) { __builtin_amdgcn_s_sleep(1); \
    if ((++_sp & 255u) == 0u) { if (xb_ld(&(bar)[XB_TMO])) break; if (_sp > XB_SPIN_CAP) { atomicAdd(&(bar)[XB_TMO], 1u); break; } } } } while (0)

struct XcdBarrier {
    unsigned* bar; unsigned x;
    volatile LAS unsigned* st;
};

__device__ __forceinline__ XcdBarrier xcd_barrier_post(unsigned* bar, volatile LAS unsigned* st) {
    XcdBarrier b; b.bar = bar; b.x = xb_xcc_id(); b.st = st;
    if (threadIdx.x == 0) (void)xb_add(&bar[XB_XCNT(b.x)], 1u);
    return b;
}
__device__ __forceinline__ void xcd_barrier_complete(unsigned* bar, unsigned x, unsigned& nloc, unsigned& nx) {
    const unsigned G = gridDim.x * gridDim.y * gridDim.z;
    unsigned sum, cnt, mine, sp = 0u;
    for (;;) {
        sum = 0u; cnt = 0u; mine = 0u;
#pragma unroll
        for (unsigned j = 0; j < 16; ++j) { const unsigned c = xb_ld(&bar[XB_XCNT(j)]); sum += c; cnt += (c > 0u) ? 1u : 0u; mine = (j == x) ? c : mine; }
        if (sum == G) break;
        __builtin_amdgcn_s_sleep(1);
        if ((++sp & 255u) == 0u) { if (xb_ld(&bar[XB_TMO])) break; if (sp > XB_SPIN_CAP) { atomicAdd(&bar[XB_TMO], 1u); break; } }
    }
    nloc = mine > 0u ? mine : 1u; nx = cnt > 0u ? cnt : 1u;
}

__device__ __forceinline__ void xcd_barrier(const XcdBarrier& b) {
    asm volatile("s_waitcnt vmcnt(0)" ::: "memory");
    __syncthreads();
    if (threadIdx.x == 0) {
        unsigned* bar = b.bar;
        __builtin_amdgcn_s_waitcnt(0);
        unsigned nloc = b.st[0], nx = b.st[1];
        if (nloc == 0u) { xcd_barrier_complete(bar, b.x, nloc, nx); b.st[0] = nloc; b.st[1] = nx; }
        const unsigned old = xb_add(&bar[XB_XSUB(b.x)], 1u);
        const unsigned gen = old / nloc;
        if (old + 1u == (gen + 1u) * nloc) {
            __builtin_amdgcn_fence(__ATOMIC_RELEASE, "agent");
            asm volatile("s_waitcnt vmcnt(0)" ::: "memory");
            const unsigned og = xb_add(&bar[XB_TOP], 1u);
            const unsigned tg = og / nx;
            if (og + 1u == (tg + 1u) * nx) xb_add(&bar[XB_TOPGEN], 1u);
            else XB_SPIN(xb_ld(&bar[XB_TOPGEN]) == tg, bar);
            __builtin_amdgcn_fence(__ATOMIC_ACQUIRE, "agent");
            xb_add(&bar[XB_XGEN(b.x)], 1u);
            asm volatile("s_waitcnt vmcnt(0)" ::: "memory");
        } else {
            XB_SPIN(xb_ld(&bar[XB_XGEN(b.x)]) == gen, bar);
            __builtin_amdgcn_fence(__ATOMIC_ACQUIRE, "agent");
            asm volatile("s_waitcnt vmcnt(0)" ::: "memory");
        }
    }
    __syncthreads();
}

__device__ __forceinline__ bf16x8 ldsfrag(const LAS bf16_t* base, int pitch, int row, int k) { return *(const LAS bf16x8*)(base + row * pitch + k); }

__device__ __forceinline__ void gdn_conv_phase(const bf16_t* __restrict__ pre, bf16_t* __restrict__ post, const float* __restrict__ convw, const float* __restrict__ logit,
                                               const float* __restrict__ a_log, const float* __restrict__ dt_bias, float* __restrict__ beta, float* __restrict__ g, int gw, int NGW, int lane, int gtid, int NT) {
    for (int it = gw; it < 512 * 24; it += NGW) {
        const int rb = it / 24, grp = it - rb * 24, r0 = rb * 32, t0 = r0 & (SEQ - 1), col = grp * 128 + 2 * lane;
        f32x2 w[4];
#pragma unroll
        for (int j = 0; j < 4; ++j) w[j] = *(const f32x2*)(convw + j * 3072 + col);
        float p0[3], p1[3];
#pragma unroll
        for (int j = 0; j < 3; ++j) { unsigned x = 0u; if (t0 - 3 + j >= 0) x = *(const unsigned*)(pre + (size_t)(r0 - 3 + j) * 3072 + col); p0[j] = bf2f((unsigned short)(x & 0xffffu)); p1[j] = bf2f((unsigned short)(x >> 16)); }
        const float qsc = (grp < 8) ? 0.08838834764831845f : 1.f;
        for (int tb = 0; tb < 32; tb += 8) {
            unsigned xr[8];
#pragma unroll
            for (int u = 0; u < 8; ++u) xr[u] = *(const unsigned*)(pre + (size_t)(r0 + tb + u) * 3072 + col);
#pragma unroll
            for (int u = 0; u < 8; ++u) { const float x0 = bf2f((unsigned short)(xr[u] & 0xffffu)), x1 = bf2f((unsigned short)(xr[u] >> 16));
                const float a0 = (w[0][0] * p0[0] + w[1][0] * p0[1]) + (w[2][0] * p0[2] + w[3][0] * x0), a1 = (w[0][1] * p1[0] + w[1][1] * p1[1]) + (w[2][1] * p1[2] + w[3][1] * x1);
                p0[0] = p0[1]; p0[1] = p0[2]; p0[2] = x0; p1[0] = p1[1]; p1[1] = p1[2]; p1[2] = x1;
                float y0 = silu_f(a0), y1 = silu_f(a1);
                if (grp < 16) { const float ss = wave_sum(y0 * y0 + y1 * y1, lane); const float sc = rsqrtf(ss + EPS) * qsc; y0 *= sc; y1 *= sc; }
                *(unsigned*)(post + (size_t)(r0 + tb + u) * 3072 + col) = pk2(y0, y1); }
        }
    }
    for (int i = gtid; i < T * 8; i += NT) { const int r = i >> 3, h = i & 7; const float bl = logit[r * 16 + h], al = logit[r * 16 + 8 + h];
        beta[i] = 1.f / (1.f + expf(-bl)); const float xx = al + dt_bias[h]; const float sp = xx > 20.f ? xx : log1pf(expf(xx)); g[i] = -expf(a_log[h]) * sp; }
}

__device__ __forceinline__ void gdn_chunk_phase(LAS unsigned char* lds, const bf16_t* __restrict__ post, const float* __restrict__ beta, const float* __restrict__ g,
                                                bf16_t* __restrict__ Wc, bf16_t* __restrict__ UT, bf16_t* __restrict__ ATT, float* __restrict__ GC, const int wv) {
    constexpr int KP = 136, TP = 72;
    LAS bf16_t* kS = (LAS bf16_t*)lds; LAS bf16_t* qS = (LAS bf16_t*)(lds + 17408); LAS bf16_t* vbT = (LAS bf16_t*)(lds + 34816); LAS bf16_t* kbgT = (LAS bf16_t*)(lds + 53248);
    LAS float* Mm = (LAS float*)(lds + 71680); LAS bf16_t* Ti = (LAS bf16_t*)(lds + 88064); LAS float* gcS = (LAS float*)(lds + 97280); LAS float* btS = (LAS float*)(lds + 97536);
    const int tid = pg8::opq_tid(wv), lane = tid & 63, wid = tid >> 6, fr = lane & 15, fq = lane >> 4;
    for (int unit = blockIdx.x; unit < 2048; unit += gridDim.x) {
        const int b = unit >> 8, h = (unit >> 5) & 7, n = unit & 31, r0 = b * SEQ + n * 64;
        __syncthreads();
        if (wid == 0) { float gv = g[(size_t)(r0 + lane) * 8 + h];
#pragma unroll
            for (int o = 1; o < 64; o <<= 1) { const float up = __int_as_float(__builtin_amdgcn_ds_bpermute(((lane - o) & 63) << 2, __float_as_int(gv))); if (lane >= o) gv += up; }
            gcS[lane] = gv; btS[lane] = beta[(size_t)(r0 + lane) * 8 + h]; GC[(size_t)unit * 64 + lane] = gv; }
        __syncthreads();
#pragma unroll
        for (int i = 0; i < 2; ++i) { const int id = tid + 512 * i, pos = id & 63, c8 = id >> 6;
            const bf16_t* rowp = post + (size_t)(r0 + pos) * 3072 + h * 128 + c8 * 8;
            const u32x4 qv = *(const u32x4*)rowp, kv = *(const u32x4*)(rowp + 1024), vv = *(const u32x4*)(rowp + 2048);
            *(LAS u32x4*)(qS + pos * KP + c8 * 8) = qv; *(LAS u32x4*)(kS + pos * KP + c8 * 8) = kv;
            const float bt = btS[pos], sc = bt * __expf(gcS[pos]);
            const bf16x8 k8 = __builtin_bit_cast(bf16x8, kv), v8 = __builtin_bit_cast(bf16x8, vv);
#pragma unroll
            for (int e = 0; e < 8; ++e) { kbgT[(c8 * 8 + e) * TP + pos] = f2bf(bf2f((unsigned short)k8[e]) * sc); vbT[(c8 * 8 + e) * TP + pos] = f2bf(bf2f((unsigned short)v8[e]) * bt); } }
        __syncthreads();
#pragma unroll
        for (int tt = 0; tt < 2; ++tt) { const int t = wid + 8 * tt, it = t >> 2, jt = t & 3; const int i = it * 16 + fr, j0 = jt * 16 + fq * 4;
            bf16_t* ap = ATT + (size_t)unit * 4096 + i * 64 + j0;
            if (jt <= it) {
                f32x4 aK = {0.f, 0.f, 0.f, 0.f}, aQ = {0.f, 0.f, 0.f, 0.f};
#pragma unroll
                for (int ks = 0; ks < 4; ++ks) { const bf16x8 kj = ldsfrag(kS, KP, jt * 16 + fr, ks * 32 + fq * 8), ki = ldsfrag(kS, KP, it * 16 + fr, ks * 32 + fq * 8), qi = ldsfrag(qS, KP, it * 16 + fr, ks * 32 + fq * 8);
                    aK = MFMA16(kj, ki, aK); aQ = MFMA16(kj, qi, aQ); }
                const float gi = gcS[i], bi = btS[i]; f32x4 mm, at;
#pragma unroll
                for (int e = 0; e < 4; ++e) { const int j = j0 + e; const float dec = (i >= j) ? __expf(gi - gcS[j]) : 0.f; mm[e] = (i > j) ? bi * aK[e] * dec : 0.f; at[e] = aQ[e] * dec; }
                *(LAS f32x4*)(Mm + i * 64 + j0) = mm; *(u32x2*)ap = pk4(at);
            } else { *(u32x2*)ap = (u32x2){0u, 0u}; }
        }
        __syncthreads();
        if (wid == 0) {
            float x[64]; int ln = lane; asm volatile("" : "+v"(ln)); int zv = 0; asm volatile("" : "+v"(zv)); const LAS float* Mv = Mm + zv;
#pragma unroll
            for (int i = 0; i < 64; ++i) {
                int dl = i - ln; dl = dl < 0 ? -dl : dl; dl = 1 - dl; dl = dl < 0 ? 0 : dl; float s0 = (float)dl, s1 = 0.f, s2 = 0.f, s3 = 0.f;
#pragma unroll
                for (int j4 = 0; j4 < (i + 3) / 4; ++j4) { const f32x4 m = *(const LAS f32x4*)(Mv + i * 64 + j4 * 4);
                    if (j4 * 4 + 0 < i) s0 -= m[0] * x[j4 * 4 + 0]; if (j4 * 4 + 1 < i) s1 -= m[1] * x[j4 * 4 + 1];
                    if (j4 * 4 + 2 < i) s2 -= m[2] * x[j4 * 4 + 2]; if (j4 * 4 + 3 < i) s3 -= m[3] * x[j4 * 4 + 3]; }
                x[i] = (s0 + s1) + (s2 + s3);
                Ti[i * TP + lane] = f2bf(x[i]);
            }
        }
        __syncthreads();
#pragma unroll
        for (int q = 0; q < 4; ++q) { const int t = wid * 4 + q, pt = t >> 3, dt = t & 7;
            f32x4 aU = {0.f, 0.f, 0.f, 0.f}, aW = {0.f, 0.f, 0.f, 0.f};
#pragma unroll
            for (int ks = 0; ks < 2; ++ks) { const bf16x8 tf = ldsfrag(Ti, TP, pt * 16 + fr, ks * 32 + fq * 8);
                aU = MFMA16(tf, ldsfrag(vbT, TP, dt * 16 + fr, ks * 32 + fq * 8), aU);
                aW = MFMA16(ldsfrag(kbgT, TP, dt * 16 + fr, ks * 32 + fq * 8), tf, aW); }
            *(u32x2*)(UT + (size_t)unit * 8192 + (dt * 16 + fr) * 64 + pt * 16 + fq * 4) = pk4(aU);
            *(u32x2*)(Wc + (size_t)unit * 8192 + (pt * 16 + fr) * 128 + dt * 16 + fq * 4) = pk4(aW);
        }
    }
}

__device__ __forceinline__ void gdn_seq_phase(LAS unsigned char* lds, const bf16_t* __restrict__ post, const bf16_t* __restrict__ Wc, const bf16_t* __restrict__ UT, const bf16_t* __restrict__ ATT,
                                              const float* __restrict__ GC, const bf16_t* __restrict__ gate, const float* __restrict__ o_norm, bf16_t* __restrict__ out, const int wv) {
    constexpr int KP = 136, TP = 72;
    LAS bf16_t* wS = (LAS bf16_t*)lds; LAS bf16_t* qgS = (LAS bf16_t*)(lds + 17408); LAS bf16_t* kdT = (LAS bf16_t*)(lds + 34816); LAS bf16_t* atS = (LAS bf16_t*)(lds + 53248);
    LAS bf16_t* StT = (LAS bf16_t*)(lds + 62464); LAS bf16_t* vnT = (LAS bf16_t*)(lds + 97280); LAS float* part = (LAS float*)(lds + 115712);
    const int tid = pg8::opq_tid(wv), lane = tid & 63, wid = tid >> 6, fr = lane & 15, fq = lane >> 4;
    const int dvr = 16 * wid + fr;
    for (int item = blockIdx.x; item < 64; item += gridDim.x) {
        const int b = item >> 3, h = item & 7;
        f32x4 sacc[8];
#pragma unroll
        for (int mt = 0; mt < 8; ++mt) { sacc[mt] = (f32x4){0.f, 0.f, 0.f, 0.f}; *(LAS u32x2*)(StT + dvr * KP + mt * 16 + fq * 4) = (u32x2){0u, 0u}; }
        const float gn = o_norm[dvr];
        for (int n = 0; n < 32; ++n) {
            const int unit = item * 32 + n, r0 = b * SEQ + n * 64;
            const float glast = GC[(size_t)unit * 64 + 63];
            __syncthreads();
#pragma unroll
            for (int i = 0; i < 2; ++i) { const int id = tid + 512 * i;
                { const int pos = id >> 4, c8 = id & 15;
                  *(LAS u32x4*)(wS + pos * KP + c8 * 8) = *(const u32x4*)(Wc + (size_t)unit * 8192 + pos * 128 + c8 * 8);
                  const bf16x8 q8 = *(const bf16x8*)(post + (size_t)(r0 + pos) * 3072 + h * 128 + c8 * 8); const float eg = __expf(GC[(size_t)unit * 64 + pos]);
                  u32x4 w; w.x = pk2(bf2f((unsigned short)q8[0]) * eg, bf2f((unsigned short)q8[1]) * eg); w.y = pk2(bf2f((unsigned short)q8[2]) * eg, bf2f((unsigned short)q8[3]) * eg);
                  w.z = pk2(bf2f((unsigned short)q8[4]) * eg, bf2f((unsigned short)q8[5]) * eg); w.w = pk2(bf2f((unsigned short)q8[6]) * eg, bf2f((unsigned short)q8[7]) * eg);
                  *(LAS u32x4*)(qgS + pos * KP + c8 * 8) = w; }
                { const int pos = id & 63, c8 = id >> 6;
                  const bf16x8 k8 = *(const bf16x8*)(post + (size_t)(r0 + pos) * 3072 + 1024 + h * 128 + c8 * 8); const float sc = __expf(glast - GC[(size_t)unit * 64 + pos]);
#pragma unroll
                  for (int e = 0; e < 8; ++e) kdT[(c8 * 8 + e) * TP + pos] = f2bf(bf2f((unsigned short)k8[e]) * sc); } }
            { const int i = tid >> 3, c8 = tid & 7; *(LAS u32x4*)(atS + i * TP + c8 * 8) = *(const u32x4*)(ATT + (size_t)unit * 4096 + i * 64 + c8 * 8); }
            __syncthreads();
            f32x4 o[4];
#pragma unroll
            for (int rt = 0; rt < 4; ++rt) { f32x4 acc = {0.f, 0.f, 0.f, 0.f};
#pragma unroll
                for (int ks = 0; ks < 4; ++ks) acc = MFMA16(ldsfrag(wS, KP, rt * 16 + fr, ks * 32 + fq * 8), ldsfrag(StT, KP, dvr, ks * 32 + fq * 8), acc);
                const bf16x4 u4 = *(const bf16x4*)(UT + (size_t)unit * 8192 + dvr * 64 + rt * 16 + fq * 4);
                f32x4 vn; for (int e = 0; e < 4; ++e) vn[e] = bf2f((unsigned short)u4[e]) - acc[e];
                *(LAS u32x2*)(vnT + dvr * TP + rt * 16 + fq * 4) = pk4(vn); }
#pragma unroll
            for (int rt = 0; rt < 4; ++rt) { f32x4 acc = {0.f, 0.f, 0.f, 0.f};
#pragma unroll
                for (int ks = 0; ks < 4; ++ks) acc = MFMA16(ldsfrag(qgS, KP, rt * 16 + fr, ks * 32 + fq * 8), ldsfrag(StT, KP, dvr, ks * 32 + fq * 8), acc);
#pragma unroll
                for (int ks = 0; ks < 2; ++ks) acc = MFMA16(ldsfrag(atS, TP, rt * 16 + fr, ks * 32 + fq * 8), ldsfrag(vnT, TP, dvr, ks * 32 + fq * 8), acc);
                o[rt] = acc; }
            const float egl = __expf(glast);
#pragma unroll
            for (int mt = 0; mt < 8; ++mt) { f32x4 acc = sacc[mt] * egl;
#pragma unroll
                for (int ks = 0; ks < 2; ++ks) acc = MFMA16(ldsfrag(kdT, TP, mt * 16 + fr, ks * 32 + fq * 8), ldsfrag(vnT, TP, dvr, ks * 32 + fq * 8), acc);
                sacc[mt] = acc; *(LAS u32x2*)(StT + dvr * KP + mt * 16 + fq * 4) = pk4(acc); }
#pragma unroll
            for (int rt = 0; rt < 4; ++rt) { f32x4 ss = o[rt] * o[rt];
#pragma unroll
                for (int sh = 1; sh < 16; sh <<= 1) { ss[0] += shx(ss[0], sh, lane); ss[1] += shx(ss[1], sh, lane); ss[2] += shx(ss[2], sh, lane); ss[3] += shx(ss[3], sh, lane); }
                if (fr == 0) *(LAS f32x4*)(part + wid * 64 + rt * 16 + fq * 4) = ss; }
            __syncthreads();
#pragma unroll
            for (int rt = 0; rt < 4; ++rt) { f32x4 tot = {0.f, 0.f, 0.f, 0.f};
#pragma unroll
                for (int w = 0; w < 8; ++w) tot += *(const LAS f32x4*)(part + w * 64 + rt * 16 + fq * 4);
#pragma unroll
                for (int e = 0; e < 4; ++e) { const int pos = rt * 16 + fq * 4 + e; const size_t oi = (size_t)(r0 + pos) * 1024 + h * 128 + dvr;
                    const float rstd = rsqrtf(tot[e] * (1.f / 128.f) + EPS); const float gt = bf2f(gate[oi]);
                    out[oi] = f2bf(o[rt][e] * rstd * gn * silu_f(gt)); } }
        }
    }
}

__device__ __forceinline__ void mla_mid_phase(const float* __restrict__ z, const float* __restrict__ qn, const float* __restrict__ kvn, const float* __restrict__ cosb, const float* __restrict__ sinb,
                                              bf16_t* __restrict__ cqn, bf16_t* __restrict__ ckvn, bf16_t* __restrict__ krope, int gw, int NGW, int lane) {
    for (int r = gw; r < T; r += NGW) {
        const float* zr = z + (size_t)r * 704;
        f32x2 a[3]; float s = 0.f;
#pragma unroll
        for (int i = 0; i < 3; ++i) { a[i] = *(const f32x2*)(zr + 2 * lane + 128 * i); s += a[i][0] * a[i][0] + a[i][1] * a[i][1]; }
        float rstd = rsqrtf(wave_sum(s, lane) * (1.f / 384.f) + EPS);
#pragma unroll
        for (int i = 0; i < 3; ++i) { const f32x2 gg = *(const f32x2*)(qn + 2 * lane + 128 * i); *(unsigned*)(cqn + (size_t)r * 384 + 2 * lane + 128 * i) = pk2(a[i][0] * rstd * gg[0], a[i][1] * rstd * gg[1]); }
        f32x2 c[2]; s = 0.f;
#pragma unroll
        for (int i = 0; i < 2; ++i) { c[i] = *(const f32x2*)(zr + 384 + 2 * lane + 128 * i); s += c[i][0] * c[i][0] + c[i][1] * c[i][1]; }
        rstd = rsqrtf(wave_sum(s, lane) * (1.f / 256.f) + EPS);
#pragma unroll
        for (int i = 0; i < 2; ++i) { const f32x2 gg = *(const f32x2*)(kvn + 2 * lane + 128 * i); *(unsigned*)(ckvn + (size_t)r * 256 + 2 * lane + 128 * i) = pk2(c[i][0] * rstd * gg[0], c[i][1] * rstd * gg[1]); }
        const float v = zr[640 + lane], pv = shx(v, 32, lane); const int i = lane & 31; const float cs = cosb[(size_t)r * 32 + i], sn = sinb[(size_t)r * 32 + i];
        const float outv = (lane < 32) ? (v * cs - pv * sn) : (v * cs + pv * sn);
        krope[(size_t)r * 64 + lane] = f2bf(outv);
    }
}
__device__ __forceinline__ void sc_mid_phase(const bf16_t* __restrict__ z, const float* __restrict__ cw, bf16_t* __restrict__ y, int gtid, int NT) {
    for (int it = gtid; it < T * 128; it += NT) {
        const int r = it >> 7, c8 = it & 127, t = r & (SEQ - 1), col = c8 * 8;
        float acc[8];
#pragma unroll
        for (int e = 0; e < 8; ++e) acc[e] = 0.f;
#pragma unroll
        for (int j = 0; j < 3; ++j) { if (t - 2 + j >= 0) { const bf16_t* zr = z + (size_t)(r - 2 + j) * 3072 + col;
            const bf16x8 cg8 = *(const bf16x8*)(zr + 1024), u8 = *(const bf16x8*)(zr + 2048); const f32x4 w0 = *(const f32x4*)(cw + j * 1024 + col), w1 = *(const f32x4*)(cw + j * 1024 + col + 4);
#pragma unroll
            for (int e = 0; e < 8; ++e) acc[e] += (e < 4 ? w0[e] : w1[e - 4]) * (bf2f((unsigned short)cg8[e]) * bf2f((unsigned short)u8[e])); } }
        const bf16x8 b8 = *(const bf16x8*)(z + (size_t)r * 3072 + col);
        u32x4 o; o.x = pk2(acc[0] * bf2f((unsigned short)b8[0]), acc[1] * bf2f((unsigned short)b8[1])); o.y = pk2(acc[2] * bf2f((unsigned short)b8[2]), acc[3] * bf2f((unsigned short)b8[3]));
        o.z = pk2(acc[4] * bf2f((unsigned short)b8[4]), acc[5] * bf2f((unsigned short)b8[5])); o.w = pk2(acc[6] * bf2f((unsigned short)b8[6]), acc[7] * bf2f((unsigned short)b8[7]));
        *(u32x4*)(y + (size_t)r * 1024 + col) = o;
    }
}
struct Params { const float* in[28]; float* out; unsigned char* ws; int L, pad; };
enum { PH_PREP = 0, PH_IN_MLA, PH_IN_GDN, PH_IN_SC, PH_MLA_MID, PH_MLA_UP, PH_MLA_ATTN, PH_GDN_CONV, PH_GDN_CHUNK, PH_GDN_SEQ, PH_SC_MID, PH_OPROJ,
       PH_XNORM, PH_XQ, PH_XATTN, PH_XO, PH_MNORM, PH_MUP, PH_MDOWN, PH_FINAL, PH_COUNT };

template <int PH> __device__ __forceinline__ void run_phase(const Params& p, const int L, LAS unsigned char* lds, const int wv) {
    const int tid = pg8::opq_tid(wv), lane = tid & 63, wid = tid >> 6;
    int G_ = gridDim.x; asm volatile("" : "+s"(G_));
    const int G = G_, gw = blockIdx.x * 8 + wid, NGW = G * 8, gtid = blockIdx.x * 512 + tid, NT = G * 512;
    unsigned char* ws = p.ws;
    float* X = p.out;
    bf16_t* H = (bf16_t*)(ws + WS_H); bf16_t* MEMN = (bf16_t*)(ws + WS_MEMN); bf16_t* MK = (bf16_t*)(ws + WS_MK); bf16_t* MVT = (bf16_t*)(ws + WS_MVT);
    float* COS = (float*)(ws + WS_COS); float* SIN = (float*)(ws + WS_SIN);
    bf16_t* XB = (bf16_t*)(ws + WS_AR + 128 * MiB); float* SSP = (float*)(ws + WS_AR + 160 * MiB);
    bf16_t* Wmixin = (bf16_t*)(ws + W_MIXIN); bf16_t* Wuq = (bf16_t*)(ws + W_UQ); bf16_t* Wukv = (bf16_t*)(ws + W_UKV); bf16_t* Wmixo = (bf16_t*)(ws + W_MIXO);
    bf16_t* Wxq = (bf16_t*)(ws + W_XQ); bf16_t* Wxkv = (bf16_t*)(ws + W_XKV); bf16_t* Wxo = (bf16_t*)(ws + W_XO); bf16_t* W1 = (bf16_t*)(ws + W_1); bf16_t* W2 = (bf16_t*)(ws + W_2);
    const int kind = L % 3, j = L / 3;
    if constexpr (PH == PH_PREP) {
        const float* xin = p.in[0]; const float* mem = p.in[1]; const int* positions = (const int*)p.in[2];
        LAS float* scr = (LAS float*)(lds + wid * 16384);
        if (kind == 0) {
            conv_w(p.in[3] + (size_t)j * 1024 * 704, 1024, 704, 768, Wmixin, scr, gw, NGW, lane, p.in[18] + L * D);
            conv_w(p.in[6] + (size_t)j * 384 * 1536, 384, 1536, 1536, Wuq, scr, gw, NGW, lane);
            conv_w(p.in[7] + (size_t)j * 256 * 2048, 256, 2048, 2048, Wukv, scr, gw, NGW, lane);
            conv_w(p.in[8] + (size_t)j * 1024 * 1024, 1024, 1024, 1024, Wmixo, scr, gw, NGW, lane);
        } else if (kind == 1) {
            conv_w(p.in[9], 1024, 4112, 4352, Wmixin, scr, gw, NGW, lane, p.in[18] + L * D);
            conv_w(p.in[14], 1024, 1024, 1024, Wmixo, scr, gw, NGW, lane);
        } else {
            conv_w(p.in[15], 1024, 3072, 3072, Wmixin, scr, gw, NGW, lane, p.in[18] + L * D);
            conv_w(p.in[17], 1024, 1024, 1024, Wmixo, scr, gw, NGW, lane);
        }
        conv_w(p.in[21] + (size_t)L * 1024 * 1024, 1024, 1024, 1024, Wxq, scr, gw, NGW, lane, p.in[19] + L * D);
        conv_w(p.in[22] + (size_t)L * 1024 * 2048, 1024, 2048, 2048, Wxkv, scr, gw, NGW, lane);
        conv_w(p.in[23] + (size_t)L * 1024 * 1024, 1024, 1024, 1024, Wxo, scr, gw, NGW, lane);
        conv_w(p.in[24] + (size_t)L * 1024 * 4096, 1024, 4096, 4096, W1, scr, gw, NGW, lane, p.in[20] + L * D);
        conv_w(p.in[25] + (size_t)L * 4096 * 1024, 4096, 1024, 1024, W2, scr, gw, NGW, lane);
        if (L == 0) {
            for (int r = gw; r < T; r += NGW) init_row(xin + (size_t)r * D, X + (size_t)r * D, XB + (size_t)r * D, SSP + (size_t)r * 16, lane);
            for (int r = gw; r < 2048; r += NGW) rms_row(mem + (size_t)r * D, p.in[26], MEMN + (size_t)r * D, nullptr, lane);
            for (int i = gtid; i < T * 32; i += NT) { const int r = i >> 5, k = i & 31; const float inv = exp2f(-(float)k * (13.287712379549449f / 32.f));
                const float ang = (float)positions[r] * inv; double rev = (double)ang * 0.15915494309189535; rev -= rint(rev); const float rr = (float)(rev * 6.283185307179586);
                COS[i] = cosf(rr); SIN[i] = sinf(rr); }
        }
    } else if constexpr (PH == PH_IN_MLA) {
        run_gemm(lds, XB, Wmixin, T, 768, 1024, FMlaIn{(float*)(ws + A_Z), SSP}, wv);
        run_gemm(lds, MEMN, Wxkv, 2048, 2048, 1024, FMemKV{MK, MVT}, wv, 64);
    } else if constexpr (PH == PH_IN_GDN) {
        run_gemm(lds, XB, Wmixin, T, 4352, 1024, FGdnIn{(bf16_t*)(ws + G_PRE), (bf16_t*)(ws + G_GATE), (float*)(ws + G_LOGIT), SSP}, wv);
        run_gemm(lds, MEMN, Wxkv, 2048, 2048, 1024, FMemKV{MK, MVT}, wv, 192);
    } else if constexpr (PH == PH_IN_SC) {
        run_gemm(lds, XB, Wmixin, T, 3072, 1024, FBf16S{(bf16_t*)(ws + WS_AR), 3072, SSP}, wv);
        run_gemm(lds, MEMN, Wxkv, 2048, 2048, 1024, FMemKV{MK, MVT}, wv, 0);
    } else if constexpr (PH == PH_MLA_MID) {
        mla_mid_phase((const float*)(ws + A_Z), p.in[4] + j * 384, p.in[5] + j * 256, COS, SIN, (bf16_t*)(ws + A_CQN), (bf16_t*)(ws + A_CKVN), (bf16_t*)(ws + A_KROPE), gw, NGW, lane);
    } else if constexpr (PH == PH_MLA_UP) {
#ifndef UPSEL
#define UPSEL 3
#endif
        if (UPSEL & 1) run_gemm(lds, (const bf16_t*)(ws + A_CQN), Wuq, T, 1536, 384, FBf16{(bf16_t*)(ws + A_Q), 1536}, wv);
        if (UPSEL & 2) run_gemm(lds, (const bf16_t*)(ws + A_CKVN), Wukv, T, 2048, 256, FUkv{(bf16_t*)(ws + A_KNOPE), (bf16_t*)(ws + A_VT)}, wv);
    } else if constexpr (PH == PH_MLA_ATTN) {
        const bf16_t* Qb = (const bf16_t*)(ws + A_Q); const bf16_t* Kn = (const bf16_t*)(ws + A_KNOPE); const bf16_t* Kr = (const bf16_t*)(ws + A_KROPE); const bf16_t* Vt = (const bf16_t*)(ws + A_VT);
        for (int item = blockIdx.x; item < 256; item += G) {
            const int bh = item >> 2, s = item & 3, b = bh >> 3, h = bh & 7;
            for (int pass = 0; pass < 2; ++pass) { const int qb = pass ? 7 - s : s; const size_t row0 = (size_t)b * SEQ + qb * 256;
                attn_unit<128, 64, 128, 2, true, true>(lds, Qb + row0 * 1536 + h * 192, 1536, Kn + (size_t)b * SEQ * 1024 + h * 128, 1024, Kr + (size_t)b * SEQ * 64, 64,
                    Vt + (size_t)(b * 8 + h) * 128 * 2048, 64, (qb + 1) * 4, qb * 256, H + row0 * 1024 + h * 128, 1024, 0.07216878364870322f * 1.4426950408889634f, COS + row0 * 32, SIN + row0 * 32, wv); }
        }
    } else if constexpr (PH == PH_GDN_CONV) {
        gdn_conv_phase((const bf16_t*)(ws + G_PRE), (bf16_t*)(ws + G_POST), p.in[10], (const float*)(ws + G_LOGIT), p.in[11], p.in[12], (float*)(ws + G_BETA), (float*)(ws + G_G), gw, NGW, lane, gtid, NT);
    } else if constexpr (PH == PH_GDN_CHUNK) {
        gdn_chunk_phase(lds, (const bf16_t*)(ws + G_POST), (const float*)(ws + G_BETA), (const float*)(ws + G_G), (bf16_t*)(ws + G_W), (bf16_t*)(ws + G_UT), (bf16_t*)(ws + G_ATT), (float*)(ws + G_GC), wv);
    } else if constexpr (PH == PH_GDN_SEQ) {
        gdn_seq_phase(lds, (const bf16_t*)(ws + G_POST), (const bf16_t*)(ws + G_W), (const bf16_t*)(ws + G_UT), (const bf16_t*)(ws + G_ATT), (const float*)(ws + G_GC), (const bf16_t*)(ws + G_GATE), p.in[13], H, wv);
    } else if constexpr (PH == PH_SC_MID) {
        sc_mid_phase((const bf16_t*)(ws + WS_AR), p.in[16], H, gtid, NT);
    } else if constexpr (PH == PH_OPROJ) {
        run_gemm(lds, H, Wmixo, T, 1024, 1024, FResid{X, XB, SSP}, wv);
    } else if constexpr (PH == PH_XNORM) {
        for (int r = gw; r < T; r += NGW) rms_row(X + (size_t)r * D, p.in[19] + L * D, H + (size_t)r * D, nullptr, lane);
    } else if constexpr (PH == PH_XQ) {
        run_gemm(lds, XB, Wxq, T, 1024, 1024, FBf16S{(bf16_t*)(ws + WS_AR), 1024, SSP}, wv);
    } else if constexpr (PH == PH_XATTN) {
        const bf16_t* Qb = (const bf16_t*)(ws + WS_AR);
        for (int item = blockIdx.x; item < 512; item += G) { const int b = item >> 6, h = (item >> 4) & 3, qb = item & 15; const size_t row0 = (size_t)b * SEQ + qb * 128;
            attn_unit<256, 0, 256, 1, false, false>(lds, Qb + row0 * 1024 + h * 256, 1024, MK + (size_t)b * 256 * 1024 + h * 256, 1024, MK, 0,
                MVT + (size_t)(b * 4 + h) * 256 * 256, 64, 4, 0, H + row0 * 1024 + h * 256, 1024, 0.0625f * 1.4426950408889634f, COS, SIN, wv); }
    } else if constexpr (PH == PH_XO) {
        run_gemm(lds, H, Wxo, T, 1024, 1024, FResid{X, XB, SSP}, wv);
    } else if constexpr (PH == PH_MNORM) {
        for (int r = gw; r < T; r += NGW) rms_row(X + (size_t)r * D, p.in[20] + L * D, H + (size_t)r * D, nullptr, lane);
    } else if constexpr (PH == PH_MUP) {
        run_gemm(lds, XB, W1, T, 4096, 1024, FRelu2{(bf16_t*)(ws + WS_AR), 4096, SSP}, wv);
    } else if constexpr (PH == PH_MDOWN) {
        run_gemm(lds, (const bf16_t*)(ws + WS_AR), W2, T, 1024, 4096, FResid{X, XB, SSP}, wv);
    } else if constexpr (PH == PH_FINAL) {
        for (int r = gw; r < T; r += NGW) rms_row_f32(X + (size_t)r * D, p.in[27], lane);
    }
}

#ifndef N_LAUNCH_SPLIT
#define N_LAUNCH_SPLIT 1
#endif
#if N_LAUNCH_SPLIT
template <int PH> __global__ void __launch_bounds__(512) k_phase(Params p) {
    extern __shared__ __attribute__((aligned(16))) unsigned char lds_raw[];
    run_phase<PH>(p, p.L, (LAS unsigned char*)lds_raw, __builtin_amdgcn_readfirstlane((int)threadIdx.x >> 6));
}
template <int PH> static void launch_phase(Params p, int L, int grid, hipStream_t stream) {
    static bool attr = false;
    if (!attr) { (void)hipFuncSetAttribute((const void*)k_phase<PH>, hipFuncAttributeMaxDynamicSharedMemorySize, LDS_BYTES); attr = true; }
    p.L = L;
    hipLaunchKernelGGL(k_phase<PH>, dim3(grid), dim3(512), LDS_BYTES, stream, p);
}
#else
#ifndef PH_MASK
#define PH_MASK 0xFFFFFF
#endif
#define RUN(PH) do { if constexpr ((PH_MASK >> PH) & 1) run_phase<PH>(p, L, lds, wv); if (L == 0 && PH == PH_PREP) grid.sync(); else xcd_barrier(bar); } while (0)
template <int L> __device__ __forceinline__ void run_layer(const Params& p, LAS unsigned char* lds, cg::grid_group& grid, const XcdBarrier& bar, const int wv) {
    constexpr int kind = L % 3;
    RUN(PH_PREP);
    if constexpr (kind == 0) { RUN(PH_IN_MLA); RUN(PH_MLA_MID); RUN(PH_MLA_UP); RUN(PH_MLA_ATTN); }
    else if constexpr (kind == 1) { RUN(PH_IN_GDN); RUN(PH_GDN_CONV); RUN(PH_GDN_CHUNK); RUN(PH_GDN_SEQ); }
    else { RUN(PH_IN_SC); RUN(PH_SC_MID); }
    RUN(PH_OPROJ); RUN(PH_XQ); RUN(PH_XATTN); RUN(PH_XO); RUN(PH_MUP); RUN(PH_MDOWN);
}
#undef RUN
__global__ void __launch_bounds__(512) mega(Params p) {
    extern __shared__ __attribute__((aligned(16))) unsigned char lds_raw[];
    LAS unsigned char* lds = (LAS unsigned char*)lds_raw;
    cg::grid_group grid = cg::this_grid();
    const int wv = __builtin_amdgcn_readfirstlane((int)threadIdx.x >> 6);
    if (threadIdx.x < 2) ((volatile LAS unsigned*)(lds + 131072 + 1024))[threadIdx.x] = 0u;
    __syncthreads();
    const XcdBarrier bar = xcd_barrier_post((unsigned*)p.ws, (volatile LAS unsigned*)(lds + 131072 + 1024));
    run_layer<0>(p, lds, grid, bar, wv); run_layer<1>(p, lds, grid, bar, wv); run_layer<2>(p, lds, grid, bar, wv); run_layer<3>(p, lds, grid, bar, wv);
    run_phase<PH_FINAL>(p, 3, lds, wv);
}
#endif

extern "C" void kernel_launch(void* const* d_in, const int* in_sizes, int n_in, void* d_out, int out_size, void* d_ws, size_t ws_size, hipStream_t stream) {
    static int grid_blocks = 0;
    if (!grid_blocks) {
        if (n_in != 28 || ws_size < WS_END) { fprintf(stderr, "kernel_launch: unexpected n_in %d / ws_size %zu (need %zu)\n", n_in, ws_size, (size_t)WS_END); grid_blocks = -1; return; }
        int dev = 0, cus = 0;
        (void)hipGetDevice(&dev);
        (void)hipDeviceGetAttribute(&cus, hipDeviceAttributeMultiprocessorCount, dev);
        if (cus < 1) cus = 256;
#if N_LAUNCH_SPLIT
        grid_blocks = cus;
#else
        int per_cu = 0;
        (void)hipFuncSetAttribute((const void*)mega, hipFuncAttributeMaxDynamicSharedMemorySize, LDS_BYTES);
        (void)hipOccupancyMaxActiveBlocksPerMultiprocessor(&per_cu, (const void*)mega, 512, LDS_BYTES);
        if (per_cu < 1) per_cu = 1;
        grid_blocks = cus * per_cu;
#endif
        (void)hipGetLastError();
    }
    if (grid_blocks < 0) return;
    Params p{};
    for (int i = 0; i < 28; ++i) p.in[i] = (const float*)d_in[i];
    p.out = (float*)d_out; p.ws = (unsigned char*)d_ws;
#if N_LAUNCH_SPLIT
    const int g = grid_blocks;
    for (int L = 0; L < 4; ++L) {
        const int kind = L % 3;
        launch_phase<PH_PREP>(p, L, g, stream);
        if (kind == 0) { launch_phase<PH_IN_MLA>(p, L, g, stream); launch_phase<PH_MLA_MID>(p, L, g, stream); launch_phase<PH_MLA_UP>(p, L, g, stream); launch_phase<PH_MLA_ATTN>(p, L, g, stream); }
        else if (kind == 1) { launch_phase<PH_IN_GDN>(p, L, g, stream); launch_phase<PH_GDN_CONV>(p, L, g, stream); launch_phase<PH_GDN_CHUNK>(p, L, g, stream); launch_phase<PH_GDN_SEQ>(p, L, g, stream); }
        else { launch_phase<PH_IN_SC>(p, L, g, stream); launch_phase<PH_SC_MID>(p, L, g, stream); }
        launch_phase<PH_OPROJ>(p, L, g, stream); launch_phase<PH_XQ>(p, L, g, stream); launch_phase<PH_XATTN>(p, L, g, stream);
        launch_phase<PH_XO>(p, L, g, stream); launch_phase<PH_MUP>(p, L, g, stream); launch_phase<PH_MDOWN>(p, L, g, stream);
    }
    launch_phase<PH_FINAL>(p, 3, g, stream);
#else
    (void)hipMemsetAsync(d_ws, 0, 16384, stream);
    void* args[] = {&p};
    hipError_t e = hipLaunchCooperativeKernel((const void*)mega, dim3(grid_blocks), dim3(512), args, LDS_BYTES, stream);
    if (e != hipSuccess) fprintf(stderr, "cooperative launch failed: %s (grid %d)\n", hipGetErrorString(e), grid_blocks);
#endif
}
```

```cpp
#include <hip/hip_runtime.h>
#include <hip/hip_cooperative_groups.h>
#include <cstdio>
#include <cstdint>
namespace cg = cooperative_groups;
namespace pg8 {
#define PG8_LAS __attribute__((address_space(3)))
typedef unsigned short bf16_t;
typedef short bf16x8 __attribute__((ext_vector_type(8)));
typedef float f32x4 __attribute__((ext_vector_type(4)));
typedef unsigned u32x4 __attribute__((ext_vector_type(4)));
constexpr int BM = 256, BK = 64, HALF = 128, HTB = HALF * BK * 2  , STAGE_BYTES = 8 * HTB, NXCD = 8, WGM = 8;

__host__ __device__ __forceinline__ int lds_byte(int r, int c) { const int st = (r >> 4) * 2 + (c >> 5), rr = r & 15, cc = c & 31, ob = rr * 64 + cc * 2; return st * 1024 + (ob ^ (((ob >> 9) & 1) << 5)); }
__host__ __device__ __forceinline__ void stage_rc(int b, int& R, int& C) { const int st = b / 1024, sb = b % 1024, swz = sb ^ (((sb >> 9) & 1) << 5); R = (st >> 1) * 16 + swz / 64; C = (st & 1) * 32 + (swz % 64) / 2; }
__host__ __device__ __forceinline__ int perm32(int rho) { const int n = rho >> 4, i = rho & 15; return 8 * (i >> 2) + 4 * n + (i & 3); }

struct Unit { int pm, pn; };
struct Gemm { const bf16_t* A; const bf16_t* Bt; int M, N, K; };

struct StaticOrder {
    int nM, nN, nwg, G, c;
    __host__ __device__ void init(int M, int N, int G_, int c_) { nM = M / BM; nN = N / BM; nwg = nM * nN; G = G_; c = c_; }
    __host__ __device__ bool next(int i, Unit& u) const {
        const long L = (long)i * G + c; if (L >= nwg) return false;
        int wgid = (int)L; { const int q = nwg / NXCD, r = nwg % NXCD, xcd = wgid % NXCD, off = wgid / NXCD; wgid = (xcd < r ? xcd * (q + 1) : r * (q + 1) + (xcd - r) * q) + off; }
        const int nig = WGM * nN, gid = wgid / nig, fm = gid * WGM, gsz = (nM - fm) < WGM ? (nM - fm) : WGM;
        u.pm = fm + ((wgid % nig) % gsz); u.pn = (wgid % nig) / gsz; return true;
    }
    __device__ __forceinline__ void a_ready(const Unit&) const {}
    __device__ __forceinline__ void done(const Unit&) const {}
};

__device__ __forceinline__ unsigned cvt_pk_bf16(float lo, float hi) { unsigned r; asm volatile("v_cvt_pk_bf16_f32 %0, %1, %2" : "=v"(r) : "v"(lo), "v"(hi)); return r; }
__device__ __forceinline__ int opq_tid(int wv) { int l; asm volatile("v_mbcnt_lo_u32_b32 %0, -1, 0\n\tv_mbcnt_hi_u32_b32 %0, -1, %0" : "=v"(l)); return wv * 64 + l; }
template <class Epi, class Sched, bool ALIGN_EPI = false, bool SP2 = false>
__device__ __forceinline__ void gemm_phase(PG8_LAS unsigned char* lds, const Gemm g, const Sched& S, const Epi& E, const int wv) {
    const int tid = opq_tid(wv), wid = __builtin_amdgcn_readfirstlane(tid >> 6), lane = tid & 63, wr = wid >> 2, wc = wid & 3, fr = lane & 15, fq = lane >> 4;
    const int K = g.K, nt = K / BK;
    unsigned voffA[2], voffB[2];
#pragma unroll
    for (int i = 0; i < 2; ++i) { int R, C; stage_rc(tid * 16 + i * 8192, R, C); const int Rb = Epi::PERM ? ((R & ~31) + perm32(R & 31)) : R;
        voffA[i] = (unsigned)(R * K + C) * 2u; voffB[i] = (unsigned)(Rb * K + C) * 2u; }
    const size_t kstep = (size_t)(BK * 2);
    const size_t hstep = (size_t)HALF * K * 2;
    const size_t tstep = 2 * hstep;
    const unsigned ldsw = (unsigned)wid * 1024u;
    const int aoff = lds_byte(wr * 64 + fr, fq * 8), boff = lds_byte(wc * 32 + fr, fq * 8);
#define PG8_SA(b, h) (((b) * 2 + (h)) * HTB)
#define PG8_SB(b, h) ((4 + (b) * 2 + (h)) * HTB)
#define PG8_STAGE(bufoff, gbase, voff) do { _Pragma("unroll") for (int _i = 0; _i < 2; ++_i) \
        __builtin_amdgcn_global_load_lds((const unsigned*)((const char*)(gbase) + (voff)[_i]), (PG8_LAS unsigned*)(lds + (bufoff) + ldsw + _i * 8192), 16, 0, 0); } while (0)
#define PG8_LDA(dst, b, h) do { _Pragma("unroll") for (int m = 0; m < 4; ++m) _Pragma("unroll") for (int k = 0; k < 2; ++k) dst[m][k] = *(const PG8_LAS bf16x8*)(lds + PG8_SA(b, h) + aoff + m * 2048 + k * 1024); } while (0)
#define PG8_LDB(dst, b, h) do { _Pragma("unroll") for (int n = 0; n < 2; ++n) _Pragma("unroll") for (int k = 0; k < 2; ++k) dst[n][k] = *(const PG8_LAS bf16x8*)(lds + PG8_SB(b, h) + boff + n * 2048 + k * 1024); } while (0)
#define PG8_MMA(ai, bj, At, Bt) do { __builtin_amdgcn_s_setprio(1); _Pragma("unroll") for (int m = 0; m < 4; ++m) _Pragma("unroll") for (int n = 0; n < 2; ++n) _Pragma("unroll") for (int k = 0; k < 2; ++k) \
        acc[ai][bj][m][n] = __builtin_amdgcn_mfma_f32_16x16x32_bf16(Bt[n][k], At[m][k], acc[ai][bj][m][n], 0, 0, 0); __builtin_amdgcn_s_setprio(0); } while (0)
#define PG8_WAIT_V(n) asm volatile("s_waitcnt vmcnt(" #n ")" ::: "memory")
#define PG8_WAIT_L(n) asm volatile("s_waitcnt lgkmcnt(" #n ")" ::: "memory")
#define PG8_BAR __builtin_amdgcn_s_barrier()
#define PG8_SCHED __builtin_amdgcn_sched_barrier(0)
    Unit cur, nxt; int ui = 0;
    if (!S.next(0, cur)) return;
    f32x4 acc[2][2][4][2];
#pragma unroll
    for (int a = 0; a < 2; ++a)
#pragma unroll
        for (int b = 0; b < 2; ++b)
#pragma unroll
            for (int m = 0; m < 4; ++m)
#pragma unroll
                for (int n = 0; n < 2; ++n) acc[a][b][m][n] = (f32x4){0.f, 0.f, 0.f, 0.f};
    bf16x8 At[4][2], B0[2][2], B1[2][2];
    const char* cA = (const char*)g.A + (size_t)cur.pm * tstep; const char* cB = (const char*)g.Bt + (size_t)cur.pn * tstep;
    S.a_ready(cur);
    if constexpr (SP2) {
        PG8_STAGE(PG8_SB(0, 0), cB, voffB); PG8_STAGE(PG8_SB(0, 1), cB + hstep, voffB); PG8_STAGE(PG8_SA(0, 0), cA, voffA); PG8_STAGE(PG8_SA(0, 1), cA + hstep, voffA);
        if (wr == 1) PG8_BAR;
        PG8_WAIT_V(2); PG8_BAR;
        PG8_STAGE(PG8_SB(1, 0), cB + kstep, voffB); PG8_STAGE(PG8_SA(1, 0), cA + kstep, voffA); PG8_STAGE(PG8_SB(1, 1), cB + hstep + kstep, voffB);
        PG8_WAIT_V(6); PG8_BAR;
    } else {
        PG8_STAGE(PG8_SB(0, 0), cB, voffB); PG8_STAGE(PG8_SA(0, 0), cA, voffA); PG8_STAGE(PG8_SB(0, 1), cB + hstep, voffB); PG8_STAGE(PG8_SA(0, 1), cA + hstep, voffA);
        if (wr == 1) PG8_BAR;
        PG8_WAIT_V(4); PG8_BAR;
        PG8_STAGE(PG8_SB(1, 0), cB + kstep, voffB); PG8_STAGE(PG8_SA(1, 0), cA + kstep, voffA); PG8_STAGE(PG8_SB(1, 1), cB + hstep + kstep, voffB);
        PG8_WAIT_V(6); PG8_BAR;
    }
    for (;;) {
        const bool has_next = S.next(ui + 1, nxt);
        const char* nA = has_next ? (const char*)g.A + (size_t)nxt.pm * tstep : cA; const char* nB = has_next ? (const char*)g.Bt + (size_t)nxt.pn * tstep : cB;
        for (int t = 0; t < nt; t += 2) {
            const bool last = (t == nt - 2);
            const char* a1 = cA + (size_t)(t + 1) * kstep;
            const char* a2 = last ? nA : cA + (size_t)(t + 2) * kstep; const char* b2 = last ? nB : cB + (size_t)(t + 2) * kstep;
            const char* a3 = a2 + kstep; const char* b3 = b2 + kstep;
            if (last && has_next) S.a_ready(nxt);
            if constexpr (SP2) {
            PG8_LDB(B0, 0, 0); PG8_LDB(B1, 0, 1); PG8_SCHED; PG8_LDA(At, 0, 0); PG8_STAGE(PG8_SA(1, 1), a1 + hstep, voffA);
            PG8_WAIT_V(8); PG8_WAIT_L(0); PG8_BAR; PG8_MMA(0, 0, At, B0); PG8_MMA(0, 1, At, B1); PG8_BAR; PG8_SCHED;
            PG8_LDA(At, 0, 1); PG8_STAGE(PG8_SB(0, 0), b2, voffB); PG8_STAGE(PG8_SB(0, 1), b2 + hstep, voffB); PG8_STAGE(PG8_SA(0, 0), a2, voffA);
            PG8_WAIT_V(8); PG8_WAIT_L(0); PG8_BAR; PG8_MMA(1, 0, At, B0); PG8_MMA(1, 1, At, B1); PG8_BAR; PG8_SCHED;
            PG8_LDB(B0, 1, 0); PG8_LDB(B1, 1, 1); PG8_SCHED; PG8_LDA(At, 1, 0); PG8_STAGE(PG8_SA(0, 1), a2 + hstep, voffA);
            PG8_WAIT_V(8); PG8_WAIT_L(0); PG8_BAR; PG8_MMA(0, 0, At, B0); PG8_MMA(0, 1, At, B1); PG8_BAR; PG8_SCHED;
            PG8_LDA(At, 1, 1); PG8_STAGE(PG8_SB(1, 0), b3, voffB); PG8_STAGE(PG8_SB(1, 1), b3 + hstep, voffB); PG8_STAGE(PG8_SA(1, 0), a3, voffA);
            PG8_WAIT_V(8); PG8_WAIT_L(0); PG8_BAR; PG8_MMA(1, 0, At, B0); PG8_MMA(1, 1, At, B1); PG8_BAR; PG8_SCHED;
            } else {
            PG8_LDB(B0, 0, 0); PG8_SCHED; PG8_LDA(At, 0, 0); PG8_STAGE(PG8_SA(1, 1), a1 + hstep, voffA);
            PG8_WAIT_L(8); PG8_BAR; PG8_WAIT_L(0); PG8_MMA(0, 0, At, B0); PG8_BAR; PG8_SCHED;
            PG8_LDB(B1, 0, 1); PG8_STAGE(PG8_SB(0, 0), b2, voffB);
            PG8_BAR; PG8_WAIT_L(0); PG8_MMA(0, 1, At, B1); PG8_BAR;
            PG8_LDA(At, 0, 1); PG8_STAGE(PG8_SA(0, 0), a2, voffA);
            PG8_BAR; PG8_WAIT_L(0); PG8_MMA(1, 0, At, B0); PG8_BAR; PG8_SCHED;
            PG8_STAGE(PG8_SB(0, 1), b2 + hstep, voffB);
            PG8_WAIT_V(6); PG8_BAR; PG8_MMA(1, 1, At, B1); PG8_BAR;
            PG8_LDB(B0, 1, 0); PG8_SCHED; PG8_LDA(At, 1, 0); PG8_STAGE(PG8_SA(0, 1), a2 + hstep, voffA);
            PG8_WAIT_L(8); PG8_BAR; PG8_WAIT_L(0); PG8_MMA(0, 0, At, B0); PG8_BAR; PG8_SCHED;
            PG8_LDB(B1, 1, 1); PG8_STAGE(PG8_SB(1, 0), b3, voffB);
            PG8_BAR; PG8_WAIT_L(0); PG8_MMA(0, 1, At, B1); PG8_BAR;
            PG8_LDA(At, 1, 1); PG8_STAGE(PG8_SA(1, 0), a3, voffA);
            PG8_BAR; PG8_WAIT_L(0); PG8_MMA(1, 0, At, B0); PG8_BAR; PG8_SCHED;
            PG8_STAGE(PG8_SB(1, 1), b3 + hstep, voffB);
            PG8_WAIT_V(6); PG8_BAR; PG8_MMA(1, 1, At, B1); PG8_BAR;
            }
        }
        if constexpr (ALIGN_EPI) { if (wr == 0) PG8_BAR; }
        if constexpr (!Epi::AFTER_DRAIN) { E(acc, cur, wr, wc, fr, fq); S.done(cur); }
        if (!has_next) break;
#pragma unroll
        for (int a = 0; a < 2; ++a)
#pragma unroll
            for (int b = 0; b < 2; ++b)
#pragma unroll
                for (int m = 0; m < 4; ++m)
#pragma unroll
                    for (int n = 0; n < 2; ++n) acc[a][b][m][n] = (f32x4){0.f, 0.f, 0.f, 0.f};
        cur = nxt; cA = nA; cB = nB; ++ui;
        if constexpr (ALIGN_EPI) { if (wr == 1) PG8_BAR; }
    }
    PG8_WAIT_V(0);
    if constexpr (!ALIGN_EPI) { if (wr == 0) PG8_BAR; }
    PG8_BAR;
    if constexpr (Epi::AFTER_DRAIN) { E.fused(acc, cur, wr, wc, fr, fq, lds, wid, lane); S.done(cur); }
#undef PG8_SA
#undef PG8_SB
#undef PG8_STAGE
#undef PG8_LDA
#undef PG8_LDB
#undef PG8_MMA
#undef PG8_WAIT_V
#undef PG8_WAIT_L
#undef PG8_BAR
#undef PG8_SCHED
}
}
#define LAS __attribute__((address_space(3)))
typedef unsigned short bf16_t;
typedef short bf16x8 __attribute__((ext_vector_type(8)));
typedef short bf16x4 __attribute__((ext_vector_type(4)));
typedef float f32x4 __attribute__((ext_vector_type(4)));
typedef float f32x2 __attribute__((ext_vector_type(2)));
typedef unsigned u32x4 __attribute__((ext_vector_type(4)));
typedef unsigned u32x2 __attribute__((ext_vector_type(2)));
typedef __bf16 bf16x2_t __attribute__((ext_vector_type(2)));

constexpr int T = 16384, D = 1024, SEQ = 2048;
constexpr float EPS = 1e-6f;
constexpr size_t MiB = 1u << 20;
constexpr int LDS_BYTES = 163840;
#ifndef N_LAUNCH_SPLIT
#define N_LAUNCH_SPLIT 0
#endif

constexpr size_t W_MIXIN = 1 * MiB, W_UQ = 10 * MiB, W_UKV = 12 * MiB, W_MIXO = 13 * MiB, W_XQ = 15 * MiB, W_XKV = 17 * MiB, W_XO = 21 * MiB, W_1 = 23 * MiB, W_2 = 31 * MiB;
constexpr size_t WS_H = 39 * MiB, WS_MEMN = 71 * MiB, WS_MK = 75 * MiB, WS_MVT = 79 * MiB, WS_COS = 83 * MiB, WS_SIN = 85 * MiB, WS_AR = 87 * MiB;
constexpr size_t A_Z = WS_AR, A_CQN = WS_AR + 44 * MiB, A_CKVN = WS_AR + 56 * MiB, A_KROPE = WS_AR + 64 * MiB, A_Q = WS_AR + 66 * MiB, A_KNOPE = WS_AR + 114 * MiB, A_VT = WS_AR + 146 * MiB;
constexpr size_t G_PRE = WS_AR, G_POST = WS_AR + 96 * MiB, G_GATE = WS_AR + 192 * MiB, G_LOGIT = WS_AR + 224 * MiB, G_BETA = WS_AR + 225 * MiB, G_G = G_BETA + MiB / 2, G_GC = WS_AR + 226 * MiB;
constexpr size_t G_W = WS_AR, G_UT = WS_AR + 32 * MiB, G_ATT = WS_AR + 64 * MiB;
constexpr size_t WS_END = WS_AR + 227 * MiB;

__device__ __forceinline__ float shx(float v, int m, int lane) { return __int_as_float(__builtin_amdgcn_ds_bpermute((lane ^ m) << 2, __float_as_int(v))); }
__device__ __forceinline__ float wave_sum(float v, int lane) {
#pragma unroll
    for (int o = 32; o > 0; o >>= 1) v += shx(v, o, lane);
    return v;
}
__device__ __forceinline__ float bf2f(unsigned short b) { return __uint_as_float(((unsigned)b) << 16); }
__device__ __forceinline__ unsigned pk2(float lo, float hi) { f32x2 v = {lo, hi}; bf16x2_t b = __builtin_convertvector(v, bf16x2_t); return __builtin_bit_cast(unsigned, b); }
__device__ __forceinline__ unsigned short f2bf(float f) { return (unsigned short)(pk2(f, 0.f) & 0xffffu); }
__device__ __forceinline__ float silu_f(float x) { return x / (1.f + __expf(-x)); }
__device__ __forceinline__ u32x2 pk4(f32x4 v) { u32x2 r; r.x = pk2(v[0], v[1]); r.y = pk2(v[2], v[3]); return r; }
#define MFMA16(a, b, c) __builtin_amdgcn_mfma_f32_16x16x32_bf16((a), (b), (c), 0, 0, 0)

__device__ __forceinline__ u32x4 pk8(f32x4 a, f32x4 b) { const u32x2 x = pk4(a), y = pk4(b); return (u32x4){x.x, x.y, y.x, y.y}; }
struct Pre4 { f32x4 a, b, c, d; };
template <class F> struct EpiF {
    static constexpr bool PERM = F::WIDE, AFTER_DRAIN = false;
    F f;
    __device__ __forceinline__ void operator()(const pg8::f32x4 (&acc)[2][2][4][2], const pg8::Unit& u, int wr, int wc, int fr, int fq) const {
        constexpr int NS = PERM ? 4 : 16;
        const int rowb = u.pm * 256 + wr * 64 + fr, colb = u.pn * 256 + wc * 32 + fq * (PERM ? 8 : 4);
        Pre4 pre[2];
        if constexpr (F::MODE != 0) f.prefetch(pre[0], rowb, colb);
#pragma unroll
        for (int g = 0; g < 8; ++g) {
            const int ai = g >> 2, m = g & 3, row = rowb + ai * 128 + m * 16;
            if constexpr (F::MODE != 0) { if (g + 1 < 8) f.prefetch(pre[(g + 1) & 1], rowb + ((g + 1) >> 2) * 128 + ((g + 1) & 3) * 16, colb); }
            asm volatile("" ::: "memory");
            if constexpr (F::MODE == 2) {
                const Pre4& p = pre[g & 1]; float part = 0.f;
#pragma unroll
                for (int bj = 0; bj < 2; ++bj) { const f32x4 o0 = (bj == 0 ? p.a : p.c) + acc[ai][bj][m][0], o1 = (bj == 0 ? p.b : p.d) + acc[ai][bj][m][1];
                    const u32x2 w0 = pk4(o0), w1 = pk4(o1); *(u32x4*)(f.xb + (size_t)row * D + colb + bj * 128) = (u32x4){w0.x, w0.y, w1.x, w1.y};
                    part += ((o0[0] * o0[0] + o0[1] * o0[1]) + (o0[2] * o0[2] + o0[3] * o0[3])) + ((o1[0] * o1[0] + o1[1] * o1[1]) + (o1[2] * o1[2] + o1[3] * o1[3])); }
                const int lane = fq * 16 + fr; part += shx(part, 16, lane); part += shx(part, 32, lane);
                if (fq == 0) f.ssq[(size_t)row * 16 + u.pn * 4 + wc] = part;
            } else {
                float rs = 1.f;
                if constexpr (F::MODE == 1 || F::MODE == 3) { const Pre4& p = pre[g & 1]; const f32x4 t = (p.a + p.b) + (p.c + p.d); rs = rsqrtf(((t[0] + t[1]) + (t[2] + t[3])) * F::INVN + EPS); }
                if constexpr (F::MODE == 3) {
                    float pA = 0.f, pB = 0.f;
#pragma unroll
                    for (int bj = 0; bj < 2; ++bj) { const int col = colb + bj * 128; const f32x4 v0 = acc[ai][bj][m][0] * rs, v1 = acc[ai][bj][m][1] * rs;
                        const float sq = ((v0[0] * v0[0] + v0[1] * v0[1]) + (v0[2] * v0[2] + v0[3] * v0[3])) + ((v1[0] * v1[0] + v1[1] * v1[1]) + (v1[2] * v1[2] + v1[3] * v1[3]));
                        if (col < 384) { *(u32x4*)(f.cq + (size_t)row * 384 + col) = pk8(v0, v1); if (bj == 0) pA += sq; else pB += sq; }
                        else if (col < 640) { *(u32x4*)(f.ckv + (size_t)row * 256 + (col - 384)) = pk8(v0, v1); if (bj == 0) pA += sq; else pB += sq; }
                        else if (col < 704) { float* kp = f.kr + (size_t)row * 64 + (col - 640); *(f32x4*)kp = v0; *(f32x4*)(kp + 4) = v1; } }
                    const int lane = fq * 16 + fr; pA += shx(pA, 16, lane); pA += shx(pA, 32, lane); pB += shx(pB, 16, lane); pB += shx(pB, 32, lane);
                    if (fq == 0) { float* q2 = f.ssq2 + (size_t)row * 32;
                        if (u.pn == 0) { q2[wc] = pA; q2[4 + wc] = pB; } else if (u.pn == 1) { q2[8 + wc] = pA; q2[16 + wc] = pB; } else { q2[20 + wc] = pA; } }
                } else {
#pragma unroll
                for (int bj = 0; bj < 2; ++bj) {
                    if constexpr (F::WIDE) { f.one2(row, colb + bj * 128, acc[ai][bj][m][0] * rs, acc[ai][bj][m][1] * rs); __builtin_amdgcn_sched_barrier(0); }
                    else {
#pragma unroll
                        for (int n = 0; n < 2; ++n) { f.one(row, colb + bj * 128 + n * NS, acc[ai][bj][m][n] * rs, bj); __builtin_amdgcn_sched_barrier(0); } } }
                }
            }
            asm volatile("" ::: "memory");
        }
    }
};
template <class F> __device__ __forceinline__ void run_gemm(LAS unsigned char* lds, const bf16_t* A, const bf16_t* Bt, int M, int N, int K, const F& f, const int wv, const int cshift = 0) {
    int cc_ = (int)blockIdx.x + cshift; if (cc_ >= (int)gridDim.x) cc_ -= (int)gridDim.x;
    pg8::Gemm g{A, Bt, M, N, K}; pg8::StaticOrder S; S.init(M, N, (int)gridDim.x, cc_);
    EpiF<F> E{f};
    pg8::gemm_phase<EpiF<F>, pg8::StaticOrder, true, true>(lds, g, S, E, wv);
}
#define F_PLAIN static constexpr int MODE = 0; static constexpr bool WIDE = false;
#define F_SCALEDW static constexpr int MODE = 1; static constexpr float INVN = 1.f / D; static constexpr bool WIDE = true; __device__ __forceinline__ void prefetch(Pre4& p, int row, int) const { const f32x4* q_ = (const f32x4*)(ssq + (size_t)row * 16); p.a = q_[0]; p.b = q_[1]; p.c = q_[2]; p.d = q_[3]; }
#define F_SCALED static constexpr int MODE = 1; static constexpr float INVN = 1.f / D; static constexpr bool WIDE = false; __device__ __forceinline__ void prefetch(Pre4& p, int row, int) const { const f32x4* q_ = (const f32x4*)(ssq + (size_t)row * 16); p.a = q_[0]; p.b = q_[1]; p.c = q_[2]; p.d = q_[3]; }
struct FResid { float* x; bf16_t* xb; float* ssq; static constexpr int MODE = 2; static constexpr bool WIDE = true;
    __device__ __forceinline__ static f32x4 up4(const bf16_t* q) { const bf16x4 v = *(const bf16x4*)q; return (f32x4){bf2f((unsigned short)v[0]), bf2f((unsigned short)v[1]), bf2f((unsigned short)v[2]), bf2f((unsigned short)v[3])}; }
    __device__ __forceinline__ void prefetch(Pre4& p, int row, int colb) const { const bf16_t* q_ = xb + (size_t)row * D + colb; p.a = up4(q_); p.b = up4(q_ + 4); p.c = up4(q_ + 128); p.d = up4(q_ + 132); } };
struct FBf16 { bf16_t* O; int ldc; F_PLAIN __device__ __forceinline__ void one(int row, int col, f32x4 v, int bj) const { *(u32x2*)(O + (size_t)row * ldc + col) = pk4(v); } };
struct FBf16S { bf16_t* O; int ldc; const float* ssq; F_SCALEDW __device__ __forceinline__ void one2(int row, int col, f32x4 v0, f32x4 v1) const { *(u32x4*)(O + (size_t)row * ldc + col) = pk8(v0, v1); } };
struct FRelu2 { bf16_t* O; int ldc; const float* ssq; F_SCALEDW __device__ __forceinline__ void one2(int row, int col, f32x4 v0, f32x4 v1) const {
    f32x4 r0, r1; for (int e = 0; e < 4; ++e) { const float t = v0[e] > 0.f ? v0[e] : 0.f; r0[e] = t * t; const float t1 = v1[e] > 0.f ? v1[e] : 0.f; r1[e] = t1 * t1; } *(u32x4*)(O + (size_t)row * ldc + col) = pk8(r0, r1); } };
struct FMlaIn { bf16_t* cq; bf16_t* ckv; float* kr; const float* ssq; float* ssq2; static constexpr int MODE = 3; static constexpr bool WIDE = true; static constexpr float INVN = 1.f / D;
    __device__ __forceinline__ void prefetch(Pre4& p, int row, int) const { const f32x4* q_ = (const f32x4*)(ssq + (size_t)row * 16); p.a = q_[0]; p.b = q_[1]; p.c = q_[2]; p.d = q_[3]; } };
struct FUq { bf16_t* O; const float* ssq2; static constexpr int MODE = 1; static constexpr bool WIDE = true; static constexpr float INVN = 1.f / 384.f;
    __device__ __forceinline__ void prefetch(Pre4& p, int row, int) const { const f32x4* q_ = (const f32x4*)(ssq2 + (size_t)row * 32); p.a = q_[0]; p.b = q_[1]; p.c = q_[2]; p.d = (f32x4){0.f, 0.f, 0.f, 0.f}; }
    __device__ __forceinline__ void one2(int row, int col, f32x4 v0, f32x4 v1) const { *(u32x4*)(O + (size_t)row * 1536 + col) = pk8(v0, v1); } };
struct FMemKV { bf16_t* K; bf16_t* Vt; static constexpr int MODE = 0; static constexpr bool WIDE = true; __device__ __forceinline__ void one2(int row, int col, f32x4 v0, f32x4 v1) const {
    if (col < 1024) { *(u32x4*)(K + (size_t)row * 1024 + col) = pk8(v0, v1); }
    else { const int c = col - 1024, hh = c >> 8, d = c & 255, b = row >> 8, m = row & 255; bf16_t* p = Vt + (size_t)(((b * 4 + hh) * 4 + (m >> 6)) * 16384 + d * 64 + (m & 63));
#pragma unroll
        for (int e = 0; e < 4; ++e) { p[e * 64] = f2bf(v0[e]); p[(4 + e) * 64] = f2bf(v1[e]); } } } };
struct FUkv { bf16_t* kn; bf16_t* Vt; const float* ssq2; static constexpr int MODE = 1; static constexpr bool WIDE = true; static constexpr float INVN = 1.f / 256.f;
    __device__ __forceinline__ void prefetch(Pre4& p, int row, int) const { const f32x4* q_ = (const f32x4*)(ssq2 + (size_t)row * 32 + 16); p.a = q_[0]; p.b = q_[1]; p.c = (f32x4){0.f, 0.f, 0.f, 0.f}; p.d = p.c; }
    __device__ __forceinline__ void one2(int row, int col, f32x4 v0, f32x4 v1) const {
    const int hh = col >> 8, wi = col & 255;
    if (wi < 128) { *(u32x4*)(kn + (size_t)row * 1024 + hh * 128 + wi) = pk8(v0, v1); }
    else { const int d = wi - 128, b = row >> 11, s = row & 2047; bf16_t* p = Vt + (size_t)(((b * 8 + hh) * 32 + (s >> 6)) * 8192 + d * 64 + (s & 63));
#pragma unroll
        for (int e = 0; e < 4; ++e) { p[e * 64] = f2bf(v0[e]); p[(4 + e) * 64] = f2bf(v1[e]); } } } };
struct FGdnIn { bf16_t* qkv; bf16_t* gate; float* logit; const float* ssq; F_SCALEDW __device__ __forceinline__ void one2(int row, int col, f32x4 v0, f32x4 v1) const {
    if (col < 3072) *(u32x4*)(qkv + (size_t)row * 3072 + col) = pk8(v0, v1);
    else if (col < 4096) *(u32x4*)(gate + (size_t)row * 1024 + (col - 3072)) = pk8(v0, v1);
    else if (col < 4112) { float* lp = logit + (size_t)row * 16 + (col - 4096); *(f32x4*)lp = v0; *(f32x4*)(lp + 4) = v1; } } };

__device__ __forceinline__ void conv_w(const float* __restrict__ W, int K, int Nvalid, int Npad, bf16_t* __restrict__ WT, LAS float* scr, int gw, int NGW, int lane, const float* __restrict__ gk = nullptr) {
    const int nblk = Npad / 32, nitems = (K / 64) * nblk;
    const int r = lane >> 3, c4 = (lane & 7) * 4;
    for (int it = gw; it < nitems; it += NGW) {
        const int kb = it / nblk, nb = it - kb * nblk, k0 = 64 * kb, n0 = 32 * nb;
        const bool ok = (n0 + c4) < Nvalid;
        f32x4 v[8];
#pragma unroll
        for (int i = 0; i < 8; ++i) v[i] = ok ? *(const f32x4*)(W + (size_t)(k0 + 8 * i + r) * Nvalid + n0 + c4) : (f32x4){0.f, 0.f, 0.f, 0.f};
#pragma unroll
        for (int i = 0; i < 8; ++i) { const int kk = 8 * i + r; f32x4 t = v[i]; if (gk) t = t * gk[k0 + kk]; LAS float* d = scr + kk * 33 + c4; d[0] = t[0]; d[1] = t[1]; d[2] = t[2]; d[3] = t[3]; }
        asm volatile("s_waitcnt lgkmcnt(0)" ::: "memory");
        const int c = lane & 7;
#pragma unroll
        for (int j = 0; j < 4; ++j) { const int nn = (lane >> 3) + 8 * j; const LAS float* s = scr + (8 * c) * 33 + nn;
            u32x4 o; o.x = pk2(s[0 * 33], s[1 * 33]); o.y = pk2(s[2 * 33], s[3 * 33]); o.z = pk2(s[4 * 33], s[5 * 33]); o.w = pk2(s[6 * 33], s[7 * 33]);
            *(u32x4*)(WT + (size_t)(n0 + nn) * K + k0 + 8 * c) = o; }
        asm volatile("s_waitcnt lgkmcnt(0)" ::: "memory");
    }
}
__device__ __forceinline__ void init_row(const float* xrow, float* copy, bf16_t* orow, float* ssq_row, int lane) {
    const f32x4* xr = (const f32x4*)xrow + lane;
    f32x4 v[4]; float s = 0.f;
#pragma unroll
    for (int j = 0; j < 4; ++j) { v[j] = xr[64 * j]; s += (v[j][0] * v[j][0] + v[j][1] * v[j][1]) + (v[j][2] * v[j][2] + v[j][3] * v[j][3]); }
    s = wave_sum(s, lane);
    u32x2* o8 = (u32x2*)orow + lane;
#pragma unroll
    for (int j = 0; j < 4; ++j) { o8[64 * j] = pk4(v[j]); }
    if (lane < 16) ssq_row[lane] = (lane == 0) ? s : 0.f;
}
__device__ __forceinline__ void rms_row(const float* xrow, const float* g, bf16_t* orow, float* copy, int lane) {
    const f32x4* xr = (const f32x4*)xrow + lane; const f32x4* gr = (const f32x4*)g + lane;
    f32x4 v[4]; float s = 0.f;
#pragma unroll
    for (int j = 0; j < 4; ++j) { v[j] = xr[64 * j]; s += (v[j][0] * v[j][0] + v[j][1] * v[j][1]) + (v[j][2] * v[j][2] + v[j][3] * v[j][3]); }
    const float rstd = rsqrtf(wave_sum(s, lane) * (1.f / D) + EPS);
    u32x2* o8 = (u32x2*)orow + lane;
#pragma unroll
    for (int j = 0; j < 4; ++j) { if (copy) ((f32x4*)copy + lane)[64 * j] = v[j]; const f32x4 gg = gr[64 * j]; o8[64 * j] = pk4(v[j] * rstd * gg); }
}
__device__ __forceinline__ void rms_row_f32(const bf16_t* xrow, float* orow, const float* g, int lane) {
    const bf16x4* xr = (const bf16x4*)xrow + lane; const f32x4* gr = (const f32x4*)g + lane;
    f32x4 v[4]; float s = 0.f;
#pragma unroll
    for (int j = 0; j < 4; ++j) { const bf16x4 t = xr[64 * j]; v[j] = (f32x4){bf2f((unsigned short)t[0]), bf2f((unsigned short)t[1]), bf2f((unsigned short)t[2]), bf2f((unsigned short)t[3])};
        s += (v[j][0] * v[j][0] + v[j][1] * v[j][1]) + (v[j][2] * v[j][2] + v[j][3] * v[j][3]); }
    const float rstd = rsqrtf(wave_sum(s, lane) * (1.f / D) + EPS);
#pragma unroll
    for (int j = 0; j < 4; ++j) ((f32x4*)orow + lane)[64 * j] = v[j] * rstd * gr[64 * j];
}

template <int DK1, int DK2, int DV, int RT, bool CAUSAL, bool ROPE>
__device__ __forceinline__ void attn_unit(LAS unsigned char* lds, const bf16_t* __restrict__ Q, int ldq, const bf16_t* __restrict__ K1, int ldk1, const bf16_t* __restrict__ K2, int ldk2,
                                          const bf16_t* __restrict__ Vt, int ldvt, int nkt, int q0, bf16_t* __restrict__ O, int ldo, float sl2, const float* __restrict__ cosr, const float* __restrict__ sinr, const int wv) {
    constexpr int DQK = DK1 + DK2, NKS = DQK / 32, NDT = DV / 16, KP = DQK + 16, VP = 80, KCH = DQK / 8;
    const int tid = pg8::opq_tid(wv), lane = tid & 63, wid = tid >> 6, fr = lane & 15, fq = lane >> 4;
    const int wrow0 = wid * 16 * RT;
    constexpr int NKL = (64 * KCH) / 512, NVL = (DV * 8) / 512, BUFB = (64 * KP + DV * VP) * 2;
    u32x4 kreg[NKL], vreg[NVL];
#define ATT_LOAD(kt_) do { \
        _Pragma("unroll") for (int i = 0; i < NKL; ++i) { const int id = tid + 512 * i, key = id / KCH, c = id - key * KCH; \
            const bf16_t* src = (c < DK1 / 8) ? (K1 + (size_t)((kt_) * 64 + key) * ldk1 + c * 8) : (K2 + (size_t)((kt_) * 64 + key) * ldk2 + (c - DK1 / 8) * 8); kreg[i] = *(const u32x4*)src; } \
        _Pragma("unroll") for (int i = 0; i < NVL; ++i) { const int id = tid + 512 * i, d = id >> 3, c = id & 7; vreg[i] = *(const u32x4*)(Vt + (size_t)(kt_) * (DV * 64) + d * 64 + c * 8); } } while (0)
#define ATT_STORE(buf_) do { LAS bf16_t* Kd = (LAS bf16_t*)(lds + (buf_) * BUFB); LAS bf16_t* Vd = Kd + 64 * KP; \
        _Pragma("unroll") for (int i = 0; i < NKL; ++i) { const int id = tid + 512 * i, key = id / KCH, c = id - key * KCH; *(LAS u32x4*)(Kd + key * KP + c * 8) = kreg[i]; } \
        _Pragma("unroll") for (int i = 0; i < NVL; ++i) { const int id = tid + 512 * i, d = id >> 3, c = id & 7; LAS bf16_t* vp_ = Vd + d * VP + (c >> 2) * 32 + (c & 1) * 16 + ((c & 3) >> 1) * 4; \
            *(LAS u32x2*)vp_ = (u32x2){vreg[i].x, vreg[i].y}; *(LAS u32x2*)(vp_ + 8) = (u32x2){vreg[i].z, vreg[i].w}; } } while (0)
    ATT_LOAD(0);
    bf16x8 qf[RT][NKS];
#pragma unroll
    for (int rt = 0; rt < RT; ++rt)
#pragma unroll
        for (int ks = 0; ks < NKS; ++ks) qf[rt][ks] = *(const bf16x8*)(Q + (size_t)(wrow0 + rt * 16 + fr) * ldq + ks * 32 + fq * 8);
    if (!ROPE) {
#pragma unroll
        for (int rt = 0; rt < RT; ++rt)
#pragma unroll
            for (int ks = 0; ks < NKS; ++ks) { bf16x8 a = qf[rt][ks], o;
#pragma unroll
                for (int j = 0; j < 8; ++j) o[j] = (short)f2bf(bf2f((unsigned short)a[j]) * sl2);
                qf[rt][ks] = o; }
    }
    if (ROPE) {
#pragma unroll
        for (int rt = 0; rt < RT; ++rt)
#pragma unroll
            for (int ks = 0; ks < DK1 / 32; ++ks) { bf16x8 a = qf[rt][ks], o;
#pragma unroll
                for (int j = 0; j < 8; ++j) o[j] = (short)f2bf(bf2f((unsigned short)a[j]) * sl2);
                qf[rt][ks] = o; }
#pragma unroll
        for (int rt = 0; rt < RT; ++rt) {
            const int row = wrow0 + rt * 16 + fr; constexpr int k1 = DK1 / 32;
            bf16x8 a = qf[rt][k1], b = qf[rt][k1 + 1], oa, ob;
#pragma unroll
            for (int j = 0; j < 8; ++j) { const float c = cosr[row * 32 + fq * 8 + j], s = sinr[row * 32 + fq * 8 + j];
                const float x1 = bf2f((unsigned short)a[j]), x2 = bf2f((unsigned short)b[j]);
                oa[j] = (short)f2bf((x1 * c - x2 * s) * sl2); ob[j] = (short)f2bf((x2 * c + x1 * s) * sl2); }
            qf[rt][k1] = oa; qf[rt][k1 + 1] = ob;
        }
    }
    float m_run[RT], l_run[RT]; f32x4 oacc[RT][NDT];
#pragma unroll
    for (int rt = 0; rt < RT; ++rt) { m_run[rt] = -INFINITY; l_run[rt] = 0.f;
#pragma unroll
        for (int dt = 0; dt < NDT; ++dt) oacc[rt][dt] = (f32x4){0.f, 0.f, 0.f, 0.f}; }
    ATT_STORE(0);
    if (nkt > 1) ATT_LOAD(1);
    __syncthreads();
    for (int kt = 0; kt < nkt; ++kt) {
        if (kt + 1 < nkt) ATT_STORE((kt + 1) & 1);
        if (kt + 2 < nkt) ATT_LOAD(kt + 2);
        const LAS bf16_t* Kb = (const LAS bf16_t*)(lds + (kt & 1) * BUFB); const LAS bf16_t* Vb = Kb + 64 * KP;
        if (!(CAUSAL && kt * 64 > q0 + wrow0 + 16 * RT - 1)) {
        f32x4 sacc[RT][4];
#pragma unroll
        for (int rt = 0; rt < RT; ++rt)
#pragma unroll
            for (int ct = 0; ct < 4; ++ct) sacc[rt][ct] = (f32x4){0.f, 0.f, 0.f, 0.f};
#pragma unroll
        for (int ks = 0; ks < NKS; ++ks) { bf16x8 kf[4];
#pragma unroll
            for (int ct = 0; ct < 4; ++ct) kf[ct] = *(const LAS bf16x8*)(Kb + (ct * 16 + fr) * KP + ks * 32 + fq * 8);
#pragma unroll
            for (int ct = 0; ct < 4; ++ct)
#pragma unroll
                for (int rt = 0; rt < RT; ++rt) sacc[rt][ct] = MFMA16(kf[ct], qf[rt][ks], sacc[rt][ct]); }
        const bool need_mask = CAUSAL && (kt * 64 + 63 > q0 + wrow0);
        bf16x8 pf[RT][2];
#pragma unroll
        for (int rt = 0; rt < RT; ++rt) {
            const int qi = q0 + wrow0 + rt * 16 + fr;
            float mx = -INFINITY;
#pragma unroll
            for (int ct = 0; ct < 4; ++ct)
#pragma unroll
                for (int e = 0; e < 4; ++e) { float s = sacc[rt][ct][e]; if (need_mask && (kt * 64 + ct * 16 + fq * 4 + e > qi)) s = -INFINITY; sacc[rt][ct][e] = s; mx = fmaxf(mx, s); }
            mx = fmaxf(mx, shx(mx, 16, lane)); mx = fmaxf(mx, shx(mx, 32, lane));
            const float m_new = fmaxf(m_run[rt], mx);
            const float alpha = __builtin_amdgcn_exp2f(m_run[rt] - m_new); m_run[rt] = m_new;
            float ls = 0.f;
#pragma unroll
            for (int ct = 0; ct < 4; ++ct)
#pragma unroll
                for (int e = 0; e < 4; ++e) { const float p = __builtin_amdgcn_exp2f(sacc[rt][ct][e] - m_new); sacc[rt][ct][e] = p; ls += p; }
            l_run[rt] = l_run[rt] * alpha + ls;
            if (__any(alpha != 1.f)) {
#pragma unroll
                for (int dt = 0; dt < NDT; ++dt) oacc[rt][dt] = oacc[rt][dt] * alpha; }
#pragma unroll
            for (int s2 = 0; s2 < 2; ++s2) { u32x4 w; w.x = pk2(sacc[rt][2 * s2][0], sacc[rt][2 * s2][1]); w.y = pk2(sacc[rt][2 * s2][2], sacc[rt][2 * s2][3]);
                w.z = pk2(sacc[rt][2 * s2 + 1][0], sacc[rt][2 * s2 + 1][1]); w.w = pk2(sacc[rt][2 * s2 + 1][2], sacc[rt][2 * s2 + 1][3]); pf[rt][s2] = __builtin_bit_cast(bf16x8, w); }
        }
#pragma unroll
        for (int dh = 0; dh < NDT / 4; ++dh)
#pragma unroll
            for (int s2 = 0; s2 < 2; ++s2) { bf16x8 vf[4];
#pragma unroll
                for (int d4 = 0; d4 < 4; ++d4) vf[d4] = *(const LAS bf16x8*)(Vb + ((dh * 4 + d4) * 16 + fr) * VP + s2 * 32 + fq * 8);
#pragma unroll
                for (int d4 = 0; d4 < 4; ++d4)
#pragma unroll
                    for (int rt = 0; rt < RT; ++rt) oacc[rt][dh * 4 + d4] = MFMA16(vf[d4], pf[rt][s2], oacc[rt][dh * 4 + d4]);
                if (NDT > 8) __builtin_amdgcn_sched_barrier(0);
            }
        }
        __syncthreads();
    }
    {
        constexpr int OSP = DV + 8, RPI = 512 / DV, CPR = DV / 8;
        LAS bf16_t* Os = (LAS bf16_t*)(lds + wid * (16 * RT * OSP * 2));
#pragma unroll
        for (int rt = 0; rt < RT; ++rt) {
            float l = l_run[rt]; l += shx(l, 16, lane); l += shx(l, 32, lane);
            const float inv = 1.f / l;
#pragma unroll
            for (int dt = 0; dt < NDT; ++dt) *(LAS u32x2*)(Os + (rt * 16 + fr) * OSP + dt * 16 + fq * 4) = pk4(oacc[rt][dt] * inv);
        }
#pragma unroll
        for (int i = 0; i < (16 * RT) / RPI; ++i) { const int row = i * RPI + lane / CPR, ch = lane % CPR;
            const u32x4 v = *(const LAS u32x4*)(Os + row * OSP + ch * 8); *(u32x4*)(O + (size_t)(wrow0 + row) * ldo + ch * 8) = v; }
        __syncthreads();
    }
#undef ATT_LOAD
#undef ATT_STORE
}
#define GAS __attribute__((address_space(1)))
typedef GAS unsigned gu32;
typedef GAS unsigned long long gu64;
#define RLX_AGENT __ATOMIC_RELAXED, __HIP_MEMORY_SCOPE_AGENT
#define LDS_WAIT() asm volatile("s_waitcnt lgkmcnt(0)" ::: "memory")
#define VM_WAIT() asm volatile("s_waitcnt vmcnt(0)" ::: "memory")

#define XB_TMO      128
#define XB_XCNT(j)  (256  + 64 * (j))
#define XB_XSUB(j)  (1280 + 64 * (j))
#define XB_XGEN(j)  (2304 + 64 * (j))
#define XB_TOP      3328
#define XB_TOPGEN   3392
#define XCD_BAR_WORDS 3456
#define XB_SPIN_CAP (1u << 18)

__device__ __forceinline__ unsigned xb_ld(unsigned* p)              { return __hip_atomic_load(p, __ATOMIC_RELAXED, __HIP_MEMORY_SCOPE_AGENT); }
__device__ __forceinline__ unsigned xb_add(unsigned* p, unsigned v) { return __hip_atomic_fetch_add(p, v, __ATOMIC_RELAXED, __HIP_MEMORY_SCOPE_AGENT); }
__device__ __forceinline__ unsigned xb_xcc_id() { return (unsigned)__builtin_amdgcn_s_getreg((3 << 11) | 20) & 0xFu; }
#define XB_SPIN(cond, bar) do { unsigned _sp = 0; while (cond) { __builtin_amdgcn_s_sleep(1); \
    if ((++_sp & 255u) == 0u) { if (xb_ld(&(bar)[XB_TMO])) break; if (_sp > XB_SPIN_CAP) { atomicAdd(&(bar)[XB_TMO], 1u); break; } } } } while (0)

struct XcdBarrier {
    unsigned* bar; unsigned x;
    volatile LAS unsigned* st;
};

__device__ __forceinline__ XcdBarrier xcd_barrier_post(unsigned* bar, volatile LAS unsigned* st) {
    XcdBarrier b; b.bar = bar; b.x = xb_xcc_id(); b.st = st;
    if (threadIdx.x == 0) (void)xb_add(&bar[XB_XCNT(b.x)], 1u);
    return b;
}
__device__ __forceinline__ void xcd_barrier_complete(unsigned* bar, unsigned x, unsigned& nloc, unsigned& nx) {
    const unsigned G = gridDim.x * gridDim.y * gridDim.z;
    unsigned sum, cnt, mine, sp = 0u;
    for (;;) {
        sum = 0u; cnt = 0u; mine = 0u;
#pragma unroll
        for (unsigned j = 0; j < 16; ++j) { const unsigned c = xb_ld(&bar[XB_XCNT(j)]); sum += c; cnt += (c > 0u) ? 1u : 0u; mine = (j == x) ? c : mine; }
        if (sum == G) break;
        __builtin_amdgcn_s_sleep(1);
        if ((++sp & 255u) == 0u) { if (xb_ld(&bar[XB_TMO])) break; if (sp > XB_SPIN_CAP) { atomicAdd(&bar[XB_TMO], 1u); break; } }
    }
    nloc = mine > 0u ? mine : 1u; nx = cnt > 0u ? cnt : 1u;
}

__device__ __forceinline__ void xcd_barrier(const XcdBarrier& b) {
    asm volatile("s_waitcnt vmcnt(0)" ::: "memory");
    __syncthreads();
    if (threadIdx.x == 0) {
        unsigned* bar = b.bar;
        __builtin_amdgcn_s_waitcnt(0);
        unsigned nloc = b.st[0], nx = b.st[1];
        if (nloc == 0u) { xcd_barrier_complete(bar, b.x, nloc, nx); b.st[0] = nloc; b.st[1] = nx; }
        const unsigned old = xb_add(&bar[XB_XSUB(b.x)], 1u);
        const unsigned gen = old / nloc;
        if (old + 1u == (gen + 1u) * nloc) {
            __builtin_amdgcn_fence(__ATOMIC_RELEASE, "agent");
            asm volatile("s_waitcnt vmcnt(0)" ::: "memory");
            const unsigned og = xb_add(&bar[XB_TOP], 1u);
            const unsigned tg = og / nx;
            if (og + 1u == (tg + 1u) * nx) xb_add(&bar[XB_TOPGEN], 1u);
            else XB_SPIN(xb_ld(&bar[XB_TOPGEN]) == tg, bar);
            __builtin_amdgcn_fence(__ATOMIC_ACQUIRE, "agent");
            xb_add(&bar[XB_XGEN(b.x)], 1u);
            asm volatile("s_waitcnt vmcnt(0)" ::: "memory");
        } else {
            XB_SPIN(xb_ld(&bar[XB_XGEN(b.x)]) == gen, bar);
            __builtin_amdgcn_fence(__ATOMIC_ACQUIRE, "agent");
            asm volatile("s_waitcnt vmcnt(0)" ::: "memory");
        }
    }
    __syncthreads();
}

__device__ __forceinline__ bf16x8 ldsfrag(const LAS bf16_t* base, int pitch, int row, int k) { return *(const LAS bf16x8*)(base + row * pitch + k); }

__device__ __forceinline__ f32x4 unpk4(u32x2 x) { return (f32x4){__uint_as_float(x.x << 16), __uint_as_float(x.x & 0xffff0000u), __uint_as_float(x.y << 16), __uint_as_float(x.y & 0xffff0000u)}; }
__device__ __forceinline__ void gdn_conv_phase(const bf16_t* __restrict__ pre, bf16_t* __restrict__ post, const float* __restrict__ convw, const float* __restrict__ logit,
                                               const float* __restrict__ a_log, const float* __restrict__ dt_bias, float* __restrict__ beta, float* __restrict__ g, int gw, int NGW, int lane, int gtid, int NT) {
    for (int it = gw; it < 512 * 12; it += NGW) {
        const int rb = it / 12, gp = it - rb * 12, r0 = rb * 32, t0 = r0 & (SEQ - 1), col = gp * 256 + 4 * lane;
        f32x4 w[4];
#pragma unroll
        for (int j = 0; j < 4; ++j) w[j] = *(const f32x4*)(convw + j * 3072 + col);
        f32x4 pv[3];
#pragma unroll
        for (int j = 0; j < 3; ++j) { u32x2 x = {0u, 0u}; if (t0 - 3 + j >= 0) x = *(const u32x2*)(pre + (size_t)(r0 - 3 + j) * 3072 + col); pv[j] = unpk4(x); }
        const bool nrm = gp < 8; const float qsc = (gp < 4) ? 0.08838834764831845f : 1.f;
        for (int tb = 0; tb < 32; tb += 8) {
            u32x2 xr[8];
#pragma unroll
            for (int u = 0; u < 8; ++u) xr[u] = *(const u32x2*)(pre + (size_t)(r0 + tb + u) * 3072 + col);
            f32x4 y[8];
#pragma unroll
            for (int u = 0; u < 8; ++u) { const f32x4 x = unpk4(xr[u]); const f32x4 a = (w[0] * pv[0] + w[1] * pv[1]) + (w[2] * pv[2] + w[3] * x);
                pv[0] = pv[1]; pv[1] = pv[2]; pv[2] = x;
                y[u] = (f32x4){silu_f(a[0]), silu_f(a[1]), silu_f(a[2]), silu_f(a[3])}; }
            if (nrm) { float ss[8];
#pragma unroll
                for (int u = 0; u < 8; ++u) ss[u] = (y[u][0] * y[u][0] + y[u][1] * y[u][1]) + (y[u][2] * y[u][2] + y[u][3] * y[u][3]);
#pragma unroll
                for (int o = 16; o > 0; o >>= 1) {
#pragma unroll
                    for (int u = 0; u < 8; ++u) ss[u] += shx(ss[u], o, lane); }
#pragma unroll
                for (int u = 0; u < 8; ++u) y[u] = y[u] * (rsqrtf(ss[u] + EPS) * qsc); }
#pragma unroll
            for (int u = 0; u < 8; ++u) *(u32x2*)(post + (size_t)(r0 + tb + u) * 3072 + col) = pk4(y[u]);
        }
    }
    for (int i = gtid; i < T * 8; i += NT) { const int r = i >> 3, h = i & 7; const float bl = logit[r * 16 + h], al = logit[r * 16 + 8 + h];
        beta[i] = 1.f / (1.f + expf(-bl)); const float xx = al + dt_bias[h]; const float sp = xx > 20.f ? xx : log1pf(expf(xx)); g[i] = -expf(a_log[h]) * sp; }
}

__device__ __forceinline__ void gdn_chunk_phase(LAS unsigned char* lds, const bf16_t* __restrict__ post, const float* __restrict__ beta, const float* __restrict__ g,
                                                bf16_t* __restrict__ Wc, bf16_t* __restrict__ UT, bf16_t* __restrict__ ATT, float* __restrict__ GC, const int wv) {
    constexpr int KP = 144, TP = 80, SZK = 64 * KP * 2, SZT = 128 * TP * 2;
    LAS bf16_t* kS = (LAS bf16_t*)lds; LAS bf16_t* qS = (LAS bf16_t*)(lds + SZK); LAS bf16_t* vbT = (LAS bf16_t*)(lds + 2 * SZK); LAS bf16_t* kbgT = (LAS bf16_t*)(lds + 2 * SZK + SZT);
    LAS float* Mm = (LAS float*)(lds + 2 * SZK + 2 * SZT); LAS bf16_t* Ti = (LAS bf16_t*)(lds + 2 * SZK + 2 * SZT + 16384); LAS float* gcS = (LAS float*)(lds + 2 * SZK + 2 * SZT + 16384 + 64 * TP * 2); LAS float* btS = gcS + 64;
    const int tid = pg8::opq_tid(wv), lane = tid & 63, wid = tid >> 6, fr = lane & 15, fq = lane >> 4;
    u32x4 cq[2], ck[2], cv[2]; float cg = 0.f, cb = 0.f;
#define CH_LOAD(unit_) do { const int b_ = (unit_) >> 8, h_ = ((unit_) >> 5) & 7, n_ = (unit_) & 31; const size_t r_ = (size_t)b_ * SEQ + n_ * 64; \
        _Pragma("unroll") for (int i = 0; i < 2; ++i) { const int id = tid + 512 * i, pos = id & 63, c8 = id >> 6; const bf16_t* rowp = post + (r_ + pos) * 3072 + h_ * 128 + c8 * 8; \
            cq[i] = *(const u32x4*)rowp; ck[i] = *(const u32x4*)(rowp + 1024); cv[i] = *(const u32x4*)(rowp + 2048); } \
        if (wid == 0) { cg = g[(r_ + lane) * 8 + h_]; cb = beta[(r_ + lane) * 8 + h_]; } } while (0)
    if ((int)blockIdx.x < 2048) CH_LOAD((int)blockIdx.x);
    for (int unit = blockIdx.x; unit < 2048; unit += gridDim.x) {
        const int b = unit >> 8, h = (unit >> 5) & 7, n = unit & 31, r0 = b * SEQ + n * 64;
        __syncthreads();
        if (wid == 0) { float gv = cg;
#pragma unroll
            for (int o = 1; o < 64; o <<= 1) { const float up = __int_as_float(__builtin_amdgcn_ds_bpermute(((lane - o) & 63) << 2, __float_as_int(gv))); if (lane >= o) gv += up; }
            gcS[lane] = gv; btS[lane] = cb; GC[(size_t)unit * 64 + lane] = gv; }
        __syncthreads();
#pragma unroll
        for (int i = 0; i < 2; ++i) { const int id = tid + 512 * i, pos = id & 63, c8 = id >> 6;
            const u32x4 qv = cq[i], kv = ck[i], vv = cv[i];
            *(LAS u32x4*)(qS + pos * KP + c8 * 8) = qv; *(LAS u32x4*)(kS + pos * KP + c8 * 8) = kv;
            const float bt = btS[pos], sc = bt * __expf(gcS[pos]);
            const bf16x8 k8 = __builtin_bit_cast(bf16x8, kv), v8 = __builtin_bit_cast(bf16x8, vv);
#pragma unroll
            for (int e = 0; e < 8; ++e) { kbgT[(c8 * 8 + e) * TP + pos] = f2bf(bf2f((unsigned short)k8[e]) * sc); vbT[(c8 * 8 + e) * TP + pos] = f2bf(bf2f((unsigned short)v8[e]) * bt); } }
        if (unit + (int)gridDim.x < 2048) CH_LOAD(unit + (int)gridDim.x);
        __syncthreads();
#pragma unroll
        for (int tt = 0; tt < 2; ++tt) { const int t = wid + 8 * tt, it = t >> 2, jt = t & 3; const int i = it * 16 + fr, j0 = jt * 16 + fq * 4;
            bf16_t* ap = ATT + (size_t)unit * 4096 + i * 64 + j0;
            if (jt <= it) {
                f32x4 aK = {0.f, 0.f, 0.f, 0.f}, aQ = {0.f, 0.f, 0.f, 0.f};
#pragma unroll
                for (int ks = 0; ks < 4; ++ks) { const bf16x8 kj = ldsfrag(kS, KP, jt * 16 + fr, ks * 32 + fq * 8), ki = ldsfrag(kS, KP, it * 16 + fr, ks * 32 + fq * 8), qi = ldsfrag(qS, KP, it * 16 + fr, ks * 32 + fq * 8);
                    aK = MFMA16(kj, ki, aK); aQ = MFMA16(kj, qi, aQ); }
                const float gi = gcS[i], bi = btS[i]; f32x4 mm, at;
#pragma unroll
                for (int e = 0; e < 4; ++e) { const int j = j0 + e; const float dec = (i >= j) ? __expf(gi - gcS[j]) : 0.f; mm[e] = (i > j) ? bi * aK[e] * dec : 0.f; at[e] = aQ[e] * dec; }
                *(LAS f32x4*)(Mm + i * 64 + j0) = mm; *(u32x2*)ap = pk4(at);
            } else { *(u32x2*)ap = (u32x2){0u, 0u}; }
        }
        __syncthreads();
        if (wid == 0) {
            float x[64]; int ln = lane; asm volatile("" : "+v"(ln)); int zv = 0; asm volatile("" : "+v"(zv)); const LAS float* Mv = Mm + zv;
#pragma unroll
            for (int i = 0; i < 64; ++i) {
                int dl = i - ln; dl = dl < 0 ? -dl : dl; dl = 1 - dl; dl = dl < 0 ? 0 : dl; float s0 = (float)dl, s1 = 0.f, s2 = 0.f, s3 = 0.f;
#pragma unroll
                for (int j4 = 0; j4 < (i + 3) / 4; ++j4) { const f32x4 m = *(const LAS f32x4*)(Mv + i * 64 + j4 * 4);
                    if (j4 * 4 + 0 < i) s0 -= m[0] * x[j4 * 4 + 0]; if (j4 * 4 + 1 < i) s1 -= m[1] * x[j4 * 4 + 1];
                    if (j4 * 4 + 2 < i) s2 -= m[2] * x[j4 * 4 + 2]; if (j4 * 4 + 3 < i) s3 -= m[3] * x[j4 * 4 + 3]; }
                x[i] = (s0 + s1) + (s2 + s3);
                Ti[i * TP + lane] = f2bf(x[i]);
            }
        }
        __syncthreads();
#pragma unroll
        for (int q = 0; q < 4; ++q) { const int t = wid * 4 + q, pt = t >> 3, dt = t & 7;
            f32x4 aU = {0.f, 0.f, 0.f, 0.f}, aW = {0.f, 0.f, 0.f, 0.f};
#pragma unroll
            for (int ks = 0; ks < 2; ++ks) { const bf16x8 tf = ldsfrag(Ti, TP, pt * 16 + fr, ks * 32 + fq * 8);
                aU = MFMA16(tf, ldsfrag(vbT, TP, dt * 16 + fr, ks * 32 + fq * 8), aU);
                aW = MFMA16(ldsfrag(kbgT, TP, dt * 16 + fr, ks * 32 + fq * 8), tf, aW); }
            *(u32x2*)(UT + (size_t)unit * 8192 + (dt * 16 + fr) * 64 + pt * 16 + fq * 4) = pk4(aU);
            *(u32x2*)(Wc + (size_t)unit * 8192 + (pt * 16 + fr) * 128 + dt * 16 + fq * 4) = pk4(aW);
        }
    }
}

#undef CH_LOAD
__device__ __forceinline__ void gdn_seq_phase(LAS unsigned char* lds, const bf16_t* __restrict__ post, const bf16_t* __restrict__ Wc, const bf16_t* __restrict__ UT, const bf16_t* __restrict__ ATT,
                                              const float* __restrict__ GC, bf16_t* __restrict__ out, const int wv) {
    constexpr int KP = 144, TP = 80, SZK = 64 * KP * 2, SZT = 128 * TP * 2;
    LAS bf16_t* wS = (LAS bf16_t*)lds; LAS bf16_t* qgS = (LAS bf16_t*)(lds + SZK); LAS bf16_t* kdT = (LAS bf16_t*)(lds + 2 * SZK); LAS bf16_t* atS = (LAS bf16_t*)(lds + 2 * SZK + SZT);
    LAS bf16_t* StT = (LAS bf16_t*)(lds + 2 * SZK + SZT + 64 * TP * 2); LAS bf16_t* vnT = (LAS bf16_t*)(lds + 2 * SZK + SZT + 64 * TP * 2 + 32 * KP * 2);
    const int tid = pg8::opq_tid(wv), lane = tid & 63, wid = tid >> 6, fr = lane & 15, fq = lane >> 4;
    const int nh = wid & 1, pr = wid >> 1, dvl = 16 * nh + fr;
    const int G_ = (int)gridDim.x, vc = (G_ % 8 == 0) ? ((int)blockIdx.x % 8) * (G_ / 8) + (int)blockIdx.x / 8 : (int)blockIdx.x;
    for (int item = vc; item < 256; item += G_) {
        const int bh = item >> 2, dq = item & 3, b = bh >> 3, h = bh & 7, dvg = 32 * dq + dvl;
        f32x4 sacc[2];
        __syncthreads();
#pragma unroll
        for (int m = 0; m < 2; ++m) { sacc[m] = (f32x4){0.f, 0.f, 0.f, 0.f}; *(LAS u32x2*)(StT + dvl * KP + (2 * pr + m) * 16 + fq * 4) = (u32x2){0u, 0u}; }
        u32x4 wreg[2], areg; bf16x8 qreg[2], kreg[2]; bf16x4 ureg; float gqr[2], gkr[2], glr;
#define SEQ_LOAD(n_) do { const size_t un_ = (size_t)(bh * 32 + (n_)); const size_t rr_ = (size_t)b * SEQ + (n_) * 64; \
            _Pragma("unroll") for (int i = 0; i < 2; ++i) { const int id = tid + 512 * i; \
                { const int pos = id >> 4, c8 = id & 15; wreg[i] = *(const u32x4*)(Wc + un_ * 8192 + pos * 128 + c8 * 8); qreg[i] = *(const bf16x8*)(post + (rr_ + pos) * 3072 + h * 128 + c8 * 8); gqr[i] = GC[un_ * 64 + pos]; } \
                { const int pos = id & 63, c8 = id >> 6; kreg[i] = *(const bf16x8*)(post + (rr_ + pos) * 3072 + 1024 + h * 128 + c8 * 8); gkr[i] = GC[un_ * 64 + pos]; } } \
            areg = *(const u32x4*)(ATT + un_ * 4096 + (tid >> 3) * 64 + (tid & 7) * 8); glr = GC[un_ * 64 + 63]; \
            ureg = *(const bf16x4*)(UT + un_ * 8192 + dvg * 64 + 16 * pr + fq * 4); } while (0)
        SEQ_LOAD(0);
        for (int n = 0; n < 32; ++n) {
            const int r0 = b * SEQ + n * 64;
            const float glast = glr;
            __syncthreads();
#pragma unroll
            for (int i = 0; i < 2; ++i) { const int id = tid + 512 * i;
                { const int pos = id >> 4, c8 = id & 15;
                  *(LAS u32x4*)(wS + pos * KP + c8 * 8) = wreg[i];
                  const bf16x8 q8 = qreg[i]; const float eg = __expf(gqr[i]);
                  u32x4 w; w.x = pk2(bf2f((unsigned short)q8[0]) * eg, bf2f((unsigned short)q8[1]) * eg); w.y = pk2(bf2f((unsigned short)q8[2]) * eg, bf2f((unsigned short)q8[3]) * eg);
                  w.z = pk2(bf2f((unsigned short)q8[4]) * eg, bf2f((unsigned short)q8[5]) * eg); w.w = pk2(bf2f((unsigned short)q8[6]) * eg, bf2f((unsigned short)q8[7]) * eg);
                  *(LAS u32x4*)(qgS + pos * KP + c8 * 8) = w; }
                { const int pos = id & 63, c8 = id >> 6;
                  const bf16x8 k8 = kreg[i]; const float sc = __expf(glast - gkr[i]);
#pragma unroll
                  for (int e = 0; e < 8; ++e) kdT[(c8 * 8 + e) * TP + pos] = f2bf(bf2f((unsigned short)k8[e]) * sc); } }
            { const int i = tid >> 3, c8 = tid & 7; *(LAS u32x4*)(atS + i * TP + c8 * 8) = areg; }
            const bf16x4 ucur = ureg;
            __syncthreads();
            if (n + 1 < 32) SEQ_LOAD(n + 1);
            bf16x8 sf[4];
#pragma unroll
            for (int ks = 0; ks < 4; ++ks) sf[ks] = ldsfrag(StT, KP, dvl, ks * 32 + fq * 8);
            f32x4 acc = {0.f, 0.f, 0.f, 0.f}, oacc = {0.f, 0.f, 0.f, 0.f};
#pragma unroll
            for (int ks = 0; ks < 4; ++ks) acc = MFMA16(ldsfrag(wS, KP, 16 * pr + fr, ks * 32 + fq * 8), sf[ks], acc);
            { f32x4 vn; for (int e = 0; e < 4; ++e) vn[e] = bf2f((unsigned short)ucur[e]) - acc[e];
              *(LAS u32x2*)(vnT + dvl * TP + 16 * pr + fq * 4) = pk4(vn); }
#pragma unroll
            for (int ks = 0; ks < 4; ++ks) oacc = MFMA16(ldsfrag(qgS, KP, 16 * pr + fr, ks * 32 + fq * 8), sf[ks], oacc);
            __syncthreads();
            bf16x8 vf[2];
#pragma unroll
            for (int ks = 0; ks < 2; ++ks) vf[ks] = ldsfrag(vnT, TP, dvl, ks * 32 + fq * 8);
#pragma unroll
            for (int ks = 0; ks < 2; ++ks) oacc = MFMA16(ldsfrag(atS, TP, 16 * pr + fr, ks * 32 + fq * 8), vf[ks], oacc);
#pragma unroll
            for (int e = 0; e < 4; ++e) out[(size_t)(r0 + 16 * pr + fq * 4 + e) * 1024 + h * 128 + dvg] = f2bf(oacc[e]);
            const float egl = __expf(glast);
#pragma unroll
            for (int m = 0; m < 2; ++m) { const int mt = 2 * pr + m; f32x4 a2 = sacc[m] * egl;
#pragma unroll
                for (int ks = 0; ks < 2; ++ks) a2 = MFMA16(ldsfrag(kdT, TP, mt * 16 + fr, ks * 32 + fq * 8), vf[ks], a2);
                sacc[m] = a2; *(LAS u32x2*)(StT + dvl * KP + mt * 16 + fq * 4) = pk4(a2); }
        }
    }
}
#undef SEQ_LOAD
__device__ __forceinline__ void gdn_fin_phase(bf16_t* __restrict__ Hb, const bf16_t* __restrict__ gate, const float* __restrict__ o_norm, int gw, int NGW, int lane) {
    for (int r = gw; r < T; r += NGW) {
        bf16_t* hp = Hb + (size_t)r * 1024 + lane * 16; const bf16_t* gp = gate + (size_t)r * 1024 + lane * 16;
        const bf16x8 o0 = *(const bf16x8*)hp, o1 = *(const bf16x8*)(hp + 8), g0 = *(const bf16x8*)gp, g1 = *(const bf16x8*)(gp + 8);
        float ov[16]; float ss = 0.f;
#pragma unroll
        for (int e = 0; e < 8; ++e) { ov[e] = bf2f((unsigned short)o0[e]); ov[8 + e] = bf2f((unsigned short)o1[e]); }
#pragma unroll
        for (int e = 0; e < 16; ++e) ss += ov[e] * ov[e];
        ss += shx(ss, 1, lane); ss += shx(ss, 2, lane); ss += shx(ss, 4, lane);
        const float rstd = rsqrtf(ss * (1.f / 128.f) + EPS);
        const float* gn = o_norm + (lane & 7) * 16;
        u32x4 w0, w1; float res[16];
#pragma unroll
        for (int e = 0; e < 16; ++e) { const float gt = bf2f((unsigned short)(e < 8 ? g0[e] : g1[e - 8])); res[e] = ov[e] * rstd * gn[e] * silu_f(gt); }
        w0.x = pk2(res[0], res[1]); w0.y = pk2(res[2], res[3]); w0.z = pk2(res[4], res[5]); w0.w = pk2(res[6], res[7]);
        w1.x = pk2(res[8], res[9]); w1.y = pk2(res[10], res[11]); w1.z = pk2(res[12], res[13]); w1.w = pk2(res[14], res[15]);
        *(u32x4*)hp = w0; *(u32x4*)(hp + 8) = w1;
    }
}
__device__ __forceinline__ void mla_mid_phase(const float* __restrict__ z, const float* __restrict__ qn, const float* __restrict__ kvn, const float* __restrict__ cosb, const float* __restrict__ sinb,
                                              bf16_t* __restrict__ cqn, bf16_t* __restrict__ ckvn, bf16_t* __restrict__ krope, int gw, int NGW, int lane) {
    for (int r = gw; r < T; r += NGW) {
        const float* zr = z + (size_t)r * 704;
        f32x2 a[3]; float s = 0.f;
#pragma unroll
        for (int i = 0; i < 3; ++i) { a[i] = *(const f32x2*)(zr + 2 * lane + 128 * i); s += a[i][0] * a[i][0] + a[i][1] * a[i][1]; }
        float rstd = rsqrtf(wave_sum(s, lane) * (1.f / 384.f) + EPS);
#pragma unroll
        for (int i = 0; i < 3; ++i) { const f32x2 gg = *(const f32x2*)(qn + 2 * lane + 128 * i); *(unsigned*)(cqn + (size_t)r * 384 + 2 * lane + 128 * i) = pk2(a[i][0] * rstd * gg[0], a[i][1] * rstd * gg[1]); }
        f32x2 c[2]; s = 0.f;
#pragma unroll
        for (int i = 0; i < 2; ++i) { c[i] = *(const f32x2*)(zr + 384 + 2 * lane + 128 * i); s += c[i][0] * c[i][0] + c[i][1] * c[i][1]; }
        rstd = rsqrtf(wave_sum(s, lane) * (1.f / 256.f) + EPS);
#pragma unroll
        for (int i = 0; i < 2; ++i) { const f32x2 gg = *(const f32x2*)(kvn + 2 * lane + 128 * i); *(unsigned*)(ckvn + (size_t)r * 256 + 2 * lane + 128 * i) = pk2(c[i][0] * rstd * gg[0], c[i][1] * rstd * gg[1]); }
        const float v = zr[640 + lane], pv = shx(v, 32, lane); const int i = lane & 31; const float cs = cosb[(size_t)r * 32 + i], sn = sinb[(size_t)r * 32 + i];
        const float outv = (lane < 32) ? (v * cs - pv * sn) : (v * cs + pv * sn);
        krope[(size_t)r * 64 + lane] = f2bf(outv);
    }
}
__device__ __forceinline__ void sc_mid_phase(const bf16_t* __restrict__ z, const float* __restrict__ cw, bf16_t* __restrict__ y, int gtid, int NT) {
    for (int it = gtid; it < T * 128; it += NT) {
        const int r = it >> 7, c8 = it & 127, t = r & (SEQ - 1), col = c8 * 8;
        float acc[8];
#pragma unroll
        for (int e = 0; e < 8; ++e) acc[e] = 0.f;
#pragma unroll
        for (int j = 0; j < 3; ++j) { if (t - 2 + j >= 0) { const bf16_t* zr = z + (size_t)(r - 2 + j) * 3072 + col;
            const bf16x8 cg8 = *(const bf16x8*)(zr + 1024), u8 = *(const bf16x8*)(zr + 2048); const f32x4 w0 = *(const f32x4*)(cw + j * 1024 + col), w1 = *(const f32x4*)(cw + j * 1024 + col + 4);
#pragma unroll
            for (int e = 0; e < 8; ++e) acc[e] += (e < 4 ? w0[e] : w1[e - 4]) * (bf2f((unsigned short)cg8[e]) * bf2f((unsigned short)u8[e])); } }
        const bf16x8 b8 = *(const bf16x8*)(z + (size_t)r * 3072 + col);
        u32x4 o; o.x = pk2(acc[0] * bf2f((unsigned short)b8[0]), acc[1] * bf2f((unsigned short)b8[1])); o.y = pk2(acc[2] * bf2f((unsigned short)b8[2]), acc[3] * bf2f((unsigned short)b8[3]));
        o.z = pk2(acc[4] * bf2f((unsigned short)b8[4]), acc[5] * bf2f((unsigned short)b8[5])); o.w = pk2(acc[6] * bf2f((unsigned short)b8[6]), acc[7] * bf2f((unsigned short)b8[7]));
        *(u32x4*)(y + (size_t)r * 1024 + col) = o;
    }
}
struct Params { const float* in[28]; float* out; unsigned char* ws; int L, pad; };
enum { PH_PREP = 0, PH_IN_MLA, PH_IN_GDN, PH_IN_SC, PH_MLA_MID, PH_MLA_UP, PH_MLA_ATTN, PH_GDN_CONV, PH_GDN_CHUNK, PH_GDN_SEQ, PH_SC_MID, PH_OPROJ,
       PH_XNORM, PH_XQ, PH_XATTN, PH_XO, PH_MNORM, PH_MUP, PH_MDOWN, PH_FINAL, PH_COUNT };

template <int PH> __device__ __forceinline__ void run_phase(const Params& p, const int L, LAS unsigned char* lds, const int wv) {
    const int tid = pg8::opq_tid(wv), lane = tid & 63, wid = tid >> 6;
    int G_ = gridDim.x; asm volatile("" : "+s"(G_));
    const int G = G_, gw = blockIdx.x * 8 + wid, NGW = G * 8, gtid = blockIdx.x * 512 + tid, NT = G * 512;
    unsigned char* ws = p.ws;
    float* X = p.out;
    bf16_t* H = (bf16_t*)p.out;     bf16_t* MEMN = (bf16_t*)(ws + WS_MEMN); bf16_t* MK = (bf16_t*)(ws + WS_MK); bf16_t* MVT = (bf16_t*)(ws + WS_MVT);
    float* COS = (float*)(ws + WS_COS); float* SIN = (float*)(ws + WS_SIN);
    bf16_t* XB = (bf16_t*)(ws + WS_H);   float* SSP = (float*)(ws + WS_AR + 160 * MiB);
    bf16_t* Wmixin = (bf16_t*)(ws + W_MIXIN); bf16_t* Wuq = (bf16_t*)(ws + W_UQ); bf16_t* Wukv = (bf16_t*)(ws + W_UKV); bf16_t* Wmixo = (bf16_t*)(ws + W_MIXO);
    bf16_t* Wxq = (bf16_t*)(ws + W_XQ); bf16_t* Wxkv = (bf16_t*)(ws + W_XKV); bf16_t* Wxo = (bf16_t*)(ws + W_XO); bf16_t* W1 = (bf16_t*)(ws + W_1); bf16_t* W2 = (bf16_t*)(ws + W_2);
    const int kind = L % 3, j = L / 3;
    if constexpr (PH == PH_PREP) {
        const float* xin = p.in[0]; const float* mem = p.in[1]; const int* positions = (const int*)p.in[2];
        LAS float* scr = (LAS float*)(lds + wid * 16384);
        if (kind == 0) {
            conv_w(p.in[3] + (size_t)j * 1024 * 704, 1024, 704, 768, Wmixin, scr, gw, NGW, lane, p.in[18] + L * D);
            conv_w(p.in[6] + (size_t)j * 384 * 1536, 384, 1536, 1536, Wuq, scr, gw, NGW, lane, p.in[4] + j * 384);
            conv_w(p.in[7] + (size_t)j * 256 * 2048, 256, 2048, 2048, Wukv, scr, gw, NGW, lane, p.in[5] + j * 256);
            conv_w(p.in[8] + (size_t)j * 1024 * 1024, 1024, 1024, 1024, Wmixo, scr, gw, NGW, lane);
        } else if (kind == 1) {
            conv_w(p.in[9], 1024, 4112, 4352, Wmixin, scr, gw, NGW, lane, p.in[18] + L * D);
            conv_w(p.in[14], 1024, 1024, 1024, Wmixo, scr, gw, NGW, lane);
        } else {
            conv_w(p.in[15], 1024, 3072, 3072, Wmixin, scr, gw, NGW, lane, p.in[18] + L * D);
            conv_w(p.in[17], 1024, 1024, 1024, Wmixo, scr, gw, NGW, lane);
        }
        conv_w(p.in[21] + (size_t)L * 1024 * 1024, 1024, 1024, 1024, Wxq, scr, gw, NGW, lane, p.in[19] + L * D);
        conv_w(p.in[22] + (size_t)L * 1024 * 2048, 1024, 2048, 2048, Wxkv, scr, gw, NGW, lane);
        conv_w(p.in[23] + (size_t)L * 1024 * 1024, 1024, 1024, 1024, Wxo, scr, gw, NGW, lane);
        conv_w(p.in[24] + (size_t)L * 1024 * 4096, 1024, 4096, 4096, W1, scr, gw, NGW, lane, p.in[20] + L * D);
        conv_w(p.in[25] + (size_t)L * 4096 * 1024, 4096, 1024, 1024, W2, scr, gw, NGW, lane);
        if (L == 0) {
            for (int r = gw; r < T; r += NGW) init_row(xin + (size_t)r * D, X + (size_t)r * D, XB + (size_t)r * D, SSP + (size_t)r * 16, lane);
            for (int r = gw; r < 2048; r += NGW) rms_row(mem + (size_t)r * D, p.in[26], MEMN + (size_t)r * D, nullptr, lane);
            for (int i = gtid; i < T * 32; i += NT) { const int r = i >> 5, k = i & 31; const float inv = exp2f(-(float)k * (13.287712379549449f / 32.f));
                const float ang = (float)positions[r] * inv; double rev = (double)ang * 0.15915494309189535; rev -= rint(rev); const float rr = (float)(rev * 6.283185307179586);
                COS[i] = cosf(rr); SIN[i] = sinf(rr); }
        }
    } else if constexpr (PH == PH_IN_MLA) {
        run_gemm(lds, XB, Wmixin, T, 768, 1024, FMlaIn{(bf16_t*)(ws + A_CQN), (bf16_t*)(ws + A_CKVN), (float*)(ws + A_Z), SSP, (float*)(ws + A_Z + 8 * MiB)}, wv);
        run_gemm(lds, MEMN, Wxkv, 2048, 2048, 1024, FMemKV{MK, MVT}, wv, 64);
    } else if constexpr (PH == PH_IN_GDN) {
        run_gemm(lds, XB, Wmixin, T, 4352, 1024, FGdnIn{(bf16_t*)(ws + G_PRE), (bf16_t*)(ws + G_GATE), (float*)(ws + G_LOGIT), SSP}, wv);
        run_gemm(lds, MEMN, Wxkv, 2048, 2048, 1024, FMemKV{MK, MVT}, wv, 192);
    } else if constexpr (PH == PH_IN_SC) {
        run_gemm(lds, XB, Wmixin, T, 3072, 1024, FBf16S{(bf16_t*)(ws + WS_AR), 3072, SSP}, wv);
        run_gemm(lds, MEMN, Wxkv, 2048, 2048, 1024, FMemKV{MK, MVT}, wv, 0);
    } else if constexpr (PH == PH_MLA_MID) {
        mla_mid_phase((const float*)(ws + A_Z), p.in[4] + j * 384, p.in[5] + j * 256, COS, SIN, (bf16_t*)(ws + A_CQN), (bf16_t*)(ws + A_CKVN), (bf16_t*)(ws + A_KROPE), gw, NGW, lane);
    } else if constexpr (PH == PH_MLA_UP) {
#ifndef UPSEL
#define UPSEL 3
#endif
        { const float* kr = (const float*)(ws + A_Z); bf16_t* kro = (bf16_t*)(ws + A_KROPE);
          for (int i = gtid; i < T * 32; i += NT) { const int r = i >> 5, k = i & 31; const float x1 = kr[(size_t)r * 64 + k], x2 = kr[(size_t)r * 64 + 32 + k], cs = COS[i], sn = SIN[i];
              kro[(size_t)r * 64 + k] = f2bf(x1 * cs - x2 * sn); kro[(size_t)r * 64 + 32 + k] = f2bf(x2 * cs + x1 * sn); } }
        run_gemm(lds, (const bf16_t*)(ws + A_CQN), Wuq, T, 1536, 384, FUq{(bf16_t*)(ws + A_Q), (const float*)(ws + A_Z + 8 * MiB)}, wv);
        run_gemm(lds, (const bf16_t*)(ws + A_CKVN), Wukv, T, 2048, 256, FUkv{(bf16_t*)(ws + A_KNOPE), (bf16_t*)(ws + A_VT), (const float*)(ws + A_Z + 8 * MiB)}, wv);
    } else if constexpr (PH == PH_MLA_ATTN) {
        const bf16_t* Qb = (const bf16_t*)(ws + A_Q); const bf16_t* Kn = (const bf16_t*)(ws + A_KNOPE); const bf16_t* Kr = (const bf16_t*)(ws + A_KROPE); const bf16_t* Vt = (const bf16_t*)(ws + A_VT);
        const int vc = (G % 8 == 0) ? ((int)blockIdx.x % 8) * (G / 8) + (int)blockIdx.x / 8 : (int)blockIdx.x;
        for (int item = vc; item < 256; item += G) {
            const int bh = item >> 2, s = item & 3, b = bh >> 3, h = bh & 7;
            for (int pass = 0; pass < 2; ++pass) { const int qb = pass ? 7 - s : s; const size_t row0 = (size_t)b * SEQ + qb * 256;
                attn_unit<128, 64, 128, 2, true, true>(lds, Qb + row0 * 1536 + h * 192, 1536, Kn + (size_t)b * SEQ * 1024 + h * 128, 1024, Kr + (size_t)b * SEQ * 64, 64,
                    Vt + (size_t)(b * 8 + h) * 128 * 2048, 64, (qb + 1) * 4, qb * 256, H + row0 * 1024 + h * 128, 1024, 0.07216878364870322f * 1.4426950408889634f, COS + row0 * 32, SIN + row0 * 32, wv); }
        }
    } else if constexpr (PH == PH_GDN_CONV) {
        gdn_conv_phase((const bf16_t*)(ws + G_PRE), (bf16_t*)(ws + G_POST), p.in[10], (const float*)(ws + G_LOGIT), p.in[11], p.in[12], (float*)(ws + G_BETA), (float*)(ws + G_G), gw, NGW, lane, gtid, NT);
    } else if constexpr (PH == PH_GDN_CHUNK) {
        gdn_chunk_phase(lds, (const bf16_t*)(ws + G_POST), (const float*)(ws + G_BETA), (const float*)(ws + G_G), (bf16_t*)(ws + G_W), (bf16_t*)(ws + G_UT), (bf16_t*)(ws + G_ATT), (float*)(ws + G_GC), wv);
    } else if constexpr (PH == PH_GDN_SEQ) {
        gdn_seq_phase(lds, (const bf16_t*)(ws + G_POST), (const bf16_t*)(ws + G_W), (const bf16_t*)(ws + G_UT), (const bf16_t*)(ws + G_ATT), (const float*)(ws + G_GC), H, wv);
    } else if constexpr (PH == PH_SC_MID) {
        sc_mid_phase((const bf16_t*)(ws + WS_AR), p.in[16], H, gtid, NT);
    } else if constexpr (PH == PH_OPROJ) {
        run_gemm(lds, H, Wmixo, T, 1024, 1024, FResid{X, XB, SSP}, wv);
    } else if constexpr (PH == PH_XNORM) {
        gdn_fin_phase(H, (const bf16_t*)(ws + G_GATE), p.in[13], gw, NGW, lane);
    } else if constexpr (PH == PH_XQ) {
        bf16_t* Qb = (bf16_t*)(ws + WS_AR);
        run_gemm(lds, XB, Wxq, T, 1024, 1024, FBf16S{Qb, 1024, SSP}, wv);
        asm volatile("s_waitcnt vmcnt(0)" ::: "memory"); __syncthreads();
        if (tid == 0) { __builtin_amdgcn_fence(__ATOMIC_ACQUIRE, "agent"); asm volatile("s_waitcnt vmcnt(0)" ::: "memory"); }
        __syncthreads();
        pg8::StaticOrder S; S.init(T, 1024, G, (int)blockIdx.x); pg8::Unit u;
        for (int ui = 0; S.next(ui, u); ++ui) {
            const int b = u.pm >> 3, h = u.pn;
            for (int half = 0; half < 2; ++half) { const size_t row0 = (size_t)u.pm * 256 + half * 128;
                attn_unit<256, 0, 256, 1, false, false>(lds, Qb + row0 * 1024 + h * 256, 1024, MK + (size_t)b * 256 * 1024 + h * 256, 1024, MK, 0,
                    MVT + (size_t)(b * 4 + h) * 256 * 256, 64, 4, 0, H + row0 * 1024 + h * 256, 1024, 0.0625f * 1.4426950408889634f, COS, SIN, wv); }
        }
    } else if constexpr (PH == PH_XATTN) {
        const bf16_t* Qb = (const bf16_t*)(ws + WS_AR);
        for (int item = blockIdx.x; item < 512; item += G) { const int b = item >> 6, h = (item >> 4) & 3, qb = item & 15; const size_t row0 = (size_t)b * SEQ + qb * 128;
            attn_unit<256, 0, 256, 1, false, false>(lds, Qb + row0 * 1024 + h * 256, 1024, MK + (size_t)b * 256 * 1024 + h * 256, 1024, MK, 0,
                MVT + (size_t)(b * 4 + h) * 256 * 256, 64, 4, 0, H + row0 * 1024 + h * 256, 1024, 0.0625f * 1.4426950408889634f, COS, SIN, wv); }
    } else if constexpr (PH == PH_XO) {
        run_gemm(lds, H, Wxo, T, 1024, 1024, FResid{X, XB, SSP}, wv);
    } else if constexpr (PH == PH_MNORM) {
        const f32x4* src = (const f32x4*)(ws + WS_AR); f32x4* dst = (f32x4*)(X + (size_t)(T / 2) * D);
        for (int i = gtid; i < (T / 2) * D / 4; i += NT) dst[i] = src[i];
    } else if constexpr (PH == PH_MUP) {
        run_gemm(lds, XB, W1, T, 4096, 1024, FRelu2{(bf16_t*)(ws + WS_AR), 4096, SSP}, wv);
    } else if constexpr (PH == PH_MDOWN) {
        run_gemm(lds, (const bf16_t*)(ws + WS_AR), W2, T, 1024, 4096, FResid{X, XB, SSP}, wv);
    } else if constexpr (PH == PH_FINAL) {
        for (int r = gw; r < T; r += NGW) rms_row_f32(XB + (size_t)r * D, X + (size_t)r * D, p.in[27], lane);
    }
}

#ifndef N_LAUNCH_SPLIT
#define N_LAUNCH_SPLIT 1
#endif
#if N_LAUNCH_SPLIT
template <int PH> __global__ void __launch_bounds__(512) k_phase(Params p) {
    extern __shared__ __attribute__((aligned(16))) unsigned char lds_raw[];
    run_phase<PH>(p, p.L, (LAS unsigned char*)lds_raw, __builtin_amdgcn_readfirstlane((int)threadIdx.x >> 6));
}
template <int PH> static void launch_phase(Params p, int L, int grid, hipStream_t stream) {
    static bool attr = false;
    if (!attr) { (void)hipFuncSetAttribute((const void*)k_phase<PH>, hipFuncAttributeMaxDynamicSharedMemorySize, LDS_BYTES); attr = true; }
    p.L = L;
    hipLaunchKernelGGL(k_phase<PH>, dim3(grid), dim3(512), LDS_BYTES, stream, p);
}
#else
#ifndef PH_MASK
#define PH_MASK 0xFFFFFF
#endif
#ifdef PROBE_A
#define PROBE_STAMP(PH) do { if (blockIdx.x == 0 && wv == 0 && pg8::opq_tid(0) == 0) { unsigned long long* tsw = (unsigned long long*)(p.ws + 32768); const unsigned long long now = __builtin_amdgcn_s_memrealtime(); \
    const unsigned long long dt_ = now - tsw[0]; tsw[0] = now; if ((PROBE_A >> PH) & 1) tsw[1] += dt_; if ((PROBE_B >> PH) & 1) tsw[2] += dt_; } } while (0)
#else
#define PROBE_STAMP(PH) do {} while (0)
#endif
#ifndef REP_MASK
#define REP_MASK 0
#endif
#define RUN(PH) do { if constexpr ((REP_MASK >> PH) & 1) { run_phase<PH>(p, L, lds, wv); xcd_barrier(bar); } if constexpr ((PH_MASK >> PH) & 1) run_phase<PH>(p, L, lds, wv); xcd_barrier(bar); PROBE_STAMP(PH); } while (0)
template <int L> __device__ __forceinline__ void run_layer(const Params& p, LAS unsigned char* lds, cg::grid_group& grid, const XcdBarrier& bar, const int wv) {
    constexpr int kind = L % 3;
    if constexpr (L != 0) RUN(PH_PREP);
    if constexpr (kind == 0) { RUN(PH_IN_MLA); RUN(PH_MLA_UP); RUN(PH_MLA_ATTN); }
    else if constexpr (kind == 1) { RUN(PH_IN_GDN); RUN(PH_GDN_CONV); RUN(PH_GDN_CHUNK); RUN(PH_GDN_SEQ); RUN(PH_XNORM); }
    else { RUN(PH_IN_SC); RUN(PH_SC_MID); }
    RUN(PH_OPROJ); RUN(PH_XQ); RUN(PH_XO); RUN(PH_MUP); RUN(PH_MDOWN);
}
#undef RUN
__global__ void __launch_bounds__(512) mega(Params p) {
    extern __shared__ __attribute__((aligned(16))) unsigned char lds_raw[];
    LAS unsigned char* lds = (LAS unsigned char*)lds_raw;
    cg::grid_group grid = cg::this_grid();
    const int wv = __builtin_amdgcn_readfirstlane((int)threadIdx.x >> 6);
    if (threadIdx.x < 2) ((volatile LAS unsigned*)(lds + LDS_BYTES - 64))[threadIdx.x] = 0u;
    if (blockIdx.x == 0) { unsigned* bw = (unsigned*)p.ws; for (int i = threadIdx.x; i < XCD_BAR_WORDS; i += 512) bw[i] = 0u; }
    __syncthreads();
    run_phase<PH_PREP>(p, 0, lds, wv);
    grid.sync();
    const XcdBarrier bar = xcd_barrier_post((unsigned*)p.ws, (volatile LAS unsigned*)(lds + LDS_BYTES - 64));
    run_layer<0>(p, lds, grid, bar, wv); run_layer<1>(p, lds, grid, bar, wv); run_layer<2>(p, lds, grid, bar, wv); run_layer<3>(p, lds, grid, bar, wv);
    run_phase<PH_FINAL>(p, 3, lds, wv);
#ifdef PROBE_A
    xcd_barrier(bar);
    if (blockIdx.x == 0) { const unsigned long long* tsw = (const unsigned long long*)(p.ws + 32768); const float a = (float)tsw[1] * 0.01f, b = (float)tsw[2] * 0.01f;
        const int t_ = pg8::opq_tid(wv); for (int i = t_; i < 10000; i += 512) p.out[4096 + i] = b; if (t_ == 0) p.out[0] = a; }
#endif
}
#endif

extern "C" void kernel_launch(void* const* d_in, const int* in_sizes, int n_in, void* d_out, int out_size, void* d_ws, size_t ws_size, hipStream_t stream) {
    static int grid_blocks = 0;
    if (!grid_blocks) {
        if (n_in != 28 || ws_size < WS_END) { fprintf(stderr, "kernel_launch: unexpected n_in %d / ws_size %zu (need %zu)\n", n_in, ws_size, (size_t)WS_END); grid_blocks = -1; return; }
        int dev = 0, cus = 0;
        (void)hipGetDevice(&dev);
        (void)hipDeviceGetAttribute(&cus, hipDeviceAttributeMultiprocessorCount, dev);
        if (cus < 1) cus = 256;
#if N_LAUNCH_SPLIT
        grid_blocks = cus;
#else
        int per_cu = 0;
        (void)hipFuncSetAttribute((const void*)mega, hipFuncAttributeMaxDynamicSharedMemorySize, LDS_BYTES);
        (void)hipOccupancyMaxActiveBlocksPerMultiprocessor(&per_cu, (const void*)mega, 512, LDS_BYTES);
        if (per_cu < 1) per_cu = 1;
        grid_blocks = cus * per_cu;
#endif
        (void)hipGetLastError();
    }
    if (grid_blocks < 0) return;
    Params p{};
    for (int i = 0; i < 28; ++i) p.in[i] = (const float*)d_in[i];
    p.out = (float*)d_out; p.ws = (unsigned char*)d_ws;
#if N_LAUNCH_SPLIT
    const int g = grid_blocks;
    for (int L = 0; L < 4; ++L) {
        const int kind = L % 3;
        launch_phase<PH_PREP>(p, L, g, stream);
        if (kind == 0) { launch_phase<PH_IN_MLA>(p, L, g, stream); launch_phase<PH_MLA_UP>(p, L, g, stream); launch_phase<PH_MLA_ATTN>(p, L, g, stream); }
        else if (kind == 1) { launch_phase<PH_IN_GDN>(p, L, g, stream); launch_phase<PH_GDN_CONV>(p, L, g, stream); launch_phase<PH_GDN_CHUNK>(p, L, g, stream); launch_phase<PH_GDN_SEQ>(p, L, g, stream); launch_phase<PH_XNORM>(p, L, g, stream); }
        else { launch_phase<PH_IN_SC>(p, L, g, stream); launch_phase<PH_SC_MID>(p, L, g, stream); }
        launch_phase<PH_OPROJ>(p, L, g, stream); launch_phase<PH_XQ>(p, L, g, stream);
        launch_phase<PH_XO>(p, L, g, stream); launch_phase<PH_MUP>(p, L, g, stream); launch_phase<PH_MDOWN>(p, L, g, stream);
    }
    launch_phase<PH_FINAL>(p, 3, g, stream);
#else
    void* args[] = {&p};
    hipError_t e = hipLaunchCooperativeKernel((const void*)mega, dim3(grid_blocks), dim3(512), args, LDS_BYTES, stream);
    if (e != hipSuccess) fprintf(stderr, "cooperative launch failed: %s (grid %d)\n", hipGetErrorString(e), grid_blocks);
#endif
}
```

```cpp
#include <hip/hip_runtime.h>
#include <hip/hip_cooperative_groups.h>
#include <cstdio>
#include <cstdint>
namespace cg = cooperative_groups;
namespace pg8 {
#define PG8_LAS __attribute__((address_space(3)))
typedef unsigned short bf16_t;
typedef short bf16x8 __attribute__((ext_vector_type(8)));
typedef float f32x4 __attribute__((ext_vector_type(4)));
typedef unsigned u32x4 __attribute__((ext_vector_type(4)));
constexpr int BM = 256, BK = 64, HALF = 128, HTB = HALF * BK * 2  , STAGE_BYTES = 8 * HTB, NXCD = 8, WGM = 8;

__host__ __device__ __forceinline__ int lds_byte(int r, int c) { const int st = (r >> 4) * 2 + (c >> 5), rr = r & 15, cc = c & 31, ob = rr * 64 + cc * 2; return st * 1024 + (ob ^ (((ob >> 9) & 1) << 5)); }
__host__ __device__ __forceinline__ void stage_rc(int b, int& R, int& C) { const int st = b / 1024, sb = b % 1024, swz = sb ^ (((sb >> 9) & 1) << 5); R = (st >> 1) * 16 + swz / 64; C = (st & 1) * 32 + (swz % 64) / 2; }
__host__ __device__ __forceinline__ int perm32(int rho) { const int n = rho >> 4, i = rho & 15; return 8 * (i >> 2) + 4 * n + (i & 3); }

struct Unit { int pm, pn; };
struct Gemm { const bf16_t* A; const bf16_t* Bt; int M, N, K; };

struct StaticOrder {
    int nM, nN, nwg, G, c;
    __host__ __device__ void init(int M, int N, int G_, int c_) { nM = M / BM; nN = N / BM; nwg = nM * nN; G = G_; c = c_; }
    __host__ __device__ bool next(int i, Unit& u) const {
        const long L = (long)i * G + c; if (L >= nwg) return false;
        int wgid = (int)L; { const int q = nwg / NXCD, r = nwg % NXCD, xcd = wgid % NXCD, off = wgid / NXCD; wgid = (xcd < r ? xcd * (q + 1) : r * (q + 1) + (xcd - r) * q) + off; }
        const int nig = WGM * nN, gid = wgid / nig, fm = gid * WGM, gsz = (nM - fm) < WGM ? (nM - fm) : WGM;
        u.pm = fm + ((wgid % nig) % gsz); u.pn = (wgid % nig) / gsz; return true;
    }
    __device__ __forceinline__ void a_ready(const Unit&) const {}
    __device__ __forceinline__ void done(const Unit&) const {}
};

__device__ __forceinline__ unsigned cvt_pk_bf16(float lo, float hi) { unsigned r; asm volatile("v_cvt_pk_bf16_f32 %0, %1, %2" : "=v"(r) : "v"(lo), "v"(hi)); return r; }
__device__ __forceinline__ int opq_tid(int wv) { int l; asm volatile("v_mbcnt_lo_u32_b32 %0, -1, 0\n\tv_mbcnt_hi_u32_b32 %0, -1, %0" : "=v"(l)); return wv * 64 + l; }
template <class Epi, class Sched, bool ALIGN_EPI = false, bool SP2 = false>
__device__ __forceinline__ void gemm_phase(PG8_LAS unsigned char* lds, const Gemm g, const Sched& S, const Epi& E, const int wv) {
    const int tid = opq_tid(wv), wid = __builtin_amdgcn_readfirstlane(tid >> 6), lane = tid & 63, wr = wid >> 2, wc = wid & 3, fr = lane & 15, fq = lane >> 4;
    const int K = g.K, nt = K / BK;
    unsigned voffA[2], voffB[2];
#pragma unroll
    for (int i = 0; i < 2; ++i) { int R, C; stage_rc(tid * 16 + i * 8192, R, C); const int Rb = Epi::PERM ? ((R & ~31) + perm32(R & 31)) : R;
        voffA[i] = (unsigned)(R * K + C) * 2u; voffB[i] = (unsigned)(Rb * K + C) * 2u; }
    const size_t kstep = (size_t)(BK * 2);
    const size_t hstep = (size_t)HALF * K * 2;
    const size_t tstep = 2 * hstep;
    const unsigned ldsw = (unsigned)wid * 1024u;
    const int aoff = lds_byte(wr * 64 + fr, fq * 8), boff = lds_byte(wc * 32 + fr, fq * 8);
#define PG8_SA(b, h) (((b) * 2 + (h)) * HTB)
#define PG8_SB(b, h) ((4 + (b) * 2 + (h)) * HTB)
#define PG8_STAGE(bufoff, gbase, voff) do { _Pragma("unroll") for (int _i = 0; _i < 2; ++_i) \
        __builtin_amdgcn_global_load_lds((const unsigned*)((const char*)(gbase) + (voff)[_i]), (PG8_LAS unsigned*)(lds + (bufoff) + ldsw + _i * 8192), 16, 0, 0); } while (0)
#define PG8_LDA(dst, b, h) do { _Pragma("unroll") for (int m = 0; m < 4; ++m) _Pragma("unroll") for (int k = 0; k < 2; ++k) dst[m][k] = *(const PG8_LAS bf16x8*)(lds + PG8_SA(b, h) + aoff + m * 2048 + k * 1024); } while (0)
#define PG8_LDB(dst, b, h) do { _Pragma("unroll") for (int n = 0; n < 2; ++n) _Pragma("unroll") for (int k = 0; k < 2; ++k) dst[n][k] = *(const PG8_LAS bf16x8*)(lds + PG8_SB(b, h) + boff + n * 2048 + k * 1024); } while (0)
#define PG8_MMA(ai, bj, At, Bt) do { __builtin_amdgcn_s_setprio(1); _Pragma("unroll") for (int m = 0; m < 4; ++m) _Pragma("unroll") for (int n = 0; n < 2; ++n) _Pragma("unroll") for (int k = 0; k < 2; ++k) \
        acc[ai][bj][m][n] = __builtin_amdgcn_mfma_f32_16x16x32_bf16(Bt[n][k], At[m][k], acc[ai][bj][m][n], 0, 0, 0); __builtin_amdgcn_s_setprio(0); } while (0)
#define PG8_WAIT_V(n) asm volatile("s_waitcnt vmcnt(" #n ")" ::: "memory")
#define PG8_WAIT_L(n) asm volatile("s_waitcnt lgkmcnt(" #n ")" ::: "memory")
#define PG8_BAR __builtin_amdgcn_s_barrier()
#define PG8_SCHED __builtin_amdgcn_sched_barrier(0)
    Unit cur, nxt; int ui = 0;
    if (!S.next(0, cur)) return;
    f32x4 acc[2][2][4][2];
#pragma unroll
    for (int a = 0; a < 2; ++a)
#pragma unroll
        for (int b = 0; b < 2; ++b)
#pragma unroll
            for (int m = 0; m < 4; ++m)
#pragma unroll
                for (int n = 0; n < 2; ++n) acc[a][b][m][n] = (f32x4){0.f, 0.f, 0.f, 0.f};
    bf16x8 At[4][2], B0[2][2], B1[2][2];
    const char* cA = (const char*)g.A + (size_t)cur.pm * tstep; const char* cB = (const char*)g.Bt + (size_t)cur.pn * tstep;
    S.a_ready(cur);
    if constexpr (SP2) {
        PG8_STAGE(PG8_SB(0, 0), cB, voffB); PG8_STAGE(PG8_SB(0, 1), cB + hstep, voffB); PG8_STAGE(PG8_SA(0, 0), cA, voffA); PG8_STAGE(PG8_SA(0, 1), cA + hstep, voffA);
        if (wr == 1) PG8_BAR;
        PG8_WAIT_V(2); PG8_BAR;
        PG8_STAGE(PG8_SB(1, 0), cB + kstep, voffB); PG8_STAGE(PG8_SA(1, 0), cA + kstep, voffA); PG8_STAGE(PG8_SB(1, 1), cB + hstep + kstep, voffB);
        PG8_WAIT_V(6); PG8_BAR;
    } else {
        PG8_STAGE(PG8_SB(0, 0), cB, voffB); PG8_STAGE(PG8_SA(0, 0), cA, voffA); PG8_STAGE(PG8_SB(0, 1), cB + hstep, voffB); PG8_STAGE(PG8_SA(0, 1), cA + hstep, voffA);
        if (wr == 1) PG8_BAR;
        PG8_WAIT_V(4); PG8_BAR;
        PG8_STAGE(PG8_SB(1, 0), cB + kstep, voffB); PG8_STAGE(PG8_SA(1, 0), cA + kstep, voffA); PG8_STAGE(PG8_SB(1, 1), cB + hstep + kstep, voffB);
        PG8_WAIT_V(6); PG8_BAR;
    }
    for (;;) {
        const bool has_next = S.next(ui + 1, nxt);
        const char* nA = has_next ? (const char*)g.A + (size_t)nxt.pm * tstep : cA; const char* nB = has_next ? (const char*)g.Bt + (size_t)nxt.pn * tstep : cB;
        for (int t = 0; t < nt; t += 2) {
            const bool last = (t == nt - 2);
            const char* a1 = cA + (size_t)(t + 1) * kstep;
            const char* a2 = last ? nA : cA + (size_t)(t + 2) * kstep; const char* b2 = last ? nB : cB + (size_t)(t + 2) * kstep;
            const char* a3 = a2 + kstep; const char* b3 = b2 + kstep;
            if (last && has_next) S.a_ready(nxt);
            if constexpr (SP2) {
            PG8_LDB(B0, 0, 0); PG8_LDB(B1, 0, 1); PG8_SCHED; PG8_LDA(At, 0, 0); PG8_STAGE(PG8_SA(1, 1), a1 + hstep, voffA);
            PG8_WAIT_V(8); PG8_WAIT_L(0); PG8_BAR; PG8_MMA(0, 0, At, B0); PG8_MMA(0, 1, At, B1); PG8_BAR; PG8_SCHED;
            PG8_LDA(At, 0, 1); PG8_STAGE(PG8_SB(0, 0), b2, voffB); PG8_STAGE(PG8_SB(0, 1), b2 + hstep, voffB); PG8_STAGE(PG8_SA(0, 0), a2, voffA);
            PG8_WAIT_V(8); PG8_WAIT_L(0); PG8_BAR; PG8_MMA(1, 0, At, B0); PG8_MMA(1, 1, At, B1); PG8_BAR; PG8_SCHED;
            PG8_LDB(B0, 1, 0); PG8_LDB(B1, 1, 1); PG8_SCHED; PG8_LDA(At, 1, 0); PG8_STAGE(PG8_SA(0, 1), a2 + hstep, voffA);
            PG8_WAIT_V(8); PG8_WAIT_L(0); PG8_BAR; PG8_MMA(0, 0, At, B0); PG8_MMA(0, 1, At, B1); PG8_BAR; PG8_SCHED;
            PG8_LDA(At, 1, 1); PG8_STAGE(PG8_SB(1, 0), b3, voffB); PG8_STAGE(PG8_SB(1, 1), b3 + hstep, voffB); PG8_STAGE(PG8_SA(1, 0), a3, voffA);
            PG8_WAIT_V(8); PG8_WAIT_L(0); PG8_BAR; PG8_MMA(1, 0, At, B0); PG8_MMA(1, 1, At, B1); PG8_BAR; PG8_SCHED;
            } else {
            PG8_LDB(B0, 0, 0); PG8_SCHED; PG8_LDA(At, 0, 0); PG8_STAGE(PG8_SA(1, 1), a1 + hstep, voffA);
            PG8_WAIT_L(8); PG8_BAR; PG8_WAIT_L(0); PG8_MMA(0, 0, At, B0); PG8_BAR; PG8_SCHED;
            PG8_LDB(B1, 0, 1); PG8_STAGE(PG8_SB(0, 0), b2, voffB);
            PG8_BAR; PG8_WAIT_L(0); PG8_MMA(0, 1, At, B1); PG8_BAR;
            PG8_LDA(At, 0, 1); PG8_STAGE(PG8_SA(0, 0), a2, voffA);
            PG8_BAR; PG8_WAIT_L(0); PG8_MMA(1, 0, At, B0); PG8_BAR; PG8_SCHED;
            PG8_STAGE(PG8_SB(0, 1), b2 + hstep, voffB);
            PG8_WAIT_V(6); PG8_BAR; PG8_MMA(1, 1, At, B1); PG8_BAR;
            PG8_LDB(B0, 1, 0); PG8_SCHED; PG8_LDA(At, 1, 0); PG8_STAGE(PG8_SA(0, 1), a2 + hstep, voffA);
            PG8_WAIT_L(8); PG8_BAR; PG8_WAIT_L(0); PG8_MMA(0, 0, At, B0); PG8_BAR; PG8_SCHED;
            PG8_LDB(B1, 1, 1); PG8_STAGE(PG8_SB(1, 0), b3, voffB);
            PG8_BAR; PG8_WAIT_L(0); PG8_MMA(0, 1, At, B1); PG8_BAR;
            PG8_LDA(At, 1, 1); PG8_STAGE(PG8_SA(1, 0), a3, voffA);
            PG8_BAR; PG8_WAIT_L(0); PG8_MMA(1, 0, At, B0); PG8_BAR; PG8_SCHED;
            PG8_STAGE(PG8_SB(1, 1), b3 + hstep, voffB);
            PG8_WAIT_V(6); PG8_BAR; PG8_MMA(1, 1, At, B1); PG8_BAR;
            }
        }
        if constexpr (ALIGN_EPI) { if (wr == 0) PG8_BAR; }
        if constexpr (!Epi::AFTER_DRAIN) { E(acc, cur, wr, wc, fr, fq); S.done(cur); }
        if (!has_next) break;
#pragma unroll
        for (int a = 0; a < 2; ++a)
#pragma unroll
            for (int b = 0; b < 2; ++b)
#pragma unroll
                for (int m = 0; m < 4; ++m)
#pragma unroll
                    for (int n = 0; n < 2; ++n) acc[a][b][m][n] = (f32x4){0.f, 0.f, 0.f, 0.f};
        cur = nxt; cA = nA; cB = nB; ++ui;
        if constexpr (ALIGN_EPI) { if (wr == 1) PG8_BAR; }
    }
    PG8_WAIT_V(0);
    if constexpr (!ALIGN_EPI) { if (wr == 0) PG8_BAR; }
    PG8_BAR;
    if constexpr (Epi::AFTER_DRAIN) { E.fused(acc, cur, wr, wc, fr, fq, lds, wid, lane); S.done(cur); }
#undef PG8_SA
#undef PG8_SB
#undef PG8_STAGE
#undef PG8_LDA
#undef PG8_LDB
#undef PG8_MMA
#undef PG8_WAIT_V
#undef PG8_WAIT_L
#undef PG8_BAR
#undef PG8_SCHED
}
}
#define LAS __attribute__((address_space(3)))
typedef unsigned short bf16_t;
typedef short bf16x8 __attribute__((ext_vector_type(8)));
typedef short bf16x4 __attribute__((ext_vector_type(4)));
typedef float f32x4 __attribute__((ext_vector_type(4)));
typedef float f32x2 __attribute__((ext_vector_type(2)));
typedef unsigned u32x4 __attribute__((ext_vector_type(4)));
typedef unsigned u32x2 __attribute__((ext_vector_type(2)));
typedef __bf16 bf16x2_t __attribute__((ext_vector_type(2)));

constexpr int T = 16384, D = 1024, SEQ = 2048;
constexpr float EPS = 1e-6f;
constexpr size_t MiB = 1u << 20;
constexpr int LDS_BYTES = 163840;
#ifndef N_LAUNCH_SPLIT
#define N_LAUNCH_SPLIT 0
#endif

constexpr size_t W_MIXIN = 1 * MiB, W_UQ = 10 * MiB, W_UKV = 12 * MiB, W_MIXO = 13 * MiB, W_XQ = 15 * MiB, W_XKV = 17 * MiB, W_XO = 21 * MiB, W_1 = 23 * MiB, W_2 = 31 * MiB;
constexpr size_t WS_H = 39 * MiB, WS_MEMN = 71 * MiB, WS_MK = 75 * MiB, WS_MVT = 79 * MiB, WS_COS = 83 * MiB, WS_SIN = 85 * MiB, WS_AR = 87 * MiB;
constexpr size_t A_Z = WS_AR, A_CQN = WS_AR + 44 * MiB, A_CKVN = WS_AR + 56 * MiB, A_KROPE = WS_AR + 64 * MiB, A_Q = WS_AR + 66 * MiB, A_KNOPE = WS_AR + 114 * MiB, A_VT = WS_AR + 146 * MiB;
constexpr size_t G_PRE = WS_AR, G_POST = WS_AR + 96 * MiB, G_GATE = WS_AR + 192 * MiB, G_LOGIT = WS_AR + 224 * MiB, G_BETA = WS_AR + 225 * MiB, G_G = G_BETA + MiB / 2, G_GC = WS_AR + 226 * MiB;
constexpr size_t G_W = WS_AR, G_UT = WS_AR + 32 * MiB, G_ATT = WS_AR + 64 * MiB;
constexpr size_t WS_END = WS_AR + 227 * MiB;

__device__ __forceinline__ float shx(float v, int m, int lane) { return __int_as_float(__builtin_amdgcn_ds_bpermute((lane ^ m) << 2, __float_as_int(v))); }
__device__ __forceinline__ float wave_sum(float v, int lane) {
#pragma unroll
    for (int o = 32; o > 0; o >>= 1) v += shx(v, o, lane);
    return v;
}
__device__ __forceinline__ float bf2f(unsigned short b) { return __uint_as_float(((unsigned)b) << 16); }
__device__ __forceinline__ unsigned pk2(float lo, float hi) { f32x2 v = {lo, hi}; bf16x2_t b = __builtin_convertvector(v, bf16x2_t); return __builtin_bit_cast(unsigned, b); }
__device__ __forceinline__ unsigned short f2bf(float f) { return (unsigned short)(pk2(f, 0.f) & 0xffffu); }
__device__ __forceinline__ float silu_f(float x) { return x / (1.f + __expf(-x)); }
__device__ __forceinline__ u32x2 pk4(f32x4 v) { u32x2 r; r.x = pk2(v[0], v[1]); r.y = pk2(v[2], v[3]); return r; }
#define MFMA16(a, b, c) __builtin_amdgcn_mfma_f32_16x16x32_bf16((a), (b), (c), 0, 0, 0)

__device__ __forceinline__ u32x4 pk8(f32x4 a, f32x4 b) { const u32x2 x = pk4(a), y = pk4(b); return (u32x4){x.x, x.y, y.x, y.y}; }
struct Pre4 { f32x4 a, b, c, d; };
template <class F> struct EpiF {
    static constexpr bool PERM = F::WIDE, AFTER_DRAIN = false;
    F f;
    __device__ __forceinline__ void operator()(const pg8::f32x4 (&acc)[2][2][4][2], const pg8::Unit& u, int wr, int wc, int fr, int fq) const {
        constexpr int NS = PERM ? 4 : 16;
        const int rowb = u.pm * 256 + wr * 64 + fr, colb = u.pn * 256 + wc * 32 + fq * (PERM ? 8 : 4);
        Pre4 pre[2];
        if constexpr (F::MODE != 0) f.prefetch(pre[0], rowb, colb);
#pragma unroll
        for (int g = 0; g < 8; ++g) {
            const int ai = g >> 2, m = g & 3, row = rowb + ai * 128 + m * 16;
            if constexpr (F::MODE != 0) { if (g + 1 < 8) f.prefetch(pre[(g + 1) & 1], rowb + ((g + 1) >> 2) * 128 + ((g + 1) & 3) * 16, colb); }
            asm volatile("" ::: "memory");
            if constexpr (F::MODE == 2) {
                const Pre4& p = pre[g & 1]; float part = 0.f;
#pragma unroll
                for (int bj = 0; bj < 2; ++bj) { const f32x4 o0 = (bj == 0 ? p.a : p.c) + acc[ai][bj][m][0], o1 = (bj == 0 ? p.b : p.d) + acc[ai][bj][m][1];
                    const u32x2 w0 = pk4(o0), w1 = pk4(o1); *(u32x4*)(f.xb + (size_t)row * D + colb + bj * 128) = (u32x4){w0.x, w0.y, w1.x, w1.y};
                    part += ((o0[0] * o0[0] + o0[1] * o0[1]) + (o0[2] * o0[2] + o0[3] * o0[3])) + ((o1[0] * o1[0] + o1[1] * o1[1]) + (o1[2] * o1[2] + o1[3] * o1[3])); }
                const int lane = fq * 16 + fr; part += shx(part, 16, lane); part += shx(part, 32, lane);
                if (fq == 0) f.ssq[(size_t)row * 16 + u.pn * 4 + wc] = part;
            } else {
                float rs = 1.f;
                if constexpr (F::MODE == 1 || F::MODE == 3) { const Pre4& p = pre[g & 1]; const f32x4 t = (p.a + p.b) + (p.c + p.d); rs = rsqrtf(((t[0] + t[1]) + (t[2] + t[3])) * F::INVN + EPS); }
                if constexpr (F::MODE == 3) {
                    float pA = 0.f, pB = 0.f;
#pragma unroll
                    for (int bj = 0; bj < 2; ++bj) { const int col = colb + bj * 128; const f32x4 v0 = acc[ai][bj][m][0] * rs, v1 = acc[ai][bj][m][1] * rs;
                        const float sq = ((v0[0] * v0[0] + v0[1] * v0[1]) + (v0[2] * v0[2] + v0[3] * v0[3])) + ((v1[0] * v1[0] + v1[1] * v1[1]) + (v1[2] * v1[2] + v1[3] * v1[3]));
                        if (col < 384) { *(u32x4*)(f.cq + (size_t)row * 384 + col) = pk8(v0, v1); if (bj == 0) pA += sq; else pB += sq; }
                        else if (col < 640) { *(u32x4*)(f.ckv + (size_t)row * 256 + (col - 384)) = pk8(v0, v1); if (bj == 0) pA += sq; else pB += sq; }
                        else if (col < 704) { float* kp = f.kr + (size_t)row * 64 + (col - 640); *(f32x4*)kp = v0; *(f32x4*)(kp + 4) = v1; } }
                    const int lane = fq * 16 + fr; pA += shx(pA, 16, lane); pA += shx(pA, 32, lane); pB += shx(pB, 16, lane); pB += shx(pB, 32, lane);
                    if (fq == 0) { float* q2 = f.ssq2 + (size_t)row * 32;
                        if (u.pn == 0) { q2[wc] = pA; q2[4 + wc] = pB; } else if (u.pn == 1) { q2[8 + wc] = pA; q2[16 + wc] = pB; } else { q2[20 + wc] = pA; } }
                } else {
#pragma unroll
                for (int bj = 0; bj < 2; ++bj) {
                    if constexpr (F::WIDE) { f.one2(row, colb + bj * 128, acc[ai][bj][m][0] * rs, acc[ai][bj][m][1] * rs); __builtin_amdgcn_sched_barrier(0); }
                    else {
#pragma unroll
                        for (int n = 0; n < 2; ++n) { f.one(row, colb + bj * 128 + n * NS, acc[ai][bj][m][n] * rs, bj); __builtin_amdgcn_sched_barrier(0); } } }
                }
            }
            asm volatile("" ::: "memory");
        }
    }
};
template <class F> __device__ __forceinline__ void run_gemm(LAS unsigned char* lds, const bf16_t* A, const bf16_t* Bt, int M, int N, int K, const F& f, const int wv, const int cshift = 0) {
    int cc_ = (int)blockIdx.x + cshift; if (cc_ >= (int)gridDim.x) cc_ -= (int)gridDim.x;
    pg8::Gemm g{A, Bt, M, N, K}; pg8::StaticOrder S; S.init(M, N, (int)gridDim.x, cc_);
    EpiF<F> E{f};
    pg8::gemm_phase<EpiF<F>, pg8::StaticOrder, true, true>(lds, g, S, E, wv);
}
#define F_PLAIN static constexpr int MODE = 0; static constexpr bool WIDE = false;
#define F_SCALEDW static constexpr int MODE = 1; static constexpr float INVN = 1.f / D; static constexpr bool WIDE = true; __device__ __forceinline__ void prefetch(Pre4& p, int row, int) const { const f32x4* q_ = (const f32x4*)(ssq + (size_t)row * 16); p.a = q_[0]; p.b = q_[1]; p.c = q_[2]; p.d = q_[3]; }
#define F_SCALED static constexpr int MODE = 1; static constexpr float INVN = 1.f / D; static constexpr bool WIDE = false; __device__ __forceinline__ void prefetch(Pre4& p, int row, int) const { const f32x4* q_ = (const f32x4*)(ssq + (size_t)row * 16); p.a = q_[0]; p.b = q_[1]; p.c = q_[2]; p.d = q_[3]; }
struct FResid { float* x; bf16_t* xb; float* ssq; static constexpr int MODE = 2; static constexpr bool WIDE = true;
    __device__ __forceinline__ static f32x4 up4(const bf16_t* q) { const bf16x4 v = *(const bf16x4*)q; return (f32x4){bf2f((unsigned short)v[0]), bf2f((unsigned short)v[1]), bf2f((unsigned short)v[2]), bf2f((unsigned short)v[3])}; }
    __device__ __forceinline__ void prefetch(Pre4& p, int row, int colb) const { const bf16_t* q_ = xb + (size_t)row * D + colb; p.a = up4(q_); p.b = up4(q_ + 4); p.c = up4(q_ + 128); p.d = up4(q_ + 132); } };
struct FBf16 { bf16_t* O; int ldc; F_PLAIN __device__ __forceinline__ void one(int row, int col, f32x4 v, int bj) const { *(u32x2*)(O + (size_t)row * ldc + col) = pk4(v); } };
struct FBf16S { bf16_t* O; int ldc; const float* ssq; F_SCALEDW __device__ __forceinline__ void one2(int row, int col, f32x4 v0, f32x4 v1) const { *(u32x4*)(O + (size_t)row * ldc + col) = pk8(v0, v1); } };
struct FRelu2 { bf16_t* O; int ldc; const float* ssq; F_SCALEDW __device__ __forceinline__ void one2(int row, int col, f32x4 v0, f32x4 v1) const {
    f32x4 r0, r1; for (int e = 0; e < 4; ++e) { const float t = v0[e] > 0.f ? v0[e] : 0.f; r0[e] = t * t; const float t1 = v1[e] > 0.f ? v1[e] : 0.f; r1[e] = t1 * t1; } *(u32x4*)(O + (size_t)row * ldc + col) = pk8(r0, r1); } };
struct FMlaIn { bf16_t* cq; bf16_t* ckv; float* kr; const float* ssq; float* ssq2; static constexpr int MODE = 3; static constexpr bool WIDE = true; static constexpr float INVN = 1.f / D;
    __device__ __forceinline__ void prefetch(Pre4& p, int row, int) const { const f32x4* q_ = (const f32x4*)(ssq + (size_t)row * 16); p.a = q_[0]; p.b = q_[1]; p.c = q_[2]; p.d = q_[3]; } };
struct FUq { bf16_t* O; const float* ssq2; static constexpr int MODE = 1; static constexpr bool WIDE = true; static constexpr float INVN = 1.f / 384.f;
    __device__ __forceinline__ void prefetch(Pre4& p, int row, int) const { const f32x4* q_ = (const f32x4*)(ssq2 + (size_t)row * 32); p.a = q_[0]; p.b = q_[1]; p.c = q_[2]; p.d = (f32x4){0.f, 0.f, 0.f, 0.f}; }
    __device__ __forceinline__ void one2(int row, int col, f32x4 v0, f32x4 v1) const { *(u32x4*)(O + (size_t)row * 1536 + col) = pk8(v0, v1); } };
struct FMemKV { bf16_t* K; bf16_t* Vt; static constexpr int MODE = 0; static constexpr bool WIDE = true; __device__ __forceinline__ void one2(int row, int col, f32x4 v0, f32x4 v1) const {
    if (col < 1024) { *(u32x4*)(K + (size_t)row * 1024 + col) = pk8(v0, v1); }
    else { const int c = col - 1024, hh = c >> 8, d = c & 255, b = row >> 8, m = row & 255; bf16_t* p = Vt + (size_t)(((b * 4 + hh) * 4 + (m >> 6)) * 16384 + d * 64 + (m & 63));
#pragma unroll
        for (int e = 0; e < 4; ++e) { p[e * 64] = f2bf(v0[e]); p[(4 + e) * 64] = f2bf(v1[e]); } } } };
struct FUkv { bf16_t* kn; bf16_t* Vt; const float* ssq2; static constexpr int MODE = 1; static constexpr bool WIDE = true; static constexpr float INVN = 1.f / 256.f;
    __device__ __forceinline__ void prefetch(Pre4& p, int row, int) const { const f32x4* q_ = (const f32x4*)(ssq2 + (size_t)row * 32 + 16); p.a = q_[0]; p.b = q_[1]; p.c = (f32x4){0.f, 0.f, 0.f, 0.f}; p.d = p.c; }
    __device__ __forceinline__ void one2(int row, int col, f32x4 v0, f32x4 v1) const {
    const int hh = col >> 8, wi = col & 255;
    if (wi < 128) { *(u32x4*)(kn + (size_t)row * 1024 + hh * 128 + wi) = pk8(v0, v1); }
    else { const int d = wi - 128, b = row >> 11, s = row & 2047; bf16_t* p = Vt + (size_t)(((b * 8 + hh) * 32 + (s >> 6)) * 8192 + d * 64 + (s & 63));
#pragma unroll
        for (int e = 0; e < 4; ++e) { p[e * 64] = f2bf(v0[e]); p[(4 + e) * 64] = f2bf(v1[e]); } } } };
struct FGdnIn { bf16_t* qkv; bf16_t* gate; float* logit; const float* ssq; F_SCALEDW __device__ __forceinline__ void one2(int row, int col, f32x4 v0, f32x4 v1) const {
    if (col < 3072) *(u32x4*)(qkv + (size_t)row * 3072 + col) = pk8(v0, v1);
    else if (col < 4096) *(u32x4*)(gate + (size_t)row * 1024 + (col - 3072)) = pk8(v0, v1);
    else if (col < 4112) { float* lp = logit + (size_t)row * 16 + (col - 4096); *(f32x4*)lp = v0; *(f32x4*)(lp + 4) = v1; } } };

__device__ __forceinline__ void conv_w(const float* __restrict__ W, int K, int Nvalid, int Npad, bf16_t* __restrict__ WT, LAS float* scr, int gw, int NGW, int lane, const float* __restrict__ gk = nullptr) {
    const int nblk = Npad / 32, nitems = (K / 64) * nblk;
    const int r = lane >> 3, c4 = (lane & 7) * 4;
    for (int it = gw; it < nitems; it += NGW) {
        const int kb = it / nblk, nb = it - kb * nblk, k0 = 64 * kb, n0 = 32 * nb;
        const bool ok = (n0 + c4) < Nvalid;
        f32x4 v[8];
#pragma unroll
        for (int i = 0; i < 8; ++i) v[i] = ok ? *(const f32x4*)(W + (size_t)(k0 + 8 * i + r) * Nvalid + n0 + c4) : (f32x4){0.f, 0.f, 0.f, 0.f};
#pragma unroll
        for (int i = 0; i < 8; ++i) { const int kk = 8 * i + r; f32x4 t = v[i]; if (gk) t = t * gk[k0 + kk]; LAS float* d = scr + kk * 33 + c4; d[0] = t[0]; d[1] = t[1]; d[2] = t[2]; d[3] = t[3]; }
        asm volatile("s_waitcnt lgkmcnt(0)" ::: "memory");
        const int c = lane & 7;
#pragma unroll
        for (int j = 0; j < 4; ++j) { const int nn = (lane >> 3) + 8 * j; const LAS float* s = scr + (8 * c) * 33 + nn;
            u32x4 o; o.x = pk2(s[0 * 33], s[1 * 33]); o.y = pk2(s[2 * 33], s[3 * 33]); o.z = pk2(s[4 * 33], s[5 * 33]); o.w = pk2(s[6 * 33], s[7 * 33]);
            *(u32x4*)(WT + (size_t)(n0 + nn) * K + k0 + 8 * c) = o; }
        asm volatile("s_waitcnt lgkmcnt(0)" ::: "memory");
    }
}
__device__ __forceinline__ void init_row(const float* xrow, float* copy, bf16_t* orow, float* ssq_row, int lane) {
    const f32x4* xr = (const f32x4*)xrow + lane;
    f32x4 v[4]; float s = 0.f;
#pragma unroll
    for (int j = 0; j < 4; ++j) { v[j] = xr[64 * j]; s += (v[j][0] * v[j][0] + v[j][1] * v[j][1]) + (v[j][2] * v[j][2] + v[j][3] * v[j][3]); }
    s = wave_sum(s, lane);
    u32x2* o8 = (u32x2*)orow + lane;
#pragma unroll
    for (int j = 0; j < 4; ++j) { o8[64 * j] = pk4(v[j]); }
    if (lane < 16) ssq_row[lane] = (lane == 0) ? s : 0.f;
}
__device__ __forceinline__ void rms_row(const float* xrow, const float* g, bf16_t* orow, float* copy, int lane) {
    const f32x4* xr = (const f32x4*)xrow + lane; const f32x4* gr = (const f32x4*)g + lane;
    f32x4 v[4]; float s = 0.f;
#pragma unroll
    for (int j = 0; j < 4; ++j) { v[j] = xr[64 * j]; s += (v[j][0] * v[j][0] + v[j][1] * v[j][1]) + (v[j][2] * v[j][2] + v[j][3] * v[j][3]); }
    const float rstd = rsqrtf(wave_sum(s, lane) * (1.f / D) + EPS);
    u32x2* o8 = (u32x2*)orow + lane;
#pragma unroll
    for (int j = 0; j < 4; ++j) { if (copy) ((f32x4*)copy + lane)[64 * j] = v[j]; const f32x4 gg = gr[64 * j]; o8[64 * j] = pk4(v[j] * rstd * gg); }
}
__device__ __forceinline__ void rms_row_f32(const bf16_t* xrow, float* orow, const float* g, int lane) {
    const bf16x4* xr = (const bf16x4*)xrow + lane; const f32x4* gr = (const f32x4*)g + lane;
    f32x4 v[4]; float s = 0.f;
#pragma unroll
    for (int j = 0; j < 4; ++j) { const bf16x4 t = xr[64 * j]; v[j] = (f32x4){bf2f((unsigned short)t[0]), bf2f((unsigned short)t[1]), bf2f((unsigned short)t[2]), bf2f((unsigned short)t[3])};
        s += (v[j][0] * v[j][0] + v[j][1] * v[j][1]) + (v[j][2] * v[j][2] + v[j][3] * v[j][3]); }
    const float rstd = rsqrtf(wave_sum(s, lane) * (1.f / D) + EPS);
#pragma unroll
    for (int j = 0; j < 4; ++j) ((f32x4*)orow + lane)[64 * j] = v[j] * rstd * gr[64 * j];
}

template <int DK1, int DK2, int DV, int RT, bool CAUSAL, bool ROPE>
__device__ __forceinline__ void attn_unit(LAS unsigned char* lds, const bf16_t* __restrict__ Q, int ldq, const bf16_t* __restrict__ K1, int ldk1, const bf16_t* __restrict__ K2, int ldk2,
                                          const bf16_t* __restrict__ Vt, int ldvt, int nkt, int q0, bf16_t* __restrict__ O, int ldo, float sl2, const float* __restrict__ cosr, const float* __restrict__ sinr, const int wv) {
    constexpr int DQK = DK1 + DK2, NKS = DQK / 32, NDT = DV / 16, KP = DQK + 16, VP = 80, KCH = DQK / 8;
    const int tid = pg8::opq_tid(wv), lane = tid & 63, wid = tid >> 6, fr = lane & 15, fq = lane >> 4;
    const int wrow0 = wid * 16 * RT;
    bf16x8 qf[RT][NKS];
#pragma unroll
    for (int rt = 0; rt < RT; ++rt)
#pragma unroll
        for (int ks = 0; ks < NKS; ++ks) qf[rt][ks] = *(const bf16x8*)(Q + (size_t)(wrow0 + rt * 16 + fr) * ldq + ks * 32 + fq * 8);
    if (!ROPE) {
#pragma unroll
        for (int rt = 0; rt < RT; ++rt)
#pragma unroll
            for (int ks = 0; ks < NKS; ++ks) { bf16x8 a = qf[rt][ks], o;
#pragma unroll
                for (int j = 0; j < 8; ++j) o[j] = (short)f2bf(bf2f((unsigned short)a[j]) * sl2);
                qf[rt][ks] = o; }
    }
    if (ROPE) {
#pragma unroll
        for (int rt = 0; rt < RT; ++rt)
#pragma unroll
            for (int ks = 0; ks < DK1 / 32; ++ks) { bf16x8 a = qf[rt][ks], o;
#pragma unroll
                for (int j = 0; j < 8; ++j) o[j] = (short)f2bf(bf2f((unsigned short)a[j]) * sl2);
                qf[rt][ks] = o; }
#pragma unroll
        for (int rt = 0; rt < RT; ++rt) {
            const int row = wrow0 + rt * 16 + fr; constexpr int k1 = DK1 / 32;
            bf16x8 a = qf[rt][k1], b = qf[rt][k1 + 1], oa, ob;
#pragma unroll
            for (int j = 0; j < 8; ++j) { const float c = cosr[row * 32 + fq * 8 + j], s = sinr[row * 32 + fq * 8 + j];
                const float x1 = bf2f((unsigned short)a[j]), x2 = bf2f((unsigned short)b[j]);
                oa[j] = (short)f2bf((x1 * c - x2 * s) * sl2); ob[j] = (short)f2bf((x2 * c + x1 * s) * sl2); }
            qf[rt][k1] = oa; qf[rt][k1 + 1] = ob;
        }
    }
    float m_run[RT], l_run[RT]; f32x4 oacc[RT][NDT];
#pragma unroll
    for (int rt = 0; rt < RT; ++rt) { m_run[rt] = -INFINITY; l_run[rt] = 0.f;
#pragma unroll
        for (int dt = 0; dt < NDT; ++dt) oacc[rt][dt] = (f32x4){0.f, 0.f, 0.f, 0.f}; }
    constexpr int NKL = (64 * KCH) / 512, NVL = (DV * 8) / 512, BUFB = (64 * KP + DV * VP) * 2;
    u32x4 kreg[NKL], vreg[NVL];
#define ATT_LOAD(kt_) do { \
        _Pragma("unroll") for (int i = 0; i < NKL; ++i) { const int id = tid + 512 * i, key = id / KCH, c = id - key * KCH; \
            const bf16_t* src = (c < DK1 / 8) ? (K1 + (size_t)((kt_) * 64 + key) * ldk1 + c * 8) : (K2 + (size_t)((kt_) * 64 + key) * ldk2 + (c - DK1 / 8) * 8); kreg[i] = *(const u32x4*)src; } \
        _Pragma("unroll") for (int i = 0; i < NVL; ++i) { const int id = tid + 512 * i, d = id >> 3, c = id & 7; vreg[i] = *(const u32x4*)(Vt + (size_t)(kt_) * (DV * 64) + d * 64 + c * 8); } } while (0)
#define ATT_STORE(buf_) do { LAS bf16_t* Kd = (LAS bf16_t*)(lds + (buf_) * BUFB); LAS bf16_t* Vd = Kd + 64 * KP; \
        _Pragma("unroll") for (int i = 0; i < NKL; ++i) { const int id = tid + 512 * i, key = id / KCH, c = id - key * KCH; *(LAS u32x4*)(Kd + key * KP + c * 8) = kreg[i]; } \
        _Pragma("unroll") for (int i = 0; i < NVL; ++i) { const int id = tid + 512 * i, d = id >> 3, c = id & 7; LAS bf16_t* vp_ = Vd + d * VP + (c >> 2) * 32 + (c & 1) * 16 + ((c & 3) >> 1) * 4; \
            *(LAS u32x2*)vp_ = (u32x2){vreg[i].x, vreg[i].y}; *(LAS u32x2*)(vp_ + 8) = (u32x2){vreg[i].z, vreg[i].w}; } } while (0)
    ATT_LOAD(0);
    ATT_STORE(0);
    if (nkt > 1) ATT_LOAD(1);
    __syncthreads();
    for (int kt = 0; kt < nkt; ++kt) {
        if (kt + 1 < nkt) ATT_STORE((kt + 1) & 1);
        if (kt + 2 < nkt) ATT_LOAD(kt + 2);
        const LAS bf16_t* Kb = (const LAS bf16_t*)(lds + (kt & 1) * BUFB); const LAS bf16_t* Vb = Kb + 64 * KP;
        if (!(CAUSAL && kt * 64 > q0 + wrow0 + 16 * RT - 1)) {
        f32x4 sacc[RT][4];
#pragma unroll
        for (int rt = 0; rt < RT; ++rt)
#pragma unroll
            for (int ct = 0; ct < 4; ++ct) sacc[rt][ct] = (f32x4){0.f, 0.f, 0.f, 0.f};
#pragma unroll
        for (int ks = 0; ks < NKS; ++ks) { bf16x8 kf[4];
#pragma unroll
            for (int ct = 0; ct < 4; ++ct) kf[ct] = *(const LAS bf16x8*)(Kb + (ct * 16 + fr) * KP + ks * 32 + fq * 8);
#pragma unroll
            for (int ct = 0; ct < 4; ++ct)
#pragma unroll
                for (int rt = 0; rt < RT; ++rt) sacc[rt][ct] = MFMA16(kf[ct], qf[rt][ks], sacc[rt][ct]); }
        const bool need_mask = CAUSAL && (kt * 64 + 63 > q0 + wrow0);
        bf16x8 pf[RT][2];
#pragma unroll
        for (int rt = 0; rt < RT; ++rt) {
            const int qi = q0 + wrow0 + rt * 16 + fr;
            float mx = -INFINITY;
#pragma unroll
            for (int ct = 0; ct < 4; ++ct)
#pragma unroll
                for (int e = 0; e < 4; ++e) { float s = sacc[rt][ct][e]; if (need_mask && (kt * 64 + ct * 16 + fq * 4 + e > qi)) s = -INFINITY; sacc[rt][ct][e] = s; mx = fmaxf(mx, s); }
            mx = fmaxf(mx, shx(mx, 16, lane)); mx = fmaxf(mx, shx(mx, 32, lane));
            const float m_new = fmaxf(m_run[rt], mx);
            const float alpha = __builtin_amdgcn_exp2f(m_run[rt] - m_new); m_run[rt] = m_new;
            float ls = 0.f;
#pragma unroll
            for (int ct = 0; ct < 4; ++ct)
#pragma unroll
                for (int e = 0; e < 4; ++e) { const float p = __builtin_amdgcn_exp2f(sacc[rt][ct][e] - m_new); sacc[rt][ct][e] = p; ls += p; }
            l_run[rt] = l_run[rt] * alpha + ls;
            if (__any(alpha != 1.f)) {
#pragma unroll
                for (int dt = 0; dt < NDT; ++dt) oacc[rt][dt] = oacc[rt][dt] * alpha; }
#pragma unroll
            for (int s2 = 0; s2 < 2; ++s2) { u32x4 w; w.x = pk2(sacc[rt][2 * s2][0], sacc[rt][2 * s2][1]); w.y = pk2(sacc[rt][2 * s2][2], sacc[rt][2 * s2][3]);
                w.z = pk2(sacc[rt][2 * s2 + 1][0], sacc[rt][2 * s2 + 1][1]); w.w = pk2(sacc[rt][2 * s2 + 1][2], sacc[rt][2 * s2 + 1][3]); pf[rt][s2] = __builtin_bit_cast(bf16x8, w); }
        }
#pragma unroll
        for (int dh = 0; dh < NDT / 4; ++dh)
#pragma unroll
            for (int s2 = 0; s2 < 2; ++s2) { bf16x8 vf[4];
#pragma unroll
                for (int d4 = 0; d4 < 4; ++d4) vf[d4] = *(const LAS bf16x8*)(Vb + ((dh * 4 + d4) * 16 + fr) * VP + s2 * 32 + fq * 8);
#pragma unroll
                for (int d4 = 0; d4 < 4; ++d4)
#pragma unroll
                    for (int rt = 0; rt < RT; ++rt) oacc[rt][dh * 4 + d4] = MFMA16(vf[d4], pf[rt][s2], oacc[rt][dh * 4 + d4]);
                if (NDT > 8) __builtin_amdgcn_sched_barrier(0);
            }
        }
        __syncthreads();
    }
    {
        constexpr int OSP = DV + 8, RPI = 512 / DV, CPR = DV / 8;
        LAS bf16_t* Os = (LAS bf16_t*)(lds + wid * (16 * RT * OSP * 2));
#pragma unroll
        for (int rt = 0; rt < RT; ++rt) {
            float l = l_run[rt]; l += shx(l, 16, lane); l += shx(l, 32, lane);
            const float inv = 1.f / l;
#pragma unroll
            for (int dt = 0; dt < NDT; ++dt) *(LAS u32x2*)(Os + (rt * 16 + fr) * OSP + dt * 16 + fq * 4) = pk4(oacc[rt][dt] * inv);
        }
#pragma unroll
        for (int i = 0; i < (16 * RT) / RPI; ++i) { const int row = i * RPI + lane / CPR, ch = lane % CPR;
            const u32x4 v = *(const LAS u32x4*)(Os + row * OSP + ch * 8); *(u32x4*)(O + (size_t)(wrow0 + row) * ldo + ch * 8) = v; }
        __syncthreads();
    }
#undef ATT_LOAD
#undef ATT_STORE
}
#define GAS __attribute__((address_space(1)))
typedef GAS unsigned gu32;
typedef GAS unsigned long long gu64;
#define RLX_AGENT __ATOMIC_RELAXED, __HIP_MEMORY_SCOPE_AGENT
#define LDS_WAIT() asm volatile("s_waitcnt lgkmcnt(0)" ::: "memory")
#define VM_WAIT() asm volatile("s_waitcnt vmcnt(0)" ::: "memory")

#define XB_TMO      128
#define XB_XCNT(j)  (256  + 64 * (j))
#define XB_XSUB(j)  (1280 + 64 * (j))
#define XB_XGEN(j)  (2304 + 64 * (j))
#define XB_TOP      3328
#define XB_TOPGEN   3392
#define XCD_BAR_WORDS 3456
#define XB_SPIN_CAP (1u << 18)

__device__ __forceinline__ unsigned xb_ld(unsigned* p)              { return __hip_atomic_load(p, __ATOMIC_RELAXED, __HIP_MEMORY_SCOPE_AGENT); }
__device__ __forceinline__ unsigned xb_add(unsigned* p, unsigned v) { return __hip_atomic_fetch_add(p, v, __ATOMIC_RELAXED, __HIP_MEMORY_SCOPE_AGENT); }
__device__ __forceinline__ unsigned xb_xcc_id() { return (unsigned)__builtin_amdgcn_s_getreg((3 << 11) | 20) & 0xFu; }
#define XB_SPIN(cond, bar) do { unsigned _sp = 0; while (cond) { __builtin_amdgcn_s_sleep(1); \
    if ((++_sp & 255u) == 0u) { if (xb_ld(&(bar)[XB_TMO])) break; if (_sp > XB_SPIN_CAP) { atomicAdd(&(bar)[XB_TMO], 1u); break; } } } } while (0)

struct XcdBarrier {
    unsigned* bar; unsigned x;
    volatile LAS unsigned* st;
};

__device__ __forceinline__ XcdBarrier xcd_barrier_post(unsigned* bar, volatile LAS unsigned* st) {
    XcdBarrier b; b.bar = bar; b.x = xb_xcc_id(); b.st = st;
    if (threadIdx.x == 0) (void)xb_add(&bar[XB_XCNT(b.x)], 1u);
    return b;
}
__device__ __forceinline__ void xcd_barrier_complete(unsigned* bar, unsigned x, unsigned& nloc, unsigned& nx) {
    const unsigned G = gridDim.x * gridDim.y * gridDim.z;
    unsigned sum, cnt, mine, sp = 0u;
    for (;;) {
        sum = 0u; cnt = 0u; mine = 0u;
#pragma unroll
        for (unsigned j = 0; j < 16; ++j) { const unsigned c = xb_ld(&bar[XB_XCNT(j)]); sum += c; cnt += (c > 0u) ? 1u : 0u; mine = (j == x) ? c : mine; }
        if (sum == G) break;
        __builtin_amdgcn_s_sleep(1);
        if ((++sp & 255u) == 0u) { if (xb_ld(&bar[XB_TMO])) break; if (sp > XB_SPIN_CAP) { atomicAdd(&bar[XB_TMO], 1u); break; } }
    }
    nloc = mine > 0u ? mine : 1u; nx = cnt > 0u ? cnt : 1u;
}

__device__ __forceinline__ void xcd_barrier(const XcdBarrier& b) {
    asm volatile("s_waitcnt vmcnt(0)" ::: "memory");
    __syncthreads();
    if (threadIdx.x == 0) {
        unsigned* bar = b.bar;
        __builtin_amdgcn_s_waitcnt(0);
        unsigned nloc = b.st[0], nx = b.st[1];
        if (nloc == 0u) { xcd_barrier_complete(bar, b.x, nloc, nx); b.st[0] = nloc; b.st[1] = nx; }
        const unsigned old = xb_add(&bar[XB_XSUB(b.x)], 1u);
        const unsigned gen = old / nloc;
        if (old + 1u == (gen + 1u) * nloc) {
            __builtin_amdgcn_fence(__ATOMIC_RELEASE, "agent");
            asm volatile("s_waitcnt vmcnt(0)" ::: "memory");
            const unsigned og = xb_add(&bar[XB_TOP], 1u);
            const unsigned tg = og / nx;
            if (og + 1u == (tg + 1u) * nx) xb_add(&bar[XB_TOPGEN], 1u);
            else XB_SPIN(xb_ld(&bar[XB_TOPGEN]) == tg, bar);
            __builtin_amdgcn_fence(__ATOMIC_ACQUIRE, "agent");
            xb_add(&bar[XB_XGEN(b.x)], 1u);
            asm volatile("s_waitcnt vmcnt(0)" ::: "memory");
        } else {
            XB_SPIN(xb_ld(&bar[XB_XGEN(b.x)]) == gen, bar);
            __builtin_amdgcn_fence(__ATOMIC_ACQUIRE, "agent");
            asm volatile("s_waitcnt vmcnt(0)" ::: "memory");
        }
    }
    __syncthreads();
}

__device__ __forceinline__ bf16x8 ldsfrag(const LAS bf16_t* base, int pitch, int row, int k) { return *(const LAS bf16x8*)(base + row * pitch + k); }

__device__ __forceinline__ f32x4 unpk4(u32x2 x) { return (f32x4){__uint_as_float(x.x << 16), __uint_as_float(x.x & 0xffff0000u), __uint_as_float(x.y << 16), __uint_as_float(x.y & 0xffff0000u)}; }
__device__ __forceinline__ void gdn_conv_phase(const bf16_t* __restrict__ pre, bf16_t* __restrict__ post, const float* __restrict__ convw, const float* __restrict__ logit,
                                               const float* __restrict__ a_log, const float* __restrict__ dt_bias, float* __restrict__ beta, float* __restrict__ g, int gw, int NGW, int lane, int gtid, int NT) {
    for (int it = gw; it < 512 * 12; it += NGW) {
        const int rb = it / 12, gp = it - rb * 12, r0 = rb * 32, t0 = r0 & (SEQ - 1), col = gp * 256 + 4 * lane;
        f32x4 w[4];
#pragma unroll
        for (int j = 0; j < 4; ++j) w[j] = *(const f32x4*)(convw + j * 3072 + col);
        f32x4 pv[3];
#pragma unroll
        for (int j = 0; j < 3; ++j) { u32x2 x = {0u, 0u}; if (t0 - 3 + j >= 0) x = *(const u32x2*)(pre + (size_t)(r0 - 3 + j) * 3072 + col); pv[j] = unpk4(x); }
        const bool nrm = gp < 8; const float qsc = (gp < 4) ? 0.08838834764831845f : 1.f;
        for (int tb = 0; tb < 32; tb += 8) {
            u32x2 xr[8];
#pragma unroll
            for (int u = 0; u < 8; ++u) xr[u] = *(const u32x2*)(pre + (size_t)(r0 + tb + u) * 3072 + col);
            f32x4 y[8];
#pragma unroll
            for (int u = 0; u < 8; ++u) { const f32x4 x = unpk4(xr[u]); const f32x4 a = (w[0] * pv[0] + w[1] * pv[1]) + (w[2] * pv[2] + w[3] * x);
                pv[0] = pv[1]; pv[1] = pv[2]; pv[2] = x;
                y[u] = (f32x4){silu_f(a[0]), silu_f(a[1]), silu_f(a[2]), silu_f(a[3])}; }
            if (nrm) { float ss[8];
#pragma unroll
                for (int u = 0; u < 8; ++u) ss[u] = (y[u][0] * y[u][0] + y[u][1] * y[u][1]) + (y[u][2] * y[u][2] + y[u][3] * y[u][3]);
#pragma unroll
                for (int o = 16; o > 0; o >>= 1) {
#pragma unroll
                    for (int u = 0; u < 8; ++u) ss[u] += shx(ss[u], o, lane); }
#pragma unroll
                for (int u = 0; u < 8; ++u) y[u] = y[u] * (rsqrtf(ss[u] + EPS) * qsc); }
#pragma unroll
            for (int u = 0; u < 8; ++u) *(u32x2*)(post + (size_t)(r0 + tb + u) * 3072 + col) = pk4(y[u]);
        }
    }
    for (int i = gtid; i < T * 8; i += NT) { const int r = i >> 3, h = i & 7; const float bl = logit[r * 16 + h], al = logit[r * 16 + 8 + h];
        beta[i] = 1.f / (1.f + expf(-bl)); const float xx = al + dt_bias[h]; const float sp = xx > 20.f ? xx : log1pf(expf(xx)); g[i] = -expf(a_log[h]) * sp; }
}

__device__ __forceinline__ void gdn_chunk_phase(LAS unsigned char* lds, const bf16_t* __restrict__ post, const float* __restrict__ beta, const float* __restrict__ g,
                                                bf16_t* __restrict__ Wc, bf16_t* __restrict__ UT, bf16_t* __restrict__ ATT, float* __restrict__ GC, const int wv) {
    constexpr int KP = 144, TP = 80, SZK = 64 * KP * 2, SZT = 128 * TP * 2;
    LAS bf16_t* kS = (LAS bf16_t*)lds; LAS bf16_t* qS = (LAS bf16_t*)(lds + SZK); LAS bf16_t* vbT = (LAS bf16_t*)(lds + 2 * SZK); LAS bf16_t* kbgT = (LAS bf16_t*)(lds + 2 * SZK + SZT);
    LAS float* Mm = (LAS float*)(lds + 2 * SZK + 2 * SZT); LAS bf16_t* Ti = (LAS bf16_t*)(lds + 2 * SZK + 2 * SZT + 16384); LAS float* gcS = (LAS float*)(lds + 2 * SZK + 2 * SZT + 16384 + 64 * TP * 2); LAS float* btS = gcS + 64;
    const int tid = pg8::opq_tid(wv), lane = tid & 63, wid = tid >> 6, fr = lane & 15, fq = lane >> 4;
    u32x4 cq[2], ck[2], cv[2]; float cg = 0.f, cb = 0.f;
#define CH_LOAD(unit_) do { const int b_ = (unit_) >> 8, h_ = ((unit_) >> 5) & 7, n_ = (unit_) & 31; const size_t r_ = (size_t)b_ * SEQ + n_ * 64; \
        _Pragma("unroll") for (int i = 0; i < 2; ++i) { const int id = tid + 512 * i, pos = id & 63, c8 = id >> 6; const bf16_t* rowp = post + (r_ + pos) * 3072 + h_ * 128 + c8 * 8; \
            cq[i] = *(const u32x4*)rowp; ck[i] = *(const u32x4*)(rowp + 1024); cv[i] = *(const u32x4*)(rowp + 2048); } \
        if (wid == 0) { cg = g[(r_ + lane) * 8 + h_]; cb = beta[(r_ + lane) * 8 + h_]; } } while (0)
    if ((int)blockIdx.x < 2048) CH_LOAD((int)blockIdx.x);
    for (int unit = blockIdx.x; unit < 2048; unit += gridDim.x) {
        const int b = unit >> 8, h = (unit >> 5) & 7, n = unit & 31, r0 = b * SEQ + n * 64;
        __syncthreads();
        if (wid == 0) { float gv = cg;
#pragma unroll
            for (int o = 1; o < 64; o <<= 1) { const float up = __int_as_float(__builtin_amdgcn_ds_bpermute(((lane - o) & 63) << 2, __float_as_int(gv))); if (lane >= o) gv += up; }
            gcS[lane] = gv; btS[lane] = cb; GC[(size_t)unit * 64 + lane] = gv; }
        __syncthreads();
#pragma unroll
        for (int i = 0; i < 2; ++i) { const int id = tid + 512 * i, pos = id & 63, c8 = id >> 6;
            const u32x4 qv = cq[i], kv = ck[i], vv = cv[i];
            *(LAS u32x4*)(qS + pos * KP + c8 * 8) = qv; *(LAS u32x4*)(kS + pos * KP + c8 * 8) = kv;
            const float bt = btS[pos], sc = bt * __expf(gcS[pos]);
            const bf16x8 k8 = __builtin_bit_cast(bf16x8, kv), v8 = __builtin_bit_cast(bf16x8, vv);
#pragma unroll
            for (int e = 0; e < 8; ++e) { kbgT[(c8 * 8 + e) * TP + pos] = f2bf(bf2f((unsigned short)k8[e]) * sc); vbT[(c8 * 8 + e) * TP + pos] = f2bf(bf2f((unsigned short)v8[e]) * bt); } }
        if (unit + (int)gridDim.x < 2048) CH_LOAD(unit + (int)gridDim.x);
        __syncthreads();
#pragma unroll
        for (int tt = 0; tt < 2; ++tt) { const int t = wid + 8 * tt, it = t >> 2, jt = t & 3; const int i = it * 16 + fr, j0 = jt * 16 + fq * 4;
            bf16_t* ap = ATT + (size_t)unit * 4096 + i * 64 + j0;
            if (jt <= it) {
                f32x4 aK = {0.f, 0.f, 0.f, 0.f}, aQ = {0.f, 0.f, 0.f, 0.f};
#pragma unroll
                for (int ks = 0; ks < 4; ++ks) { const bf16x8 kj = ldsfrag(kS, KP, jt * 16 + fr, ks * 32 + fq * 8), ki = ldsfrag(kS, KP, it * 16 + fr, ks * 32 + fq * 8), qi = ldsfrag(qS, KP, it * 16 + fr, ks * 32 + fq * 8);
                    aK = MFMA16(kj, ki, aK); aQ = MFMA16(kj, qi, aQ); }
                const float gi = gcS[i], bi = btS[i]; f32x4 mm, at;
#pragma unroll
                for (int e = 0; e < 4; ++e) { const int j = j0 + e; const float dec = (i >= j) ? __expf(gi - gcS[j]) : 0.f; mm[e] = (i > j) ? bi * aK[e] * dec : 0.f; at[e] = aQ[e] * dec; }
                *(LAS f32x4*)(Mm + i * 64 + j0) = mm; *(u32x2*)ap = pk4(at);
            } else { *(u32x2*)ap = (u32x2){0u, 0u}; }
        }
        __syncthreads();
        if (wid == 0) {
            float x[64]; int ln = lane; asm volatile("" : "+v"(ln)); int zv = 0; asm volatile("" : "+v"(zv)); const LAS float* Mv = Mm + zv;
#pragma unroll
            for (int i = 0; i < 64; ++i) {
                int dl = i - ln; dl = dl < 0 ? -dl : dl; dl = 1 - dl; dl = dl < 0 ? 0 : dl; float s0 = (float)dl, s1 = 0.f, s2 = 0.f, s3 = 0.f;
#pragma unroll
                for (int j4 = 0; j4 < (i + 3) / 4; ++j4) { const f32x4 m = *(const LAS f32x4*)(Mv + i * 64 + j4 * 4);
                    if (j4 * 4 + 0 < i) s0 -= m[0] * x[j4 * 4 + 0]; if (j4 * 4 + 1 < i) s1 -= m[1] * x[j4 * 4 + 1];
                    if (j4 * 4 + 2 < i) s2 -= m[2] * x[j4 * 4 + 2]; if (j4 * 4 + 3 < i) s3 -= m[3] * x[j4 * 4 + 3]; }
                x[i] = (s0 + s1) + (s2 + s3);
                Ti[i * TP + lane] = f2bf(x[i]);
            }
        }
        __syncthreads();
#pragma unroll
        for (int q = 0; q < 4; ++q) { const int t = wid * 4 + q, pt = t >> 3, dt = t & 7;
            f32x4 aU = {0.f, 0.f, 0.f, 0.f}, aW = {0.f, 0.f, 0.f, 0.f};
#pragma unroll
            for (int ks = 0; ks < 2; ++ks) { const bf16x8 tf = ldsfrag(Ti, TP, pt * 16 + fr, ks * 32 + fq * 8);
                aU = MFMA16(tf, ldsfrag(vbT, TP, dt * 16 + fr, ks * 32 + fq * 8), aU);
                aW = MFMA16(ldsfrag(kbgT, TP, dt * 16 + fr, ks * 32 + fq * 8), tf, aW); }
            *(u32x2*)(UT + (size_t)unit * 8192 + (dt * 16 + fr) * 64 + pt * 16 + fq * 4) = pk4(aU);
            *(u32x2*)(Wc + (size_t)unit * 8192 + (pt * 16 + fr) * 128 + dt * 16 + fq * 4) = pk4(aW);
        }
    }
}

#undef CH_LOAD
__device__ __forceinline__ void gdn_seq_phase(LAS unsigned char* lds, const bf16_t* __restrict__ post, const bf16_t* __restrict__ Wc, const bf16_t* __restrict__ UT, const bf16_t* __restrict__ ATT,
                                              const float* __restrict__ GC, bf16_t* __restrict__ out, const int wv) {
    constexpr int KP = 144, TP = 80, SZK = 64 * KP * 2, SZT = 128 * TP * 2;
    LAS bf16_t* wS = (LAS bf16_t*)lds; LAS bf16_t* qgS = (LAS bf16_t*)(lds + SZK); LAS bf16_t* kdT = (LAS bf16_t*)(lds + 2 * SZK); LAS bf16_t* atS = (LAS bf16_t*)(lds + 2 * SZK + SZT);
    LAS bf16_t* StT = (LAS bf16_t*)(lds + 2 * SZK + SZT + 64 * TP * 2); LAS bf16_t* vnT = (LAS bf16_t*)(lds + 2 * SZK + SZT + 64 * TP * 2 + 32 * KP * 2);
    const int tid = pg8::opq_tid(wv), lane = tid & 63, wid = tid >> 6, fr = lane & 15, fq = lane >> 4;
    const int nh = wid & 1, pr = wid >> 1, dvl = 16 * nh + fr;
    const int G_ = (int)gridDim.x, vc = (G_ % 8 == 0) ? ((int)blockIdx.x % 8) * (G_ / 8) + (int)blockIdx.x / 8 : (int)blockIdx.x;
    for (int item = vc; item < 256; item += G_) {
        const int bh = item >> 2, dq = item & 3, b = bh >> 3, h = bh & 7, dvg = 32 * dq + dvl;
        f32x4 sacc[2];
        __syncthreads();
#pragma unroll
        for (int m = 0; m < 2; ++m) { sacc[m] = (f32x4){0.f, 0.f, 0.f, 0.f}; *(LAS u32x2*)(StT + dvl * KP + (2 * pr + m) * 16 + fq * 4) = (u32x2){0u, 0u}; }
        u32x4 wreg[2], areg; bf16x8 qreg[2], kreg[2]; bf16x4 ureg; float gqr[2], gkr[2], glr;
#define SEQ_LOAD(n_) do { const size_t un_ = (size_t)(bh * 32 + (n_)); const size_t rr_ = (size_t)b * SEQ + (n_) * 64; \
            _Pragma("unroll") for (int i = 0; i < 2; ++i) { const int id = tid + 512 * i; \
                { const int pos = id >> 4, c8 = id & 15; wreg[i] = *(const u32x4*)(Wc + un_ * 8192 + pos * 128 + c8 * 8); qreg[i] = *(const bf16x8*)(post + (rr_ + pos) * 3072 + h * 128 + c8 * 8); gqr[i] = GC[un_ * 64 + pos]; } \
                { const int pos = id & 63, c8 = id >> 6; kreg[i] = *(const bf16x8*)(post + (rr_ + pos) * 3072 + 1024 + h * 128 + c8 * 8); gkr[i] = GC[un_ * 64 + pos]; } } \
            areg = *(const u32x4*)(ATT + un_ * 4096 + (tid >> 3) * 64 + (tid & 7) * 8); glr = GC[un_ * 64 + 63]; \
            ureg = *(const bf16x4*)(UT + un_ * 8192 + dvg * 64 + 16 * pr + fq * 4); } while (0)
        SEQ_LOAD(0);
        for (int n = 0; n < 32; ++n) {
            const int r0 = b * SEQ + n * 64;
            const float glast = glr;
            __syncthreads();
#pragma unroll
            for (int i = 0; i < 2; ++i) { const int id = tid + 512 * i;
                { const int pos = id >> 4, c8 = id & 15;
                  *(LAS u32x4*)(wS + pos * KP + c8 * 8) = wreg[i];
                  const bf16x8 q8 = qreg[i]; const float eg = __expf(gqr[i]);
                  u32x4 w; w.x = pk2(bf2f((unsigned short)q8[0]) * eg, bf2f((unsigned short)q8[1]) * eg); w.y = pk2(bf2f((unsigned short)q8[2]) * eg, bf2f((unsigned short)q8[3]) * eg);
                  w.z = pk2(bf2f((unsigned short)q8[4]) * eg, bf2f((unsigned short)q8[5]) * eg); w.w = pk2(bf2f((unsigned short)q8[6]) * eg, bf2f((unsigned short)q8[7]) * eg);
                  *(LAS u32x4*)(qgS + pos * KP + c8 * 8) = w; }
                { const int pos = id & 63, c8 = id >> 6;
                  const bf16x8 k8 = kreg[i]; const float sc = __expf(glast - gkr[i]);
#pragma unroll
                  for (int e = 0; e < 8; ++e) kdT[(c8 * 8 + e) * TP + pos] = f2bf(bf2f((unsigned short)k8[e]) * sc); } }
            { const int i = tid >> 3, c8 = tid & 7; *(LAS u32x4*)(atS + i * TP + c8 * 8) = areg; }
            const bf16x4 ucur = ureg;
            __syncthreads();
            if (n + 1 < 32) SEQ_LOAD(n + 1);
            bf16x8 sf[4];
#pragma unroll
            for (int ks = 0; ks < 4; ++ks) sf[ks] = ldsfrag(StT, KP, dvl, ks * 32 + fq * 8);
            f32x4 acc = {0.f, 0.f, 0.f, 0.f}, oacc = {0.f, 0.f, 0.f, 0.f};
#pragma unroll
            for (int ks = 0; ks < 4; ++ks) acc = MFMA16(ldsfrag(wS, KP, 16 * pr + fr, ks * 32 + fq * 8), sf[ks], acc);
            { f32x4 vn; for (int e = 0; e < 4; ++e) vn[e] = bf2f((unsigned short)ucur[e]) - acc[e];
              *(LAS u32x2*)(vnT + dvl * TP + 16 * pr + fq * 4) = pk4(vn); }
#pragma unroll
            for (int ks = 0; ks < 4; ++ks) oacc = MFMA16(ldsfrag(qgS, KP, 16 * pr + fr, ks * 32 + fq * 8), sf[ks], oacc);
            __syncthreads();
            bf16x8 vf[2];
#pragma unroll
            for (int ks = 0; ks < 2; ++ks) vf[ks] = ldsfrag(vnT, TP, dvl, ks * 32 + fq * 8);
#pragma unroll
            for (int ks = 0; ks < 2; ++ks) oacc = MFMA16(ldsfrag(atS, TP, 16 * pr + fr, ks * 32 + fq * 8), vf[ks], oacc);
#pragma unroll
            for (int e = 0; e < 4; ++e) out[(size_t)(r0 + 16 * pr + fq * 4 + e) * 1024 + h * 128 + dvg] = f2bf(oacc[e]);
            const float egl = __expf(glast);
#pragma unroll
            for (int m = 0; m < 2; ++m) { const int mt = 2 * pr + m; f32x4 a2 = sacc[m] * egl;
#pragma unroll
                for (int ks = 0; ks < 2; ++ks) a2 = MFMA16(ldsfrag(kdT, TP, mt * 16 + fr, ks * 32 + fq * 8), vf[ks], a2);
                sacc[m] = a2; *(LAS u32x2*)(StT + dvl * KP + mt * 16 + fq * 4) = pk4(a2); }
        }
    }
}
#undef SEQ_LOAD
__device__ __forceinline__ void gdn_fin_phase(bf16_t* __restrict__ Hb, const bf16_t* __restrict__ gate, const float* __restrict__ o_norm, int gw, int NGW, int lane) {
    const float* gn = o_norm + (lane & 7) * 16;
    for (int r = gw; r < T; r += 2 * NGW) {
        const int r2 = (r + NGW < T) ? r + NGW : r;
        bf16_t* hp[2] = {Hb + (size_t)r * 1024 + lane * 16, Hb + (size_t)r2 * 1024 + lane * 16};
        const bf16_t* gp[2] = {gate + (size_t)r * 1024 + lane * 16, gate + (size_t)r2 * 1024 + lane * 16};
        bf16x8 o0[2], o1[2], g0[2], g1[2];
#pragma unroll
        for (int q = 0; q < 2; ++q) { o0[q] = *(const bf16x8*)hp[q]; o1[q] = *(const bf16x8*)(hp[q] + 8); g0[q] = *(const bf16x8*)gp[q]; g1[q] = *(const bf16x8*)(gp[q] + 8); }
        float ss[2];
#pragma unroll
        for (int q = 0; q < 2; ++q) { float t = 0.f;
#pragma unroll
            for (int e = 0; e < 8; ++e) { const float a = bf2f((unsigned short)o0[q][e]), c = bf2f((unsigned short)o1[q][e]); t += a * a + c * c; }
            ss[q] = t; }
#pragma unroll
        for (int sh = 1; sh < 8; sh <<= 1) { ss[0] += shx(ss[0], sh, lane); ss[1] += shx(ss[1], sh, lane); }
#pragma unroll
        for (int q = 0; q < 2; ++q) { if (q == 1 && r2 == r) break;
            const float rstd = rsqrtf(ss[q] * (1.f / 128.f) + EPS); float res[16];
#pragma unroll
            for (int e = 0; e < 16; ++e) { const float ov = bf2f((unsigned short)(e < 8 ? o0[q][e] : o1[q][e - 8])), gt = bf2f((unsigned short)(e < 8 ? g0[q][e] : g1[q][e - 8])); res[e] = ov * rstd * gn[e] * silu_f(gt); }
            u32x4 w0, w1;
            w0.x = pk2(res[0], res[1]); w0.y = pk2(res[2], res[3]); w0.z = pk2(res[4], res[5]); w0.w = pk2(res[6], res[7]);
            w1.x = pk2(res[8], res[9]); w1.y = pk2(res[10], res[11]); w1.z = pk2(res[12], res[13]); w1.w = pk2(res[14], res[15]);
            *(u32x4*)hp[q] = w0; *(u32x4*)(hp[q] + 8) = w1; }
    }
}
__device__ __forceinline__ void mla_mid_phase(const float* __restrict__ z, const float* __restrict__ qn, const float* __restrict__ kvn, const float* __restrict__ cosb, const float* __restrict__ sinb,
                                              bf16_t* __restrict__ cqn, bf16_t* __restrict__ ckvn, bf16_t* __restrict__ krope, int gw, int NGW, int lane) {
    for (int r = gw; r < T; r += NGW) {
        const float* zr = z + (size_t)r * 704;
        f32x2 a[3]; float s = 0.f;
#pragma unroll
        for (int i = 0; i < 3; ++i) { a[i] = *(const f32x2*)(zr + 2 * lane + 128 * i); s += a[i][0] * a[i][0] + a[i][1] * a[i][1]; }
        float rstd = rsqrtf(wave_sum(s, lane) * (1.f / 384.f) + EPS);
#pragma unroll
        for (int i = 0; i < 3; ++i) { const f32x2 gg = *(const f32x2*)(qn + 2 * lane + 128 * i); *(unsigned*)(cqn + (size_t)r * 384 + 2 * lane + 128 * i) = pk2(a[i][0] * rstd * gg[0], a[i][1] * rstd * gg[1]); }
        f32x2 c[2]; s = 0.f;
#pragma unroll
        for (int i = 0; i < 2; ++i) { c[i] = *(const f32x2*)(zr + 384 + 2 * lane + 128 * i); s += c[i][0] * c[i][0] + c[i][1] * c[i][1]; }
        rstd = rsqrtf(wave_sum(s, lane) * (1.f / 256.f) + EPS);
#pragma unroll
        for (int i = 0; i < 2; ++i) { const f32x2 gg = *(const f32x2*)(kvn + 2 * lane + 128 * i); *(unsigned*)(ckvn + (size_t)r * 256 + 2 * lane + 128 * i) = pk2(c[i][0] * rstd * gg[0], c[i][1] * rstd * gg[1]); }
        const float v = zr[640 + lane], pv = shx(v, 32, lane); const int i = lane & 31; const float cs = cosb[(size_t)r * 32 + i], sn = sinb[(size_t)r * 32 + i];
        const float outv = (lane < 32) ? (v * cs - pv * sn) : (v * cs + pv * sn);
        krope[(size_t)r * 64 + lane] = f2bf(outv);
    }
}
__device__ __forceinline__ void sc_mid_phase(const bf16_t* __restrict__ z, const float* __restrict__ cw, bf16_t* __restrict__ y, int gtid, int NT) {
    for (int it = gtid; it < T * 128; it += NT) {
        const int r = it >> 7, c8 = it & 127, t = r & (SEQ - 1), col = c8 * 8;
        float acc[8];
#pragma unroll
        for (int e = 0; e < 8; ++e) acc[e] = 0.f;
#pragma unroll
        for (int j = 0; j < 3; ++j) { if (t - 2 + j >= 0) { const bf16_t* zr = z + (size_t)(r - 2 + j) * 3072 + col;
            const bf16x8 cg8 = *(const bf16x8*)(zr + 1024), u8 = *(const bf16x8*)(zr + 2048); const f32x4 w0 = *(const f32x4*)(cw + j * 1024 + col), w1 = *(const f32x4*)(cw + j * 1024 + col + 4);
#pragma unroll
            for (int e = 0; e < 8; ++e) acc[e] += (e < 4 ? w0[e] : w1[e - 4]) * (bf2f((unsigned short)cg8[e]) * bf2f((unsigned short)u8[e])); } }
        const bf16x8 b8 = *(const bf16x8*)(z + (size_t)r * 3072 + col);
        u32x4 o; o.x = pk2(acc[0] * bf2f((unsigned short)b8[0]), acc[1] * bf2f((unsigned short)b8[1])); o.y = pk2(acc[2] * bf2f((unsigned short)b8[2]), acc[3] * bf2f((unsigned short)b8[3]));
        o.z = pk2(acc[4] * bf2f((unsigned short)b8[4]), acc[5] * bf2f((unsigned short)b8[5])); o.w = pk2(acc[6] * bf2f((unsigned short)b8[6]), acc[7] * bf2f((unsigned short)b8[7]));
        *(u32x4*)(y + (size_t)r * 1024 + col) = o;
    }
}
struct Params { const float* in[28]; float* out; unsigned char* ws; int L, pad; };
enum { PH_PREP = 0, PH_IN_MLA, PH_IN_GDN, PH_IN_SC, PH_MLA_MID, PH_MLA_UP, PH_MLA_ATTN, PH_GDN_CONV, PH_GDN_CHUNK, PH_GDN_SEQ, PH_SC_MID, PH_OPROJ,
       PH_XNORM, PH_XQ, PH_XATTN, PH_XO, PH_MNORM, PH_MUP, PH_MDOWN, PH_FINAL, PH_COUNT };

template <int PH> __device__ __forceinline__ void run_phase(const Params& p, const int L, LAS unsigned char* lds, const int wv) {
    const int tid = pg8::opq_tid(wv), lane = tid & 63, wid = tid >> 6;
    int G_ = gridDim.x; asm volatile("" : "+s"(G_));
    const int G = G_, gw = blockIdx.x * 8 + wid, NGW = G * 8, gtid = blockIdx.x * 512 + tid, NT = G * 512;
    unsigned char* ws = p.ws;
    float* X = p.out;
    bf16_t* H = (bf16_t*)p.out;     bf16_t* MEMN = (bf16_t*)(ws + WS_MEMN); bf16_t* MK = (bf16_t*)(ws + WS_MK); bf16_t* MVT = (bf16_t*)(ws + WS_MVT);
    float* COS = (float*)(ws + WS_COS); float* SIN = (float*)(ws + WS_SIN);
    bf16_t* XB = (bf16_t*)(ws + WS_H);   float* SSP = (float*)(ws + WS_AR + 160 * MiB);
    bf16_t* Wmixin = (bf16_t*)(ws + W_MIXIN); bf16_t* Wuq = (bf16_t*)(ws + W_UQ); bf16_t* Wukv = (bf16_t*)(ws + W_UKV); bf16_t* Wmixo = (bf16_t*)(ws + W_MIXO);
    bf16_t* Wxq = (bf16_t*)(ws + W_XQ); bf16_t* Wxkv = (bf16_t*)(ws + W_XKV); bf16_t* Wxo = (bf16_t*)(ws + W_XO); bf16_t* W1 = (bf16_t*)(ws + W_1); bf16_t* W2 = (bf16_t*)(ws + W_2);
    const int kind = L % 3, j = L / 3;
    if constexpr (PH == PH_PREP) {
        const float* xin = p.in[0]; const float* mem = p.in[1]; const int* positions = (const int*)p.in[2];
        LAS float* scr = (LAS float*)(lds + wid * 16384);
        if (kind == 0) {
            conv_w(p.in[3] + (size_t)j * 1024 * 704, 1024, 704, 768, Wmixin, scr, gw, NGW, lane, p.in[18] + L * D);
            conv_w(p.in[6] + (size_t)j * 384 * 1536, 384, 1536, 1536, Wuq, scr, gw, NGW, lane, p.in[4] + j * 384);
            conv_w(p.in[7] + (size_t)j * 256 * 2048, 256, 2048, 2048, Wukv, scr, gw, NGW, lane, p.in[5] + j * 256);
            conv_w(p.in[8] + (size_t)j * 1024 * 1024, 1024, 1024, 1024, Wmixo, scr, gw, NGW, lane);
        } else if (kind == 1) {
            conv_w(p.in[9], 1024, 4112, 4352, Wmixin, scr, gw, NGW, lane, p.in[18] + L * D);
            conv_w(p.in[14], 1024, 1024, 1024, Wmixo, scr, gw, NGW, lane);
        } else {
            conv_w(p.in[15], 1024, 3072, 3072, Wmixin, scr, gw, NGW, lane, p.in[18] + L * D);
            conv_w(p.in[17], 1024, 1024, 1024, Wmixo, scr, gw, NGW, lane);
        }
        conv_w(p.in[21] + (size_t)L * 1024 * 1024, 1024, 1024, 1024, Wxq, scr, gw, NGW, lane, p.in[19] + L * D);
        conv_w(p.in[22] + (size_t)L * 1024 * 2048, 1024, 2048, 2048, Wxkv, scr, gw, NGW, lane);
        conv_w(p.in[23] + (size_t)L * 1024 * 1024, 1024, 1024, 1024, Wxo, scr, gw, NGW, lane);
        conv_w(p.in[24] + (size_t)L * 1024 * 4096, 1024, 4096, 4096, W1, scr, gw, NGW, lane, p.in[20] + L * D);
        conv_w(p.in[25] + (size_t)L * 4096 * 1024, 4096, 1024, 1024, W2, scr, gw, NGW, lane);
        if (L == 0) {
            for (int r = gw; r < T; r += NGW) init_row(xin + (size_t)r * D, X + (size_t)r * D, XB + (size_t)r * D, SSP + (size_t)r * 16, lane);
            for (int r = gw; r < 2048; r += NGW) rms_row(mem + (size_t)r * D, p.in[26], MEMN + (size_t)r * D, nullptr, lane);
            for (int i = gtid; i < T * 32; i += NT) { const int r = i >> 5, k = i & 31; const float inv = exp2f(-(float)k * (13.287712379549449f / 32.f));
                const float ang = (float)positions[r] * inv; double rev = (double)ang * 0.15915494309189535; rev -= rint(rev); const float rr = (float)(rev * 6.283185307179586);
                COS[i] = cosf(rr); SIN[i] = sinf(rr); }
        }
    } else if constexpr (PH == PH_IN_MLA) {
        run_gemm(lds, XB, Wmixin, T, 768, 1024, FMlaIn{(bf16_t*)(ws + A_CQN), (bf16_t*)(ws + A_CKVN), (float*)(ws + A_Z), SSP, (float*)(ws + A_Z + 8 * MiB)}, wv);
        run_gemm(lds, MEMN, Wxkv, 2048, 2048, 1024, FMemKV{MK, MVT}, wv, 64);
    } else if constexpr (PH == PH_IN_GDN) {
        run_gemm(lds, XB, Wmixin, T, 4352, 1024, FGdnIn{(bf16_t*)(ws + G_PRE), (bf16_t*)(ws + G_GATE), (float*)(ws + G_LOGIT), SSP}, wv);
        run_gemm(lds, MEMN, Wxkv, 2048, 2048, 1024, FMemKV{MK, MVT}, wv, 192);
    } else if constexpr (PH == PH_IN_SC) {
        run_gemm(lds, XB, Wmixin, T, 3072, 1024, FBf16S{(bf16_t*)(ws + WS_AR), 3072, SSP}, wv);
        run_gemm(lds, MEMN, Wxkv, 2048, 2048, 1024, FMemKV{MK, MVT}, wv, 0);
    } else if constexpr (PH == PH_MLA_MID) {
        mla_mid_phase((const float*)(ws + A_Z), p.in[4] + j * 384, p.in[5] + j * 256, COS, SIN, (bf16_t*)(ws + A_CQN), (bf16_t*)(ws + A_CKVN), (bf16_t*)(ws + A_KROPE), gw, NGW, lane);
    } else if constexpr (PH == PH_MLA_UP) {
#ifndef UPSEL
#define UPSEL 3
#endif
        { const float* kr = (const float*)(ws + A_Z); bf16_t* kro = (bf16_t*)(ws + A_KROPE);
          for (int i = gtid; i < T * 32; i += NT) { const int r = i >> 5, k = i & 31; const float x1 = kr[(size_t)r * 64 + k], x2 = kr[(size_t)r * 64 + 32 + k], cs = COS[i], sn = SIN[i];
              kro[(size_t)r * 64 + k] = f2bf(x1 * cs - x2 * sn); kro[(size_t)r * 64 + 32 + k] = f2bf(x2 * cs + x1 * sn); } }
        run_gemm(lds, (const bf16_t*)(ws + A_CQN), Wuq, T, 1536, 384, FUq{(bf16_t*)(ws + A_Q), (const float*)(ws + A_Z + 8 * MiB)}, wv);
        run_gemm(lds, (const bf16_t*)(ws + A_CKVN), Wukv, T, 2048, 256, FUkv{(bf16_t*)(ws + A_KNOPE), (bf16_t*)(ws + A_VT), (const float*)(ws + A_Z + 8 * MiB)}, wv);
    } else if constexpr (PH == PH_MLA_ATTN) {
        const bf16_t* Qb = (const bf16_t*)(ws + A_Q); const bf16_t* Kn = (const bf16_t*)(ws + A_KNOPE); const bf16_t* Kr = (const bf16_t*)(ws + A_KROPE); const bf16_t* Vt = (const bf16_t*)(ws + A_VT);
        const int vc = (G % 8 == 0) ? ((int)blockIdx.x % 8) * (G / 8) + (int)blockIdx.x / 8 : (int)blockIdx.x;
        for (int item = vc; item < 256; item += G) {
            const int bh = item >> 2, s = item & 3, b = bh >> 3, h = bh & 7;
            for (int pass = 0; pass < 2; ++pass) { const int qb = pass ? 7 - s : s; const size_t row0 = (size_t)b * SEQ + qb * 256;
                attn_unit<128, 64, 128, 2, true, true>(lds, Qb + row0 * 1536 + h * 192, 1536, Kn + (size_t)b * SEQ * 1024 + h * 128, 1024, Kr + (size_t)b * SEQ * 64, 64,
                    Vt + (size_t)(b * 8 + h) * 128 * 2048, 64, (qb + 1) * 4, qb * 256, H + row0 * 1024 + h * 128, 1024, 0.07216878364870322f * 1.4426950408889634f, COS + row0 * 32, SIN + row0 * 32, wv); }
        }
    } else if constexpr (PH == PH_GDN_CONV) {
        gdn_conv_phase((const bf16_t*)(ws + G_PRE), (bf16_t*)(ws + G_POST), p.in[10], (const float*)(ws + G_LOGIT), p.in[11], p.in[12], (float*)(ws + G_BETA), (float*)(ws + G_G), gw, NGW, lane, gtid, NT);
    } else if constexpr (PH == PH_GDN_CHUNK) {
        gdn_chunk_phase(lds, (const bf16_t*)(ws + G_POST), (const float*)(ws + G_BETA), (const float*)(ws + G_G), (bf16_t*)(ws + G_W), (bf16_t*)(ws + G_UT), (bf16_t*)(ws + G_ATT), (float*)(ws + G_GC), wv);
    } else if constexpr (PH == PH_GDN_SEQ) {
        gdn_seq_phase(lds, (const bf16_t*)(ws + G_POST), (const bf16_t*)(ws + G_W), (const bf16_t*)(ws + G_UT), (const bf16_t*)(ws + G_ATT), (const float*)(ws + G_GC), H, wv);
    } else if constexpr (PH == PH_SC_MID) {
        sc_mid_phase((const bf16_t*)(ws + WS_AR), p.in[16], H, gtid, NT);
    } else if constexpr (PH == PH_OPROJ) {
        run_gemm(lds, H, Wmixo, T, 1024, 1024, FResid{X, XB, SSP}, wv);
    } else if constexpr (PH == PH_XNORM) {
        gdn_fin_phase(H, (const bf16_t*)(ws + G_GATE), p.in[13], gw, NGW, lane);
    } else if constexpr (PH == PH_XQ) {
        bf16_t* Qb = (bf16_t*)(ws + WS_AR);
        run_gemm(lds, XB, Wxq, T, 1024, 1024, FBf16S{Qb, 1024, SSP}, wv);
        asm volatile("s_waitcnt vmcnt(0)" ::: "memory"); __syncthreads();
        if (tid == 0) { __builtin_amdgcn_fence(__ATOMIC_ACQUIRE, "agent"); asm volatile("s_waitcnt vmcnt(0)" ::: "memory"); }
        __syncthreads();
        pg8::StaticOrder S; S.init(T, 1024, G, (int)blockIdx.x); pg8::Unit u;
        for (int ui = 0; S.next(ui, u); ++ui) {
            const int b = u.pm >> 3, h = u.pn;
            for (int half = 0; half < 2; ++half) { const size_t row0 = (size_t)u.pm * 256 + half * 128;
                attn_unit<256, 0, 256, 1, false, false>(lds, Qb + row0 * 1024 + h * 256, 1024, MK + (size_t)b * 256 * 1024 + h * 256, 1024, MK, 0,
                    MVT + (size_t)(b * 4 + h) * 256 * 256, 64, 4, 0, H + row0 * 1024 + h * 256, 1024, 0.0625f * 1.4426950408889634f, COS, SIN, wv); }
        }
    } else if constexpr (PH == PH_XATTN) {
        const bf16_t* Qb = (const bf16_t*)(ws + WS_AR);
        for (int item = blockIdx.x; item < 512; item += G) { const int b = item >> 6, h = (item >> 4) & 3, qb = item & 15; const size_t row0 = (size_t)b * SEQ + qb * 128;
            attn_unit<256, 0, 256, 1, false, false>(lds, Qb + row0 * 1024 + h * 256, 1024, MK + (size_t)b * 256 * 1024 + h * 256, 1024, MK, 0,
                MVT + (size_t)(b * 4 + h) * 256 * 256, 64, 4, 0, H + row0 * 1024 + h * 256, 1024, 0.0625f * 1.4426950408889634f, COS, SIN, wv); }
    } else if constexpr (PH == PH_XO) {
        run_gemm(lds, H, Wxo, T, 1024, 1024, FResid{X, XB, SSP}, wv);
    } else if constexpr (PH == PH_MNORM) {
        const f32x4* src = (const f32x4*)(ws + WS_AR); f32x4* dst = (f32x4*)(X + (size_t)(T / 2) * D);
        for (int i = gtid; i < (T / 2) * D / 4; i += NT) dst[i] = src[i];
    } else if constexpr (PH == PH_MUP) {
        run_gemm(lds, XB, W1, T, 4096, 1024, FRelu2{(bf16_t*)(ws + WS_AR), 4096, SSP}, wv);
    } else if constexpr (PH == PH_MDOWN) {
        run_gemm(lds, (const bf16_t*)(ws + WS_AR), W2, T, 1024, 4096, FResid{X, XB, SSP}, wv);
    } else if constexpr (PH == PH_FINAL) {
        for (int r = gw; r < T; r += NGW) rms_row_f32(XB + (size_t)r * D, X + (size_t)r * D, p.in[27], lane);
    }
}

#ifndef N_LAUNCH_SPLIT
#define N_LAUNCH_SPLIT 1
#endif
#if N_LAUNCH_SPLIT
template <int PH> __global__ void __launch_bounds__(512) k_phase(Params p) {
    extern __shared__ __attribute__((aligned(16))) unsigned char lds_raw[];
    run_phase<PH>(p, p.L, (LAS unsigned char*)lds_raw, __builtin_amdgcn_readfirstlane((int)threadIdx.x >> 6));
}
template <int PH> static void launch_phase(Params p, int L, int grid, hipStream_t stream) {
    static bool attr = false;
    if (!attr) { (void)hipFuncSetAttribute((const void*)k_phase<PH>, hipFuncAttributeMaxDynamicSharedMemorySize, LDS_BYTES); attr = true; }
    p.L = L;
    hipLaunchKernelGGL(k_phase<PH>, dim3(grid), dim3(512), LDS_BYTES, stream, p);
}
#else
#ifndef PH_MASK
#define PH_MASK 0xFFFFFF
#endif
#ifdef PROBE_A
#define PROBE_STAMP(PH) do { if (blockIdx.x == 0 && wv == 0 && pg8::opq_tid(0) == 0) { unsigned long long* tsw = (unsigned long long*)(p.ws + 32768); const unsigned long long now = __builtin_amdgcn_s_memrealtime(); \
    const unsigned long long dt_ = now - tsw[0]; tsw[0] = now; if ((PROBE_A >> PH) & 1) tsw[1] += dt_; if ((PROBE_B >> PH) & 1) tsw[2] += dt_; } } while (0)
#else
#define PROBE_STAMP(PH) do {} while (0)
#endif
#ifndef REP_MASK
#define REP_MASK 0
#endif
#define RUN(PH) do { if constexpr ((REP_MASK >> PH) & 1) { run_phase<PH>(p, L, lds, wv); xcd_barrier(bar); } if constexpr ((PH_MASK >> PH) & 1) run_phase<PH>(p, L, lds, wv); xcd_barrier(bar); PROBE_STAMP(PH); } while (0)
template <int L> __device__ __forceinline__ void run_layer(const Params& p, LAS unsigned char* lds, cg::grid_group& grid, const XcdBarrier& bar, const int wv) {
    constexpr int kind = L % 3;
    if constexpr (L != 0) RUN(PH_PREP);
    if constexpr (kind == 0) { RUN(PH_IN_MLA); RUN(PH_MLA_UP); RUN(PH_MLA_ATTN); }
    else if constexpr (kind == 1) { RUN(PH_IN_GDN); RUN(PH_GDN_CONV); RUN(PH_GDN_CHUNK); RUN(PH_GDN_SEQ); RUN(PH_XNORM); }
    else { RUN(PH_IN_SC); RUN(PH_SC_MID); }
    RUN(PH_OPROJ); RUN(PH_XQ); RUN(PH_XO); RUN(PH_MUP); RUN(PH_MDOWN);
}
#undef RUN
__global__ void __launch_bounds__(512) mega(Params p) {
    extern __shared__ __attribute__((aligned(16))) unsigned char lds_raw[];
    LAS unsigned char* lds = (LAS unsigned char*)lds_raw;
    cg::grid_group grid = cg::this_grid();
    const int wv = __builtin_amdgcn_readfirstlane((int)threadIdx.x >> 6);
    if (threadIdx.x < 2) ((volatile LAS unsigned*)(lds + LDS_BYTES - 64))[threadIdx.x] = 0u;
    if (blockIdx.x == 0) { unsigned* bw = (unsigned*)p.ws; for (int i = threadIdx.x; i < XCD_BAR_WORDS; i += 512) bw[i] = 0u; }
    __syncthreads();
    run_phase<PH_PREP>(p, 0, lds, wv);
    grid.sync();
    const XcdBarrier bar = xcd_barrier_post((unsigned*)p.ws, (volatile LAS unsigned*)(lds + LDS_BYTES - 64));
    run_layer<0>(p, lds, grid, bar, wv); run_layer<1>(p, lds, grid, bar, wv); run_layer<2>(p, lds, grid, bar, wv); run_layer<3>(p, lds, grid, bar, wv);
    run_phase<PH_FINAL>(p, 3, lds, wv);
#ifdef PROBE_A
    xcd_barrier(bar);
    if (blockIdx.x == 0) { const unsigned long long* tsw = (const unsigned long long*)(p.ws + 32768); const float a = (float)tsw[1] * 0.01f, b = (float)tsw[2] * 0.01f;
        const int t_ = pg8::opq_tid(wv); for (int i = t_; i < 10000; i += 512) p.out[4096 + i] = b; if (t_ == 0) p.out[0] = a; }
#endif
}
#endif

extern "C" void kernel_launch(void* const* d_in, const int* in_sizes, int n_in, void* d_out, int out_size, void* d_ws, size_t ws_size, hipStream_t stream) {
    static int grid_blocks = 0;
    if (!grid_blocks) {
        if (n_in != 28 || ws_size < WS_END) { fprintf(stderr, "kernel_launch: unexpected n_in %d / ws_size %zu (need %zu)\n", n_in, ws_size, (size_t)WS_END); grid_blocks = -1; return; }
        int dev = 0, cus = 0;
        (void)hipGetDevice(&dev);
        (void)hipDeviceGetAttribute(&cus, hipDeviceAttributeMultiprocessorCount, dev);
        if (cus < 1) cus = 256;
#if N_LAUNCH_SPLIT
        grid_blocks = cus;
#else
        int per_cu = 0;
        (void)hipFuncSetAttribute((const void*)mega, hipFuncAttributeMaxDynamicSharedMemorySize, LDS_BYTES);
        (void)hipOccupancyMaxActiveBlocksPerMultiprocessor(&per_cu, (const void*)mega, 512, LDS_BYTES);
        if (per_cu < 1) per_cu = 1;
        grid_blocks = cus * per_cu;
#endif
        (void)hipGetLastError();
    }
    if (grid_blocks < 0) return;
    Params p{};
    for (int i = 0; i < 28; ++i) p.in[i] = (const float*)d_in[i];
    p.out = (float*)d_out; p.ws = (unsigned char*)d_ws;
#if N_LAUNCH_SPLIT
    const int g = grid_blocks;
    for (int L = 0; L < 4; ++L) {
        const int kind = L % 3;
        launch_phase<PH_PREP>(p, L, g, stream);
        if (kind == 0) { launch_phase<PH_IN_MLA>(p, L, g, stream); launch_phase<PH_MLA_UP>(p, L, g, stream); launch_phase<PH_MLA_ATTN>(p, L, g, stream); }
        else if (kind == 1) { launch_phase<PH_IN_GDN>(p, L, g, stream); launch_phase<PH_GDN_CONV>(p, L, g, stream); launch_phase<PH_GDN_CHUNK>(p, L, g, stream); launch_phase<PH_GDN_SEQ>(p, L, g, stream); launch_phase<PH_XNORM>(p, L, g, stream); }
        else { launch_phase<PH_IN_SC>(p, L, g, stream); launch_phase<PH_SC_MID>(p, L, g, stream); }
        launch_phase<PH_OPROJ>(p, L, g, stream); launch_phase<PH_XQ>(p, L, g, stream);
        launch_phase<PH_XO>(p, L, g, stream); launch_phase<PH_MUP>(p, L, g, stream); launch_phase<PH_MDOWN>(p, L, g, stream);
    }
    launch_phase<PH_FINAL>(p, 3, g, stream);
#else
    void* args[] = {&p};
    hipError_t e = hipLaunchCooperativeKernel((const void*)mega, dim3(grid_blocks), dim3(512), args, LDS_BYTES, stream);
    if (e != hipSuccess) fprintf(stderr, "cooperative launch failed: %s (grid %d)\n", hipGetErrorString(e), grid_blocks);
#endif
}
```
